# Optimizing an MI355X kernel written in HIP

```python
import math
import jax, jax.numpy as jnp
from jax import lax
import numpy as np

D_MODEL = 1024
BATCH = 2
SEQ = 8192
DEPTH = 2

N_META = 16
BLOCK_Q = 128
PAD = BLOCK_Q - N_META
HG_WIDTH = D_MODEL // 2
HG_HEADS = 4
HG_DK = HG_WIDTH // HG_HEADS
HG_DV = HG_WIDTH // HG_HEADS
HG_CHUNK = 64
DA_WIDTH = D_MODEL // 4
DA_HEADS = 4
DA_DV = DA_WIDTH // DA_HEADS
DA_DQK = DA_DV // 2
FX_WIDTH = D_MODEL // 4
FX_HEADS = 4
FX_DH = FX_WIDTH // FX_HEADS
MIX_WIDTH = HG_WIDTH + DA_WIDTH + FX_WIDTH
IN_SIZES = (HG_WIDTH, HG_WIDTH, HG_WIDTH, HG_WIDTH,
            DA_WIDTH, DA_WIDTH, DA_WIDTH,
            FX_WIDTH, FX_WIDTH, FX_WIDTH, FX_HEADS)
IN_WIDTH = sum(IN_SIZES)
N_GROUPS = 4
EXPERTS_PER_GROUP = 8
N_EXPERTS = N_GROUPS * EXPERTS_PER_GROUP
TOP_K = 2
D_EXPERT = D_MODEL // 2
MOE_BLOCK = 128
ROPE_THETA = 10000.0
EPS = 1e-6
NEG = -1e30
TINY = 1e-30

kernel_name = "hymba_hgrn2_diff_fox_hmoe"


def _rmsnorm(x, g):
    x32 = x.astype(jnp.float32)
    y = x32 * lax.rsqrt(jnp.mean(x32 * x32, axis=-1, keepdims=True) + EPS)
    return (y * g.astype(jnp.float32)).astype(x.dtype)


def _rope(x, pos):
    d = x.shape[-1]
    inv = ROPE_THETA ** (-jnp.arange(0, d, 2, dtype=jnp.float32) / d)
    ang = pos.astype(jnp.float32)[:, None] * inv[None, :]
    cos, sin = jnp.cos(ang), jnp.sin(ang)
    x32 = x.astype(jnp.float32)
    x1, x2 = x32[..., : d // 2], x32[..., d // 2:]
    return jnp.concatenate([x1 * cos - x2 * sin, x2 * cos + x1 * sin], axis=-1).astype(x.dtype)


def _to_heads(t, n):
    b, l, _ = t.shape
    return t.reshape(b, l, n, -1).transpose(0, 2, 1, 3)


def _hgrn2(q, fz, i, g, lb, gain, valid):
    b, l, _ = q.shape
    f32 = jnp.float32
    z = fz.astype(f32)
    lb = lb.astype(f32)
    sig = jax.nn.sigmoid(z)
    f = lb + (1.0 - lb) * sig
    log_f = jnp.log(jnp.maximum(f, TINY))
    k = (1.0 - lb) * (1.0 - sig)
    m = valid[None, :, None]
    log_f = jnp.where(m, log_f, 0.0)
    k = jnp.where(m, k, 0.0)
    qs = jax.nn.silu(q.astype(f32)) * (HG_DK ** -0.5)
    n_chunks = l // HG_CHUNK

    def chunks(t):
        return _to_heads(t, HG_HEADS).reshape(b, HG_HEADS, n_chunks, HG_CHUNK, -1).transpose(2, 0, 1, 3, 4)

    qc, kc, vc, gc = chunks(qs), chunks(k), chunks(i.astype(f32)), chunks(log_f)
    causal = jnp.tril(jnp.ones((HG_CHUNK, HG_CHUNK), dtype=bool))[:, :, None]

    def step(S, inp):
        qt, kt, vt, gt = inp
        G = jnp.cumsum(gt, axis=-2)
        o_inter = jnp.einsum('bhtk,bhkv->bhtv', qt * jnp.exp(G), S)
        rel = jnp.where(causal, G[:, :, :, None, :] - G[:, :, None, :, :], 0.0)
        decay = jnp.where(causal, jnp.exp(rel), 0.0)
        A = jnp.einsum('bhtk,bhsk,bhtsk->bhts', qt, kt, decay)
        o = o_inter + jnp.einsum('bhts,bhsv->bhtv', A, vt)
        G_last = G[:, :, -1:, :]
        S = jnp.exp(G_last[:, :, 0, :, None]) * S + jnp.einsum('bhsk,bhsv->bhkv', kt * jnp.exp(G_last - G), vt)
        return S, o

    S0 = jnp.zeros((b, HG_HEADS, HG_DK, HG_DV), f32)
    _, o = lax.scan(step, S0, (qc, kc, vc, gc))
    o = o.transpose(1, 0, 3, 2, 4).reshape(b, l, HG_HEADS, HG_DV).astype(q.dtype)
    o = _rmsnorm(o, gain) * jax.nn.silu(g).reshape(b, l, HG_HEADS, HG_DV)
    return o.reshape(b, l, HG_WIDTH)


def _diff_attn(q, k, v, lam_vecs, gain, lam_init, pos, valid):
    b, l, _ = q.shape
    nb = l // BLOCK_Q
    q = _rope(_to_heads(q, 2 * DA_HEADS), pos).reshape(b, DA_HEADS, 2, l, DA_DQK)
    k = _rope(_to_heads(k, 2 * DA_HEADS), pos).reshape(b, DA_HEADS, 2, l, DA_DQK)
    v = _to_heads(v, DA_HEADS)
    lv = lam_vecs.astype(jnp.float32)
    lam = jnp.exp(jnp.sum(lv[0] * lv[1])) - jnp.exp(jnp.sum(lv[2] * lv[3])) + lam_init
    qb = q.reshape(b, DA_HEADS, 2, nb, BLOCK_Q, DA_DQK).transpose(3, 0, 1, 2, 4, 5)
    key_idx = jnp.arange(l)
    scale = DA_DQK ** -0.5

    def block(args):
        qi, bi = args
        s = jnp.einsum('bhcqd,bhckd->bhcqk', qi, k).astype(jnp.float32) * scale
        q_idx = bi * BLOCK_Q + jnp.arange(BLOCK_Q)
        mask = (key_idx[None, :] <= q_idx[:, None]) & valid[None, :]
        p = jax.nn.softmax(jnp.where(mask, s, NEG), axis=-1)
        w = (p[:, :, 0] - lam * p[:, :, 1]).astype(v.dtype)
        return jnp.einsum('bhqk,bhkv->bhqv', w, v)

    o = lax.map(block, (qb, jnp.arange(nb)))
    o = o.transpose(1, 0, 3, 2, 4).reshape(b, l, DA_HEADS, DA_DV)
    o = _rmsnorm(o, gain) * (1.0 - lam_init)
    return o.reshape(b, l, DA_WIDTH)


def _fox_attn(q, k, v, fz, bias, gain, valid):
    b, l, _ = q.shape
    nb = l // BLOCK_Q
    q, k, v = _to_heads(q, FX_HEADS), _to_heads(k, FX_HEADS), _to_heads(v, FX_HEADS)
    log_f = jax.nn.log_sigmoid(fz.astype(jnp.float32) + bias.astype(jnp.float32))
    D = jnp.cumsum(log_f, axis=1).transpose(0, 2, 1)
    qb = q.reshape(b, FX_HEADS, nb, BLOCK_Q, FX_DH).transpose(2, 0, 1, 3, 4)
    db = D.reshape(b, FX_HEADS, nb, BLOCK_Q).transpose(2, 0, 1, 3)
    key_idx = jnp.arange(l)
    scale = FX_DH ** -0.5

    def block(args):
        qi, di, bi = args
        s = jnp.einsum('bhqd,bhkd->bhqk', qi, k).astype(jnp.float32) * scale
        s = s + di[..., :, None] - D[:, :, None, :]
        q_idx = bi * BLOCK_Q + jnp.arange(BLOCK_Q)
        mask = (key_idx[None, :] <= q_idx[:, None]) & valid[None, :]
        p = jax.nn.softmax(jnp.where(mask, s, NEG), axis=-1).astype(v.dtype)
        return jnp.einsum('bhqk,bhkv->bhqv', p, v)

    o = lax.map(block, (qb, db, jnp.arange(nb)))
    o = o.transpose(1, 0, 3, 2, 4).reshape(b, l, FX_HEADS, FX_DH)
    return _rmsnorm(o, gain).reshape(b, l, FX_WIDTH)


def _hier_moe(u, w_group, b_group, w_router, b_router, w1, w3, w2):
    b, l, d = u.shape
    n = b * l
    h = u.reshape(n, d)
    g_logits = (h @ w_group).astype(jnp.float32) + b_group.astype(jnp.float32)
    p_group = jax.nn.softmax(g_logits, axis=-1)
    g_sel = jnp.argmax(g_logits, axis=-1)
    p_gsel = jnp.take_along_axis(p_group, g_sel[:, None], axis=1)
    e_logits = ((h @ w_router).astype(jnp.float32) + b_router.astype(jnp.float32)).reshape(n, N_GROUPS, EXPERTS_PER_GROUP)
    e_in = jnp.take_along_axis(e_logits, g_sel[:, None, None], axis=1)[:, 0]
    top_p, top_i = lax.top_k(jax.nn.softmax(e_in, axis=-1), TOP_K)
    gate = p_gsel * top_p / jnp.sum(top_p, axis=-1, keepdims=True)
    expert = g_sel[:, None] * EXPERTS_PER_GROUP + top_i

    a = n * TOP_K
    e_flat = expert.reshape(a).astype(jnp.int32)
    t_flat = jnp.repeat(jnp.arange(n, dtype=jnp.int32), TOP_K)
    w_flat = gate.reshape(a)
    order = jnp.argsort(e_flat)
    e_s, t_s, w_s = e_flat[order], t_flat[order], w_flat[order]
    counts = jnp.bincount(e_flat, length=N_EXPERTS)
    padded = (counts + MOE_BLOCK - 1) // MOE_BLOCK * MOE_BLOCK
    start = jnp.cumsum(counts) - counts
    p_end = jnp.cumsum(padded)
    p_start = p_end - padded
    dest = p_start[e_s] + jnp.arange(a, dtype=jnp.int32) - start[e_s]
    p_rows = ((a + MOE_BLOCK - 1) // MOE_BLOCK + N_EXPERTS) * MOE_BLOCK
    tok_buf = jnp.full((p_rows,), n, dtype=jnp.int32).at[dest].set(t_s)
    w_buf = jnp.zeros((p_rows,), jnp.float32).at[dest].set(w_s)
    n_blocks = p_rows // MOE_BLOCK
    blk_expert = jnp.minimum(jnp.searchsorted(p_end, jnp.arange(n_blocks, dtype=jnp.int32) * MOE_BLOCK, side='right'), N_EXPERTS - 1)
    x_pad = jnp.concatenate([h, jnp.zeros((1, d), h.dtype)], axis=0)

    def run(args):
        tok, e = args
        xb = x_pad[tok]
        return (jax.nn.silu(xb @ w1[e]) * (xb @ w3[e])) @ w2[e]

    y = lax.map(run, (tok_buf.reshape(n_blocks, MOE_BLOCK), blk_expert))
    out = jnp.zeros((n + 1, d), h.dtype).at[tok_buf].add(y.reshape(p_rows, d) * w_buf[:, None].astype(h.dtype))
    return out[:n].reshape(b, l, d)


def setup_inputs(seed: int = 0) -> dict:
    key = jax.random.key(seed)
    ks = jax.random.split(key, 20)
    nrm = jax.random.normal
    f32 = jnp.float32
    return {
        "x": nrm(ks[0], (BATCH, SEQ, D_MODEL), f32),
        "meta_tokens": nrm(ks[1], (N_META, D_MODEL), f32),
        "norm_mix": 1.0 + 0.02 * nrm(ks[2], (DEPTH, D_MODEL), f32),
        "w_in": nrm(ks[3], (DEPTH, D_MODEL, IN_WIDTH), f32) * D_MODEL ** -0.5,
        "hgrn_lb": 0.5 * nrm(ks[4], (DEPTH, HG_WIDTH), f32),
        "hgrn_norm": 1.0 + 0.02 * nrm(ks[5], (DEPTH, HG_DV), f32),
        "diff_lambda": 0.1 * nrm(ks[6], (DEPTH, 4, DA_DQK), f32),
        "diff_norm": 1.0 + 0.02 * nrm(ks[7], (DEPTH, DA_DV), f32),
        "fox_bias": 3.0 + 0.1 * nrm(ks[8], (DEPTH, FX_HEADS), f32),
        "fox_norm": 1.0 + 0.02 * nrm(ks[9], (DEPTH, FX_DH), f32),
        "w_out": nrm(ks[10], (DEPTH, MIX_WIDTH, D_MODEL), f32) * MIX_WIDTH ** -0.5,
        "norm_ffn": 1.0 + 0.02 * nrm(ks[11], (DEPTH, D_MODEL), f32),
        "w_group": nrm(ks[12], (DEPTH, D_MODEL, N_GROUPS), f32) * D_MODEL ** -0.5,
        "b_group": 0.01 * nrm(ks[13], (DEPTH, N_GROUPS), f32),
        "w_router": nrm(ks[14], (DEPTH, D_MODEL, N_EXPERTS), f32) * D_MODEL ** -0.5,
        "b_router": 0.01 * nrm(ks[15], (DEPTH, N_EXPERTS), f32),
        "w1": nrm(ks[16], (DEPTH, N_EXPERTS, D_MODEL, D_EXPERT), f32) * D_MODEL ** -0.5,
        "w3": nrm(ks[17], (DEPTH, N_EXPERTS, D_MODEL, D_EXPERT), f32) * D_MODEL ** -0.5,
        "w2": nrm(ks[18], (DEPTH, N_EXPERTS, D_EXPERT, D_MODEL), f32) * D_EXPERT ** -0.5,
        "norm_final": 1.0 + 0.02 * nrm(ks[19], (D_MODEL,), f32),
    }


def reference(x, meta_tokens, norm_mix, w_in, hgrn_lb, hgrn_norm, diff_lambda, diff_norm,
              fox_bias, fox_norm, w_out, norm_ffn, w_group, b_group, w_router, b_router,
              w1, w3, w2, norm_final):
    b = x.shape[0]
    pad = jnp.zeros((b, PAD, D_MODEL), x.dtype)
    meta = jnp.broadcast_to(meta_tokens.astype(x.dtype)[None], (b, N_META, D_MODEL))
    h = jnp.concatenate([pad, meta, x], axis=1)
    l = h.shape[1]
    idx = jnp.arange(l)
    pos = idx - PAD
    valid = idx >= PAD
    s_lb = jax.nn.softmax(hgrn_lb.astype(jnp.float32), axis=0)
    lb_all = jnp.cumsum(s_lb, axis=0) - s_lb[0]
    split_at = np.cumsum(IN_SIZES)[:-1].tolist()
    for layer in range(DEPTH):
        u = _rmsnorm(h, norm_mix[layer])
        proj = u @ w_in[layer]
        hq, hf, hi, hg, dq, dk, dv, fq, fk, fv, ff = jnp.split(proj, split_at, axis=-1)
        lam_init = 0.8 - 0.6 * math.exp(-0.3 * layer)
        o_a = _hgrn2(hq, hf, hi, hg, lb_all[layer], hgrn_norm[layer], valid)
        o_b = _diff_attn(dq, dk, dv, diff_lambda[layer], diff_norm[layer], lam_init, pos, valid)
        o_c = _fox_attn(fq, fk, fv, ff, fox_bias[layer], fox_norm[layer], valid)
        h = h + jnp.concatenate([o_a, o_b, o_c], axis=-1) @ w_out[layer]
        u = _rmsnorm(h, norm_ffn[layer])
        h = h + _hier_moe(u, w_group[layer], b_group[layer], w_router[layer], b_router[layer],
                          w1[layer], w3[layer], w2[layer])
    h = _rmsnorm(h, norm_final)
    return h[:, PAD + N_META:]
```

```cpp
#include <hip/hip_runtime.h>
#include <cstdio>
#include <cstdint>

#define GAS __attribute__((address_space(1)))
#define LAS __attribute__((address_space(3)))
typedef unsigned short bf16;
typedef float f32x4 __attribute__((ext_vector_type(4)));
typedef float f32x2 __attribute__((ext_vector_type(2)));
typedef unsigned u32x4 __attribute__((ext_vector_type(4)));
typedef unsigned u32x2 __attribute__((ext_vector_type(2)));

__device__ __forceinline__ __amdgpu_buffer_rsrc_t wt_rsrc(const void* base) { return __builtin_amdgcn_make_buffer_rsrc((void*)base, (short)0, 0x7FFFFFFF, 0x00020000); }
__device__ __forceinline__ void st_wt(const void* base, const void* p, u32x4 v) { __builtin_amdgcn_raw_buffer_store_b128(v, wt_rsrc(base), (int)((const char*)p - (const char*)base), 0, 16); }
__device__ __forceinline__ void st_wt(const void* base, const void* p, float v) { __builtin_amdgcn_raw_buffer_store_b32(__builtin_bit_cast(unsigned, v), wt_rsrc(base), (int)((const char*)p - (const char*)base), 0, 16); }
__device__ __forceinline__ void st_wt(const void* base, const void* p, unsigned short v) { __builtin_amdgcn_raw_buffer_store_b16(v, wt_rsrc(base), (int)((const char*)p - (const char*)base), 0, 16); }

#ifndef MK_NAIVE_GEMM
#define MK_NAIVE_GEMM 0
#endif
#if MK_NAIVE_GEMM
#define GEMM1 gemm1_naive
#define GEMM2 gemm2_naive
#define MOEUP moe_up_naive
#define MOEDOWN moe_down_naive
#else
#define GEMM1 gemm1_mfma
#define GEMM2 gemm2_mfma
#define MOEUP moe_up_mfma
#define MOEDOWN moe_down_mfma
#endif
#ifndef MK_NAIVE_ATTN
#define MK_NAIVE_ATTN 0
#endif
#if MK_NAIVE_ATTN
#define ATTN(F, layer) attn_naive(F, layer, F.blk - 2, F.G - 2, LSEQ / 64)
#else
#define ATTN(F, layer) do { attn_naive(F, layer, F.blk - 2, F.G - 2, 2); attn_queue(F, layer); } while (0)
#endif
#ifndef MK_ONE_LAUNCH
#define MK_ONE_LAUNCH 1
#endif

constexpr int BATCH = 2, SEQ = 8192, DM = 1024, LSEQ = 8320, PADR = 112, M = BATCH * LSEQ;
constexpr int INW = 3588, NEXP = 32, DE = 512, MAXSLOT = 41472;
constexpr float EPS = 1e-6f, LOG2E = 1.4426950408889634f, TINYF = 1e-30f;
constexpr int NPH = 19;

constexpr size_t MiB = 1u << 20;
constexpr size_t WS_CTL = 0, CTL_ZERO_BYTES = 1 * MiB;
constexpr size_t WS_COS = 1 * MiB, WS_SIN = 2 * MiB, WS_LBV = 3 * MiB;
constexpr size_t WS_FLS = 4 * MiB, WS_FD2 = 4 * MiB + 512 * 1024;
constexpr size_t WS_TOKE = 5 * MiB, WS_TOKG = WS_TOKE + 160 * 1024, WS_TOKR = WS_TOKG + 160 * 1024, WS_TOKS = WS_TOKR + 160 * 1024, WS_SGATE = WS_TOKS + 160 * 1024;
constexpr size_t WS_H = 6 * MiB;
constexpr size_t WS_XN = 71 * MiB;
constexpr size_t WS_MIX = WS_XN;
constexpr size_t WS_R = 104 * MiB;
constexpr size_t SZ512 = (size_t)M * 512 * 2, SZ256 = (size_t)M * 256 * 2;
constexpr size_t WS_HQ = WS_R, WS_HLF = WS_HQ + SZ512, WS_HK = WS_HLF + 2 * SZ512, WS_HV = WS_HK + SZ512, WS_HG = WS_HV + SZ512;
constexpr size_t WS_DQ = WS_HG + SZ512, WS_DK = WS_DQ + SZ256, WS_DV = WS_DK + SZ256, WS_FQ = WS_DV + SZ256, WS_FK = WS_FQ + SZ256, WS_FV = WS_FK + SZ256;
constexpr size_t WS_PROJ_END = WS_FV + SZ256;
constexpr size_t WS_ORAW = 251 * MiB;
constexpr size_t WS_XG = WS_R, WS_HB = WS_XG + (size_t)MAXSLOT * 1024 * 2, WS_Y = WS_HB + (size_t)MAXSLOT * 512 * 2, WS_MOE_END = WS_Y + (size_t)MAXSLOT * 1024 * 2;
constexpr size_t WS_REND = 316 * MiB;
constexpr size_t WS_WIN = 316 * MiB;
constexpr size_t WS_WOUT = 330 * MiB;
constexpr size_t WS_W13 = 334 * MiB;
constexpr size_t WS_W2 = 398 * MiB;
constexpr size_t WS_KXF = 462 * MiB, WS_KXD = 463 * MiB + 512 * 1024;
constexpr size_t WS_DEC = 464 * MiB;
constexpr size_t WS_UT = WS_ORAW, WS_ST = WS_ORAW + (size_t)1040 * 16384 * 2;
constexpr size_t WS_WRT = 465 * MiB;
constexpr size_t WS_WF = 465 * MiB + 512 * 1024;
constexpr size_t WS_LIST = 466 * MiB, WS_GLIST = 469 * MiB;
constexpr size_t WS_END = 472 * MiB;
static_assert(WS_PROJ_END <= WS_ORAW && WS_ORAW + (size_t)M * 512 * 4 <= WS_REND && WS_MOE_END <= WS_REND, "ws map");
static_assert(WS_SGATE + MAXSLOT * 4 <= WS_H, "ws map small");

constexpr int CW_TMO = 0, CW_BAR = 4096, CW_CNT = 8192, CW_QATT = 8448, CW_HG = 8704;

constexpr int LDS_BYTES = 147456;
constexpr int MISC_OFF = 131072 + 320;

__device__ __forceinline__ unsigned f2bf(float f) { unsigned u = __builtin_bit_cast(unsigned, f); return (u + 0x7fffu + ((u >> 16) & 1u)) >> 16; }
__device__ __forceinline__ unsigned pk2(float lo, float hi) { return f2bf(lo) | (f2bf(hi) << 16); }
__device__ __forceinline__ float bf2f(unsigned h) { return __builtin_bit_cast(float, h << 16); }
__device__ __forceinline__ float bflo(unsigned w) { return __builtin_bit_cast(float, w << 16); }
__device__ __forceinline__ float bfhi(unsigned w) { return __builtin_bit_cast(float, w & 0xffff0000u); }
__device__ __forceinline__ float wave_sum(float v) {
#pragma unroll
    for (int o = 1; o < 64; o <<= 1) v += __shfl_xor(v, o);
    return v;
}
__device__ __forceinline__ float sigmoidf_(float x) { return 1.f / (1.f + __expf(-x)); }
__device__ __forceinline__ float siluf_(float x) { return x / (1.f + __expf(-x)); }

#define XB_TMO      128
#define XB_XCNT(j)  (256  + 64 * (j))
#define XB_XSUB(j)  (1280 + 64 * (j))
#define XB_XGEN(j)  (2304 + 64 * (j))
#define XB_TOP      3328
#define XB_TOPGEN   3392
#define XCD_BAR_WORDS 3456
#define XB_SPIN_CAP (1u << 20)

__device__ __forceinline__ unsigned xb_ld(unsigned* p)              { return __hip_atomic_load(p, __ATOMIC_RELAXED, __HIP_MEMORY_SCOPE_AGENT); }
__device__ __forceinline__ unsigned xb_add(unsigned* p, unsigned v) { return __hip_atomic_fetch_add(p, v, __ATOMIC_RELAXED, __HIP_MEMORY_SCOPE_AGENT); }
__device__ __forceinline__ unsigned xb_xcc_id() { return (unsigned)__builtin_amdgcn_s_getreg((3 << 11) | 20) & 0xFu; }
#define XB_SPIN(cond, bar) do { unsigned _sp = 0; while (cond) { __builtin_amdgcn_s_sleep(1); \
    if ((++_sp & 255u) == 0u) { if (xb_ld(&(bar)[XB_TMO])) break; if (_sp > XB_SPIN_CAP) { atomicAdd(&(bar)[XB_TMO], 1u); break; } } } } while (0)

struct XcdBarrier {
    unsigned* bar; unsigned x;
    volatile LAS unsigned* st;
};
__device__ __forceinline__ XcdBarrier xcd_barrier_post(unsigned* bar, volatile LAS unsigned* st) {
    XcdBarrier b; b.bar = bar; b.x = xb_xcc_id(); b.st = st;
    if (threadIdx.x == 0) (void)xb_add(&bar[XB_XCNT(b.x)], 1u);
    return b;
}
__device__ __forceinline__ void xcd_barrier_complete(unsigned* bar, unsigned x, unsigned& nloc, unsigned& nx) {
    const unsigned G = gridDim.x * gridDim.y * gridDim.z;
    unsigned sum, cnt, mine, sp = 0u;
    for (;;) {
        sum = 0u; cnt = 0u; mine = 0u;
#pragma unroll
        for (unsigned j = 0; j < 16; ++j) { const unsigned c = xb_ld(&bar[XB_XCNT(j)]); sum += c; cnt += (c > 0u) ? 1u : 0u; mine = (j == x) ? c : mine; }
        if (sum == G) break;
        __builtin_amdgcn_s_sleep(1);
        if ((++sp & 255u) == 0u) { if (xb_ld(&bar[XB_TMO])) break; if (sp > XB_SPIN_CAP) { atomicAdd(&bar[XB_TMO], 1u); break; } }
    }
    nloc = mine > 0u ? mine : 1u; nx = cnt > 0u ? cnt : 1u;
}
__device__ __forceinline__ void xcd_barrier(const XcdBarrier& b) {
    asm volatile("s_waitcnt vmcnt(0)" ::: "memory");
    __syncthreads();
    if (threadIdx.x == 0) {
        unsigned* bar = b.bar;
        __builtin_amdgcn_s_waitcnt(0);
        unsigned nloc = b.st[0], nx = b.st[1];
        if (nloc == 0u) { xcd_barrier_complete(bar, b.x, nloc, nx); b.st[0] = nloc; b.st[1] = nx; }
        const unsigned old = xb_add(&bar[XB_XSUB(b.x)], 1u);
        const unsigned gen = old / nloc;
        if (old + 1u == (gen + 1u) * nloc) {
            __builtin_amdgcn_fence(__ATOMIC_RELEASE, "agent");
            asm volatile("s_waitcnt vmcnt(0)" ::: "memory");
            const unsigned og = xb_add(&bar[XB_TOP], 1u);
            const unsigned tg = og / nx;
            if (og + 1u == (tg + 1u) * nx) xb_add(&bar[XB_TOPGEN], 1u);
            else XB_SPIN(xb_ld(&bar[XB_TOPGEN]) == tg, bar);
            __builtin_amdgcn_fence(__ATOMIC_ACQUIRE, "agent");
            xb_add(&bar[XB_XGEN(b.x)], 1u);
            asm volatile("s_waitcnt vmcnt(0)" ::: "memory");
        } else {
            XB_SPIN(xb_ld(&bar[XB_XGEN(b.x)]) == gen, bar);
            __builtin_amdgcn_fence(__ATOMIC_ACQUIRE, "agent");
            asm volatile("s_waitcnt vmcnt(0)" ::: "memory");
        }
    }
    __syncthreads();
}

struct Args { const float* in[20]; float* out; unsigned char* ws; int ph_lo, ph_hi; };
struct Frame {
    LAS unsigned char* lds;
    unsigned char* ws;
    float* out;
    int tid, lane, wave, G, blk;
    const float* const* in;
};
#define WSP(T, off) ((T*)(F.ws + (off)))

namespace pg8 {
#define PG8_LAS __attribute__((address_space(3)))
typedef unsigned short bf16_t;
typedef short bf16x8 __attribute__((ext_vector_type(8)));
typedef float f32x4 __attribute__((ext_vector_type(4)));
typedef unsigned u32x4 __attribute__((ext_vector_type(4)));
constexpr int BM = 256, BK = 64, HALF = 128, HTB = HALF * BK * 2  , STAGE_BYTES = 8 * HTB, NXCD = 8, WGM = 8;

__host__ __device__ __forceinline__ int lds_byte(int r, int c) { const int st = (r >> 4) * 2 + (c >> 5), rr = r & 15, cc = c & 31, ob = rr * 64 + cc * 2; return st * 1024 + (ob ^ (((ob >> 9) & 1) << 5)); }
__host__ __device__ __forceinline__ void stage_rc(int b, int& R, int& C) { const int st = b / 1024, sb = b % 1024, swz = sb ^ (((sb >> 9) & 1) << 5); R = (st >> 1) * 16 + swz / 64; C = (st & 1) * 32 + (swz % 64) / 2; }
__host__ __device__ __forceinline__ int perm32(int rho) { const int n = rho >> 4, i = rho & 15; return 8 * (i >> 2) + 4 * n + (i & 3); }

struct Unit { int pm, pn; };
struct Gemm { const bf16_t* A; const bf16_t* Bt; int M, N, K; };

struct StaticOrder {
    static constexpr bool GATHER = false;
    __device__ __forceinline__ unsigned goff(const Unit&, int, int) const { return 0u; }
    int nM, nN, nwg, G, c;
    __host__ __device__ void init(int M, int N, int G_, int c_) { nM = M / BM; nN = N / BM; nwg = nM * nN; G = G_; c = c_; }
    __host__ __device__ bool next(int i, Unit& u) const {
        const long L = (long)i * G + c; if (L >= nwg) return false;
        int wgid = (int)L; { const int q = nwg / NXCD, r = nwg % NXCD, xcd = wgid % NXCD, off = wgid / NXCD; wgid = (xcd < r ? xcd * (q + 1) : r * (q + 1) + (xcd - r) * q) + off; }
        const int nig = WGM * nN, gid = wgid / nig, fm = gid * WGM, gsz = (nM - fm) < WGM ? (nM - fm) : WGM;
        u.pm = fm + ((wgid % nig) % gsz); u.pn = (wgid % nig) / gsz; return true;
    }
    __device__ __forceinline__ void a_ready(const Unit&) const {}
    __device__ __forceinline__ void done(const Unit&) const {}
};
__device__ __forceinline__ unsigned cvt_pk_bf16(float lo, float hi) { unsigned r; asm volatile("v_cvt_pk_bf16_f32 %0, %1, %2" : "=v"(r) : "v"(lo), "v"(hi)); return r; }
template <class Epi, class Sched, bool ALIGN_EPI = false, bool SP2 = false>
__device__ __forceinline__ void gemm_phase(PG8_LAS unsigned char* lds, const Gemm g, const Sched& S, const Epi& E) {
    const int tid = threadIdx.x, wid = __builtin_amdgcn_readfirstlane(tid >> 6), lane = tid & 63, wr = wid >> 2, wc = wid & 3, fr = lane & 15, fq = lane >> 4;
    const int K = g.K, nt = K / BK;
    constexpr bool GATHER = Sched::GATHER;
    static_assert(!GATHER || SP2, "the gathered A operand is wired into the SP2 loop only");
    unsigned voffA[2], voffB[2]; int gR[2]; unsigned gC2[2];
#pragma unroll
    for (int i = 0; i < 2; ++i) { int R, C; stage_rc(tid * 16 + i * 8192, R, C); const int Rb = Epi::PERM ? ((R & ~31) + perm32(R & 31)) : R;
        voffA[i] = (unsigned)(R * K + C) * 2u; voffB[i] = (unsigned)(Rb * K + C) * 2u; gR[i] = R; gC2[i] = (unsigned)C * 2u; }
    unsigned gCur0[2] = {0u, 0u}, gCur1[2] = {0u, 0u}, gNxt0[2] = {0u, 0u}, gNxt1[2] = {0u, 0u};
#define PG8_GOFF(u, g0, g1) do { _Pragma("unroll") for (int _i = 0; _i < 2; ++_i) { g0[_i] = S.goff(u, gR[_i], K) + gC2[_i]; g1[_i] = S.goff(u, HALF + gR[_i], K) + gC2[_i]; } } while (0)
    const size_t kstep = (size_t)(BK * 2);
    const size_t hstep = (size_t)HALF * K * 2;
    const size_t tstep = 2 * hstep;
    const unsigned ldsw = (unsigned)wid * 1024u;
    const int aoff = lds_byte(wr * 64 + fr, fq * 8), boff = lds_byte(wc * 32 + fr, fq * 8);
#define PG8_SA(b, h) (((b) * 2 + (h)) * HTB)
#define PG8_SB(b, h) ((4 + (b) * 2 + (h)) * HTB)
#define PG8_STAGE(bufoff, gbase, voff) do { _Pragma("unroll") for (int _i = 0; _i < 2; ++_i) \
        __builtin_amdgcn_global_load_lds((const unsigned*)((const char*)(gbase) + (voff)[_i]), (PG8_LAS unsigned*)(lds + (bufoff) + ldsw + _i * 8192), 16, 0, 0); } while (0)
#define PG8_LDA(dst, b, h) do { _Pragma("unroll") for (int m = 0; m < 4; ++m) _Pragma("unroll") for (int k = 0; k < 2; ++k) dst[m][k] = *(const PG8_LAS bf16x8*)(lds + PG8_SA(b, h) + aoff + m * 2048 + k * 1024); } while (0)
#define PG8_LDB(dst, b, h) do { _Pragma("unroll") for (int n = 0; n < 2; ++n) _Pragma("unroll") for (int k = 0; k < 2; ++k) dst[n][k] = *(const PG8_LAS bf16x8*)(lds + PG8_SB(b, h) + boff + n * 2048 + k * 1024); } while (0)
#define PG8_MMA(ai, bj, At, Bt) do { __builtin_amdgcn_s_setprio(1); _Pragma("unroll") for (int m = 0; m < 4; ++m) _Pragma("unroll") for (int n = 0; n < 2; ++n) _Pragma("unroll") for (int k = 0; k < 2; ++k) \
        acc[ai][bj][m][n] = __builtin_amdgcn_mfma_f32_16x16x32_bf16(Bt[n][k], At[m][k], acc[ai][bj][m][n], 0, 0, 0); __builtin_amdgcn_s_setprio(0); } while (0)
#define PG8_WAIT_V(n) asm volatile("s_waitcnt vmcnt(" #n ")" ::: "memory")
#define PG8_WAIT_L(n) asm volatile("s_waitcnt lgkmcnt(" #n ")" ::: "memory")
#define PG8_BAR __builtin_amdgcn_s_barrier()
#define PG8_SCHED __builtin_amdgcn_sched_barrier(0)
    Unit cur, nxt; int ui = 0;
    if (!S.next(0, cur)) return;
    f32x4 acc[2][2][4][2];
#pragma unroll
    for (int a = 0; a < 2; ++a)
#pragma unroll
        for (int b = 0; b < 2; ++b)
#pragma unroll
            for (int m = 0; m < 4; ++m)
#pragma unroll
                for (int n = 0; n < 2; ++n) acc[a][b][m][n] = (f32x4){0.f, 0.f, 0.f, 0.f};
    bf16x8 At[4][2], B0[2][2], B1[2][2];
    const char* cA = (const char*)g.A + (GATHER ? (size_t)0 : (size_t)cur.pm * tstep); const char* cB = (const char*)g.Bt + (size_t)cur.pn * tstep;
    const size_t hsA = GATHER ? (size_t)0 : hstep;
    if constexpr (GATHER) PG8_GOFF(cur, gCur0, gCur1);
    S.a_ready(cur);
    if constexpr (SP2) {
        PG8_STAGE(PG8_SB(0, 0), cB, voffB); PG8_STAGE(PG8_SB(0, 1), cB + hstep, voffB); PG8_STAGE(PG8_SA(0, 0), cA, (GATHER ? gCur0 : voffA)); PG8_STAGE(PG8_SA(0, 1), cA + hsA, (GATHER ? gCur1 : voffA));
        if (wr == 1) PG8_BAR;
        PG8_WAIT_V(2); PG8_BAR;
        PG8_STAGE(PG8_SB(1, 0), cB + kstep, voffB); PG8_STAGE(PG8_SA(1, 0), cA + kstep, (GATHER ? gCur0 : voffA)); PG8_STAGE(PG8_SB(1, 1), cB + hstep + kstep, voffB);
        PG8_WAIT_V(6); PG8_BAR;
    } else {
        PG8_STAGE(PG8_SB(0, 0), cB, voffB); PG8_STAGE(PG8_SA(0, 0), cA, voffA); PG8_STAGE(PG8_SB(0, 1), cB + hstep, voffB); PG8_STAGE(PG8_SA(0, 1), cA + hstep, voffA);
        if (wr == 1) PG8_BAR;
        PG8_WAIT_V(4); PG8_BAR;
        PG8_STAGE(PG8_SB(1, 0), cB + kstep, voffB); PG8_STAGE(PG8_SA(1, 0), cA + kstep, voffA); PG8_STAGE(PG8_SB(1, 1), cB + hstep + kstep, voffB);
        PG8_WAIT_V(6); PG8_BAR;
    }
    for (;;) {
        const bool has_next = S.next(ui + 1, nxt);
        const char* nA = (has_next && !GATHER) ? (const char*)g.A + (size_t)nxt.pm * tstep : cA; const char* nB = has_next ? (const char*)g.Bt + (size_t)nxt.pn * tstep : cB;
        if constexpr (GATHER) { if (has_next) PG8_GOFF(nxt, gNxt0, gNxt1); else { gNxt0[0] = gCur0[0]; gNxt0[1] = gCur0[1]; gNxt1[0] = gCur1[0]; gNxt1[1] = gCur1[1]; } }
        for (int t = 0; t < nt; t += 2) {
            const bool last = (t == nt - 2);
            unsigned gS0[2], gS1[2];
            gS0[0] = last ? gNxt0[0] : gCur0[0]; gS0[1] = last ? gNxt0[1] : gCur0[1]; gS1[0] = last ? gNxt1[0] : gCur1[0]; gS1[1] = last ? gNxt1[1] : gCur1[1];
            const char* a1 = cA + (size_t)(t + 1) * kstep;
            const char* a2 = last ? nA : cA + (size_t)(t + 2) * kstep; const char* b2 = last ? nB : cB + (size_t)(t + 2) * kstep;
            const char* a3 = a2 + kstep; const char* b3 = b2 + kstep;
            if (last && has_next) S.a_ready(nxt);
            if constexpr (SP2) {
            PG8_LDB(B0, 0, 0); PG8_LDB(B1, 0, 1); PG8_SCHED; PG8_LDA(At, 0, 0); PG8_STAGE(PG8_SA(1, 1), a1 + hsA, (GATHER ? gCur1 : voffA));
            PG8_WAIT_V(8); PG8_WAIT_L(0); PG8_BAR; PG8_MMA(0, 0, At, B0); PG8_MMA(0, 1, At, B1); PG8_BAR; PG8_SCHED;
            PG8_LDA(At, 0, 1); PG8_STAGE(PG8_SB(0, 0), b2, voffB); PG8_STAGE(PG8_SB(0, 1), b2 + hstep, voffB); PG8_STAGE(PG8_SA(0, 0), a2, (GATHER ? gS0 : voffA));
            PG8_WAIT_V(8); PG8_WAIT_L(0); PG8_BAR; PG8_MMA(1, 0, At, B0); PG8_MMA(1, 1, At, B1); PG8_BAR; PG8_SCHED;
            PG8_LDB(B0, 1, 0); PG8_LDB(B1, 1, 1); PG8_SCHED; PG8_LDA(At, 1, 0); PG8_STAGE(PG8_SA(0, 1), a2 + hsA, (GATHER ? gS1 : voffA));
            PG8_WAIT_V(8); PG8_WAIT_L(0); PG8_BAR; PG8_MMA(0, 0, At, B0); PG8_MMA(0, 1, At, B1); PG8_BAR; PG8_SCHED;
            PG8_LDA(At, 1, 1); PG8_STAGE(PG8_SB(1, 0), b3, voffB); PG8_STAGE(PG8_SB(1, 1), b3 + hstep, voffB); PG8_STAGE(PG8_SA(1, 0), a3, (GATHER ? gS0 : voffA));
            PG8_WAIT_V(8); PG8_WAIT_L(0); PG8_BAR; PG8_MMA(1, 0, At, B0); PG8_MMA(1, 1, At, B1); PG8_BAR; PG8_SCHED;
            } else {
            PG8_LDB(B0, 0, 0); PG8_SCHED; PG8_LDA(At, 0, 0); PG8_STAGE(PG8_SA(1, 1), a1 + hstep, voffA);
            PG8_WAIT_L(8); PG8_BAR; PG8_WAIT_L(0); PG8_MMA(0, 0, At, B0); PG8_BAR; PG8_SCHED;
            PG8_LDB(B1, 0, 1); PG8_STAGE(PG8_SB(0, 0), b2, voffB);
            PG8_BAR; PG8_WAIT_L(0); PG8_MMA(0, 1, At, B1); PG8_BAR;
            PG8_LDA(At, 0, 1); PG8_STAGE(PG8_SA(0, 0), a2, voffA);
            PG8_BAR; PG8_WAIT_L(0); PG8_MMA(1, 0, At, B0); PG8_BAR; PG8_SCHED;
            PG8_STAGE(PG8_SB(0, 1), b2 + hstep, voffB);
            PG8_WAIT_V(6); PG8_BAR; PG8_MMA(1, 1, At, B1); PG8_BAR;
            PG8_LDB(B0, 1, 0); PG8_SCHED; PG8_LDA(At, 1, 0); PG8_STAGE(PG8_SA(0, 1), a2 + hstep, voffA);
            PG8_WAIT_L(8); PG8_BAR; PG8_WAIT_L(0); PG8_MMA(0, 0, At, B0); PG8_BAR; PG8_SCHED;
            PG8_LDB(B1, 1, 1); PG8_STAGE(PG8_SB(1, 0), b3, voffB);
            PG8_BAR; PG8_WAIT_L(0); PG8_MMA(0, 1, At, B1); PG8_BAR;
            PG8_LDA(At, 1, 1); PG8_STAGE(PG8_SA(1, 0), a3, voffA);
            PG8_BAR; PG8_WAIT_L(0); PG8_MMA(1, 0, At, B0); PG8_BAR; PG8_SCHED;
            PG8_STAGE(PG8_SB(1, 1), b3 + hstep, voffB);
            PG8_WAIT_V(6); PG8_BAR; PG8_MMA(1, 1, At, B1); PG8_BAR;
            }
        }
        if constexpr (ALIGN_EPI) { if (wr == 0) PG8_BAR; }
        if constexpr (!Epi::AFTER_DRAIN) { E(acc, cur, wr, wc, fr, fq); S.done(cur); }
        if (!has_next) break;
#pragma unroll
        for (int a = 0; a < 2; ++a)
#pragma unroll
            for (int b = 0; b < 2; ++b)
#pragma unroll
                for (int m = 0; m < 4; ++m)
#pragma unroll
                    for (int n = 0; n < 2; ++n) acc[a][b][m][n] = (f32x4){0.f, 0.f, 0.f, 0.f};
        cur = nxt; cA = nA; cB = nB; ++ui;
        if constexpr (GATHER) { gCur0[0] = gNxt0[0]; gCur0[1] = gNxt0[1]; gCur1[0] = gNxt1[0]; gCur1[1] = gNxt1[1]; }
        if constexpr (ALIGN_EPI) { if (wr == 1) PG8_BAR; }
    }
    PG8_WAIT_V(0);
    if constexpr (!ALIGN_EPI) { if (wr == 0) PG8_BAR; }
    PG8_BAR;
    if constexpr (Epi::AFTER_DRAIN) { E.fused(acc, cur, wr, wc, fr, fq, lds, wid, lane); S.done(cur); }
#undef PG8_GOFF
#undef PG8_SA
#undef PG8_SB
#undef PG8_STAGE
#undef PG8_LDA
#undef PG8_LDB
#undef PG8_MMA
#undef PG8_WAIT_V
#undef PG8_WAIT_L
#undef PG8_BAR
#undef PG8_SCHED
}
}

__device__ __forceinline__ void prologue_tables(const Frame& F) {
    const int gt = F.blk * 512 + F.tid, NT = F.G * 512;
    float* COS = WSP(float, WS_COS); float* SIN = WSP(float, WS_SIN); float* LBV = WSP(float, WS_LBV);
    for (int i = gt; i < LSEQ * 16; i += NT) {
        const int t = i >> 4, j = i & 15;
        const float inv = powf(10000.f, -(float)(2 * j) / 32.f);
        const float ang = (float)(t - PADR) * inv;
        const double a = (double)ang; const double n = rint(a * 0.15915494309189535); const float r = (float)(a - n * 6.283185307179586);
        COS[i] = cosf(r); SIN[i] = sinf(r);
    }
    { u32x4* KXD = WSP(u32x4, WS_KXD); for (int i = gt; i < LSEQ; i += NT) KXD[i] = (u32x4){i < PADR ? 0x7F00u : 0u, 0u, 0u, 0u}; }
    { bf16* WRT = WSP(bf16, WS_WRT); float* WF = WSP(float, WS_WF);
      for (int i = gt; i < 2 * 48 * 1024; i += NT) { const int l = i / (48 * 1024), r = i % (48 * 1024), col = r >> 10, k = r & 1023;
          float w = 0.f; if (col < 4) w = F.in[12][((size_t)l * DM + k) * 4 + col]; else if (col < 36) w = F.in[14][((size_t)l * DM + k) * 32 + (col - 4)];
          const unsigned hb = f2bf(w), lb2 = f2bf(w - bf2f(hb));
          WRT[(size_t)(l * 2 + 0) * 48 * 1024 + r] = (bf16)hb; WRT[(size_t)(l * 2 + 1) * 48 * 1024 + r] = (bf16)lb2; }
      for (int i = gt; i < 2 * 1024 * 4; i += NT) { const int l = i >> 12, r = i & 4095, k = r >> 2, q = r & 3; WF[i] = F.in[3][((size_t)l * DM + k) * INW + 3584 + q]; } }
    const float* lbp = F.in[4];
    for (int i = gt; i < 1024; i += NT) { const int l = i >> 9, c = i & 511; LBV[i] = l == 0 ? 0.f : sigmoidf_(lbp[512 + c] - lbp[c]); }
}

__device__ __forceinline__ void moe_tile_bases(const Frame& F, int layer, LAS int* tb);
template <int MODE> __device__ __forceinline__ void norm_phase(const Frame& F, int layer) {
    const int gw = F.blk * 8 + F.wave, NGW = F.G * 8, lane = F.lane;
    float* H = WSP(float, WS_H); bf16* XN = WSP(bf16, WS_XN); const bf16* Y = WSP(bf16, WS_Y); const int* TOKE = WSP(int, WS_TOKE); const int* TOKR = WSP(int, WS_TOKR); float* FLS = WSP(float, WS_FLS);
    LAS int* tbs = (LAS int*)(F.lds + 131072);
    const float* gain = (MODE == 2) ? F.in[19] : F.in[2] + layer * DM;
    const float* fb = F.in[8] + layer * 4;
    LAS f32x4* sWF = (LAS f32x4*)F.lds;
    if (MODE != 2) { const float* win = F.in[3] + (size_t)layer * DM * INW + 3584;
        for (int i = F.tid; i < 1024; i += 512) sWF[i] = *(const f32x4*)(win + (size_t)i * INW); __syncthreads(); }
#define NP_LOAD(mm, vv) do { const int b_ = (mm) / LSEQ, t_ = (mm) % LSEQ; \
        if (MODE == 0) { _Pragma("unroll") for (int j = 0; j < 4; ++j) { const int col = 4 * lane + 256 * j; \
                if (t_ < PADR) vv[j] = (f32x4){0.f, 0.f, 0.f, 0.f}; \
                else if (t_ < 128) vv[j] = *(const f32x4*)(F.in[1] + (size_t)(t_ - PADR) * DM + col); \
                else vv[j] = *(const f32x4*)(F.in[0] + ((size_t)b_ * SEQ + (t_ - 128)) * DM + col); } } \
        else { const int s0 = 256 * tbs[TOKE[2 * (mm)]] + TOKR[2 * (mm)], s1 = 256 * tbs[TOKE[2 * (mm) + 1]] + TOKR[2 * (mm) + 1]; \
            _Pragma("unroll") for (int j = 0; j < 4; ++j) { const int col = 4 * lane + 256 * j; \
                const f32x4 hv = *(const f32x4*)(H + (size_t)(mm) * DM + col); \
                const u32x2 y0 = *(const u32x2*)(Y + (size_t)s0 * DM + col), y1 = *(const u32x2*)(Y + (size_t)s1 * DM + col); \
                vv[j].x = hv.x + bflo(y0.x) + bflo(y1.x); vv[j].y = hv.y + bfhi(y0.x) + bfhi(y1.x); \
                vv[j].z = hv.z + bflo(y0.y) + bflo(y1.y); vv[j].w = hv.w + bfhi(y0.y) + bfhi(y1.y); } } } while (0)
    f32x4 v[4], vn[4];
#pragma unroll
    for (int j = 0; j < 4; ++j) { v[j] = (f32x4){0.f, 0.f, 0.f, 0.f}; vn[j] = v[j]; }
    if (gw < M) NP_LOAD(gw, v);
#pragma unroll 1
    for (int m = gw; m < M; m += NGW) {
        const int b = m / LSEQ, t = m % LSEQ;
        if (m + NGW < M) NP_LOAD(m + NGW, vn);
        float ss = 0.f;
#pragma unroll
        for (int j = 0; j < 4; ++j) ss += (v[j].x * v[j].x + v[j].y * v[j].y) + (v[j].z * v[j].z + v[j].w * v[j].w);
        ss = wave_sum(ss);
        const float r = rsqrtf(ss * (1.f / DM) + EPS);
        if (MODE != 2) {
            float fa[4] = {0.f, 0.f, 0.f, 0.f};
#pragma unroll
            for (int j = 0; j < 4; ++j) {
                const int col = 4 * lane + 256 * j;
                if (MODE != 0) *(f32x4*)(H + (size_t)m * DM + col) = v[j];
                const f32x4 g = *(const f32x4*)(gain + col);
                const f32x4 u = v[j] * r * g;
                u32x2 o; o.x = pk2(u.x, u.y); o.y = pk2(u.z, u.w);
                *(u32x2*)(XN + (size_t)m * DM + col) = o;
#pragma unroll
                for (int q = 0; q < 4; ++q) {
                    const f32x4 w = sWF[col + q];
                    const float uq = u[q];
                    fa[0] += uq * w.x; fa[1] += uq * w.y; fa[2] += uq * w.z; fa[3] += uq * w.w;
                }
            }
#pragma unroll
            for (int q = 0; q < 4; ++q) fa[q] = wave_sum(fa[q]);
            if (lane < 4) {
                const float z = (lane == 0 ? fa[0] : lane == 1 ? fa[1] : lane == 2 ? fa[2] : fa[3]) + fb[lane];
                FLS[(size_t)m * 4 + lane] = fminf(z, 0.f) - log1pf(__expf(-fabsf(z)));
            }
        } else {
            if (t >= 128) {
                float* orow = F.out + ((size_t)b * SEQ + (t - 128)) * DM;
#pragma unroll
                for (int j = 0; j < 4; ++j) {
                    const int col = 4 * lane + 256 * j;
                    const f32x4 g = *(const f32x4*)(gain + col);
                    __builtin_nontemporal_store(v[j] * r * g, (f32x4*)(orow + col));
                }
            }
        }
#pragma unroll
        for (int j = 0; j < 4; ++j) v[j] = vn[j];
    }
#undef NP_LOAD
    if (MODE != 2) __syncthreads();
}

__device__ __forceinline__ void fd_scan(const Frame& F) {
    const float* FLS = WSP(float, WS_FLS); float* FD2 = WSP(float, WS_FD2); u32x4* KXF = WSP(u32x4, WS_KXF);
    const int bh = F.wave, b = bh >> 2, h = bh & 3, lane = F.lane;
    float carry = 0.f;
#pragma unroll 1
    for (int t0 = 0; t0 < LSEQ; t0 += 512) {
        const int tb = t0 + lane * 8;
        float v[8];
#pragma unroll
        for (int j = 0; j < 8; ++j) v[j] = (tb + j < LSEQ) ? FLS[((size_t)b * LSEQ + tb + j) * 4 + h] : 0.f;
#pragma unroll
        for (int j = 1; j < 8; ++j) v[j] += v[j - 1];
        float tot = v[7], inc = tot;
#pragma unroll
        for (int o = 1; o < 64; o <<= 1) { const float u = __shfl_up(inc, o); if (lane >= o) inc += u; }
        const float base = carry + inc - tot;
#pragma unroll
        for (int j = 0; j < 8; ++j) if (tb + j < LSEQ) { const float d2 = (base + v[j]) * LOG2E; FD2[(size_t)bh * LSEQ + tb + j] = d2;
            const unsigned hb = f2bf(d2), lb = f2bf(d2 - bf2f(hb)); KXF[(size_t)bh * LSEQ + tb + j] = (u32x4){(tb + j) < PADR ? 0x7F00u : (hb | (lb << 16)), 0u, 0u, 0u}; }
        carry += __shfl(inc, 63);
    }
}

template <bool DUAL, class Epi>
__device__ __forceinline__ void ngemm_tile(const Frame& F, const bf16* A, int lda, const float* B, const float* B2, int ldb, int K, int n0, const Epi& epi) {
    LAS float* As = (LAS float*)F.lds;
    LAS float* Bs = As + 16 * 132;
    LAS float* Bs2 = Bs + 16 * 64;
    const int tid = F.tid, tx = tid & 15, ty = tid >> 4;
    float acc[4][4], acc2[4][4];
#pragma unroll
    for (int i = 0; i < 4; ++i)
#pragma unroll
        for (int j = 0; j < 4; ++j) { acc[i][j] = 0.f; acc2[i][j] = 0.f; }
    const int ar = tid >> 2, akq = (tid & 3) * 4, bkr = tid >> 5, bcc = (tid & 31) * 2;
    for (int k0 = 0; k0 < K; k0 += 16) {
        const u32x2 raw = *(const u32x2*)(A + (size_t)ar * lda + k0 + akq);
        const f32x2 bv = *(const f32x2*)(B + (size_t)(k0 + bkr) * ldb + n0 + bcc);
        f32x2 bv2 = (f32x2){0.f, 0.f};
        if (DUAL) bv2 = *(const f32x2*)(B2 + (size_t)(k0 + bkr) * ldb + n0 + bcc);
        As[(akq + 0) * 132 + ar] = bflo(raw.x); As[(akq + 1) * 132 + ar] = bfhi(raw.x); As[(akq + 2) * 132 + ar] = bflo(raw.y); As[(akq + 3) * 132 + ar] = bfhi(raw.y);
        Bs[bkr * 64 + bcc] = bv.x; Bs[bkr * 64 + bcc + 1] = bv.y;
        if (DUAL) { Bs2[bkr * 64 + bcc] = bv2.x; Bs2[bkr * 64 + bcc + 1] = bv2.y; }
        __syncthreads();
#pragma unroll
        for (int k = 0; k < 16; ++k) {
            const f32x4 a = *(const LAS f32x4*)(As + k * 132 + ty * 4);
            float bb[4], bb2[4];
#pragma unroll
            for (int j = 0; j < 4; ++j) { bb[j] = Bs[k * 64 + tx + 16 * j]; if (DUAL) bb2[j] = Bs2[k * 64 + tx + 16 * j]; }
#pragma unroll
            for (int i = 0; i < 4; ++i)
#pragma unroll
                for (int j = 0; j < 4; ++j) { acc[i][j] += a[i] * bb[j]; if (DUAL) acc2[i][j] += a[i] * bb2[j]; }
        }
        __syncthreads();
    }
#pragma unroll
    for (int i = 0; i < 4; ++i) epi(ty * 4 + i, n0 + tx, acc[i], acc2[i]);
}

struct EpiInproj {
    unsigned char* ws; int layer; int m0;
    __device__ __forceinline__ void operator()(int r, int c0, const float (&v)[4], const float (&)[4]) const {
        const int m = m0 + r, t = m % LSEQ; const bool valid = t >= PADR;
        const int reg = c0 >> 8;
        if (reg < 2) { bf16* O = (bf16*)(ws + WS_HQ);
#pragma unroll
            for (int j = 0; j < 4; ++j) O[(size_t)m * 512 + c0 + 16 * j] = (bf16)f2bf(siluf_(v[j]) * 0.08838834764831845f);
        } else if (reg < 4) { float* LF = (float*)(ws + WS_HLF); bf16* KK = (bf16*)(ws + WS_HK); const float* LBV = (const float*)(ws + WS_LBV) + layer * 512;
#pragma unroll
            for (int j = 0; j < 4; ++j) { const int cc = c0 - 512 + 16 * j; const float lb = LBV[cc], sg = sigmoidf_(v[j]);
                const float f = lb + (1.f - lb) * sg; float lf = __logf(fmaxf(f, TINYF)), kk = (1.f - lb) * (1.f - sg);
                if (!valid) { lf = 0.f; kk = 0.f; }
                LF[(size_t)m * 512 + cc] = lf; KK[(size_t)m * 512 + cc] = (bf16)f2bf(kk); }
        } else if (reg < 6) { bf16* O = (bf16*)(ws + WS_HV);
#pragma unroll
            for (int j = 0; j < 4; ++j) O[(size_t)m * 512 + c0 - 1024 + 16 * j] = (bf16)f2bf(v[j]);
        } else if (reg < 8) { bf16* O = (bf16*)(ws + WS_HG);
#pragma unroll
            for (int j = 0; j < 4; ++j) O[(size_t)m * 512 + c0 - 1536 + 16 * j] = (bf16)f2bf(siluf_(v[j]));
        } else if (reg < 10) {
            bf16* O = (bf16*)(ws + (reg == 8 ? WS_DQ : WS_DK)); const int cc = c0 - reg * 256;
            const float sc = reg == 8 ? 0.17677669529663687f * LOG2E : 1.f;
            const int i = cc & 15;
            const float cs = ((const float*)(ws + WS_COS))[t * 16 + i], sn = ((const float*)(ws + WS_SIN))[t * 16 + i];
#pragma unroll
            for (int p = 0; p < 2; ++p) { const float x1 = v[2 * p], x2 = v[2 * p + 1];
                O[(size_t)m * 256 + cc + 32 * p] = (bf16)f2bf((x1 * cs - x2 * sn) * sc);
                O[(size_t)m * 256 + cc + 32 * p + 16] = (bf16)f2bf((x2 * cs + x1 * sn) * sc); }
        } else { const size_t off = reg == 10 ? WS_DV : reg == 11 ? WS_FQ : reg == 12 ? WS_FK : WS_FV; bf16* O = (bf16*)(ws + off);
            const float sc = reg == 11 ? 0.125f * LOG2E : 1.f; const int cc = c0 - reg * 256;
#pragma unroll
            for (int j = 0; j < 4; ++j) O[(size_t)m * 256 + cc + 16 * j] = (bf16)f2bf(v[j] * sc);
        }
    }
};
__device__ __forceinline__ void gemm1_naive(const Frame& F, int layer) {
    const bf16* XN = WSP(bf16, WS_XN); const float* W = F.in[3] + (size_t)layer * DM * INW;
    constexpr int NT = (M / 128) * 56;
    for (int tile = F.blk; tile < NT; tile += F.G) {
        const int rt = tile / 56, ct = tile % 56;
        EpiInproj E{F.ws, layer, rt * 128};
        ngemm_tile<false>(F, XN + (size_t)rt * 128 * DM, DM, W, nullptr, INW, DM, ct * 64, E);
    }
}

__device__ __forceinline__ void hgrn_naive(const Frame& F, int layer, int which) {
    const bf16* HQ = WSP(bf16, WS_HQ); const float* HLF = WSP(float, WS_HLF); const bf16* HK = WSP(bf16, WS_HK); const bf16* HV = WSP(bf16, WS_HV); float* ORAW = WSP(float, WS_ORAW);
    const int grp = F.tid >> 7, v = F.tid & 127, bh = which * 4 + grp, b = bh >> 2, h = bh & 3;
    LAS float* sm = (LAS float*)F.lds;
    float S[128];
#pragma unroll
    for (int k = 0; k < 128; ++k) S[k] = 0.f;
    const size_t base = (size_t)b * LSEQ * 512 + 128 * h + v;
    float nq = bf2f(HQ[base]), nf = __expf(HLF[base]), nk = bf2f(HK[base]), nv = bf2f(HV[base]);
    for (int t = 0; t < LSEQ; ++t) {
        LAS float* bufp = sm + (t & 1) * 1536 + grp * 384;
        bufp[v] = nq; bufp[128 + v] = nf; bufp[256 + v] = nk; const float vt = nv;
        __syncthreads();
        if (t + 1 < LSEQ) { const size_t o = base + (size_t)(t + 1) * 512; nq = bf2f(HQ[o]); nf = __expf(HLF[o]); nk = bf2f(HK[o]); nv = bf2f(HV[o]); }
        float o = 0.f;
#pragma unroll
        for (int k4 = 0; k4 < 32; ++k4) {
            const f32x4 q4 = *(const LAS f32x4*)(bufp + 4 * k4), f4 = *(const LAS f32x4*)(bufp + 128 + 4 * k4), kk4 = *(const LAS f32x4*)(bufp + 256 + 4 * k4);
#pragma unroll
            for (int e = 0; e < 4; ++e) { const int k = 4 * k4 + e; S[k] = f4[e] * S[k] + kk4[e] * vt; o += q4[e] * S[k]; }
        }
        ORAW[base + (size_t)t * 512] = o;
    }
}

template <int DQK>
__device__ __forceinline__ void attn_lane(const float (&q)[DQK], const bf16* Kp, int kpitch, const bf16* Vp, int vpitch, const float* FDrow, float fdq, int t, int smax, float (&o)[64]) {
    float acc[64]; float mx = -INFINITY, l = 0.f;
#pragma unroll
    for (int d = 0; d < 64; ++d) acc[d] = 0.f;
    for (int s = PADR; s <= smax; ++s) {
        const u32x4* kp = (const u32x4*)(Kp + (size_t)s * kpitch);
        float sc = FDrow ? fdq - FDrow[s] : 0.f;
#pragma unroll
        for (int c = 0; c < DQK / 8; ++c) { const u32x4 w = kp[c];
            sc += q[8 * c + 0] * bflo(w.x) + q[8 * c + 1] * bfhi(w.x) + q[8 * c + 2] * bflo(w.y) + q[8 * c + 3] * bfhi(w.y)
                + q[8 * c + 4] * bflo(w.z) + q[8 * c + 5] * bfhi(w.z) + q[8 * c + 6] * bflo(w.w) + q[8 * c + 7] * bfhi(w.w); }
        if (s <= t) {
            if (sc > mx) { const float al = exp2f(mx - sc); l *= al;
#pragma unroll
                for (int d = 0; d < 64; ++d) acc[d] *= al;
                mx = sc; }
            const float p = exp2f(sc - mx); l += p;
            const u32x4* vp = (const u32x4*)(Vp + (size_t)s * vpitch);
#pragma unroll
            for (int c = 0; c < 8; ++c) { const u32x4 w = vp[c];
                acc[8 * c + 0] += p * bflo(w.x); acc[8 * c + 1] += p * bfhi(w.x); acc[8 * c + 2] += p * bflo(w.y); acc[8 * c + 3] += p * bfhi(w.y);
                acc[8 * c + 4] += p * bflo(w.z); acc[8 * c + 5] += p * bfhi(w.z); acc[8 * c + 6] += p * bflo(w.w); acc[8 * c + 7] += p * bfhi(w.w); }
        }
    }
    const float il = l > 0.f ? 1.f / l : 0.f;
#pragma unroll
    for (int d = 0; d < 64; ++d) o[d] = acc[d] * il;
}
__device__ __forceinline__ void attn_naive(const Frame& F, int layer, int vblk, int nblk, int nqb  ) {
    const int lane = F.lane;
    bf16* MIX = WSP(bf16, WS_MIX);
    const float* lv = F.in[6] + layer * 128;
    float lam; { float a = lane < 32 ? lv[lane] * lv[32 + lane] : 0.f, c = lane < 32 ? lv[64 + lane] * lv[96 + lane] : 0.f; a = wave_sum(a); c = wave_sum(c);
        const float lam_init = 0.8f - 0.6f * expf(-0.3f * (float)layer); lam = expf(a) - expf(c) + lam_init; }
    const float lam_init = 0.8f - 0.6f * expf(-0.3f * (float)layer);
    const int NQB = nqb, NTASK = 2 * 8 * NQB;
    for (int task = vblk * 8 + F.wave; task < NTASK; task += nblk * 8) {
        const int qb = NQB - 1 - task / 16, r = task % 16, type = r >> 3, bh = r & 7, b = bh >> 2, h = bh & 3;
        const int t = qb * 64 + lane, smax = qb * 64 + 63; const size_t m = (size_t)b * LSEQ + t; const size_t rb = (size_t)b * LSEQ;
        float o[64];
        if (type == 0) {
            const bf16* FQ = WSP(bf16, WS_FQ); const float* FD = WSP(float, WS_FD2) + (size_t)bh * LSEQ;
            float q[64];
#pragma unroll
            for (int c = 0; c < 8; ++c) { const u32x4 w = *(const u32x4*)(FQ + m * 256 + 64 * h + 8 * c);
                q[8 * c] = bflo(w.x); q[8 * c + 1] = bfhi(w.x); q[8 * c + 2] = bflo(w.y); q[8 * c + 3] = bfhi(w.y); q[8 * c + 4] = bflo(w.z); q[8 * c + 5] = bfhi(w.z); q[8 * c + 6] = bflo(w.w); q[8 * c + 7] = bfhi(w.w); }
            attn_lane<64>(q, WSP(bf16, WS_FK) + rb * 256 + 64 * h, 256, WSP(bf16, WS_FV) + rb * 256 + 64 * h, 256, FD, FD[t], t, smax, o);
            float ss = 0.f;
#pragma unroll
            for (int d = 0; d < 64; ++d) ss += o[d] * o[d];
            const float rn = rsqrtf(ss * (1.f / 64.f) + EPS); const float* gn = F.in[9] + layer * 64;
#pragma unroll
            for (int d = 0; d < 64; d += 2) *(unsigned*)(MIX + m * DM + 768 + 64 * h + d) = t >= PADR ? pk2(o[d] * rn * gn[d], o[d + 1] * rn * gn[d + 1]) : 0u;
        } else {
            const bf16* DQ = WSP(bf16, WS_DQ);
            float o0[64];
#pragma unroll
            for (int comp = 0; comp < 2; ++comp) {
                float q[32];
#pragma unroll
                for (int c = 0; c < 4; ++c) { const u32x4 w = *(const u32x4*)(DQ + m * 256 + 32 * (2 * h + comp) + 8 * c);
                    q[8 * c] = bflo(w.x); q[8 * c + 1] = bfhi(w.x); q[8 * c + 2] = bflo(w.y); q[8 * c + 3] = bfhi(w.y); q[8 * c + 4] = bflo(w.z); q[8 * c + 5] = bfhi(w.z); q[8 * c + 6] = bflo(w.w); q[8 * c + 7] = bfhi(w.w); }
                if (comp == 0) attn_lane<32>(q, WSP(bf16, WS_DK) + rb * 256 + 32 * (2 * h + comp), 256, WSP(bf16, WS_DV) + rb * 256 + 64 * h, 256, nullptr, 0.f, t, smax, o0);
                else attn_lane<32>(q, WSP(bf16, WS_DK) + rb * 256 + 32 * (2 * h + comp), 256, WSP(bf16, WS_DV) + rb * 256 + 64 * h, 256, nullptr, 0.f, t, smax, o);
            }
            float ss = 0.f;
#pragma unroll
            for (int d = 0; d < 64; ++d) { o[d] = o0[d] - lam * o[d]; ss += o[d] * o[d]; }
            const float rn = rsqrtf(ss * (1.f / 64.f) + EPS) * (1.f - lam_init); const float* gn = F.in[7] + layer * 64;
#pragma unroll
            for (int d = 0; d < 64; d += 2) *(unsigned*)(MIX + m * DM + 512 + 64 * h + d) = t >= PADR ? pk2(o[d] * rn * gn[d], o[d + 1] * rn * gn[d + 1]) : 0u;
        }
    }
}

__device__ __forceinline__ void hgrn_post(const Frame& F, int layer) {
    const float* ORAW = WSP(float, WS_ORAW); const bf16* HG = WSP(bf16, WS_HG); bf16* MIX = WSP(bf16, WS_MIX); const float* gn = F.in[5] + layer * 128;
    const int gw = F.blk * 8 + F.wave, NGW = F.G * 8, lane = F.lane;
    for (int it = gw; it < M * 4; it += NGW) {
        const int m = it >> 2, h = it & 3;
        const f32x2 o = *(const f32x2*)(ORAW + (size_t)m * 512 + 128 * h + 2 * lane);
        const float ss = wave_sum(o.x * o.x + o.y * o.y), rn = rsqrtf(ss * (1.f / 128.f) + EPS);
        const unsigned g = *(const unsigned*)(HG + (size_t)m * 512 + 128 * h + 2 * lane);
        *(unsigned*)(MIX + (size_t)m * DM + 128 * h + 2 * lane) = pk2(o.x * rn * gn[2 * lane] * bflo(g), o.y * rn * gn[2 * lane + 1] * bfhi(g));
    }
}

struct EpiResid { float* H; int m0;
    __device__ __forceinline__ void operator()(int r, int c0, const float (&v)[4], const float (&)[4]) const {
#pragma unroll
        for (int j = 0; j < 4; ++j) H[(size_t)(m0 + r) * DM + c0 + 16 * j] += v[j]; } };
__device__ __forceinline__ void gemm2_naive(const Frame& F, int layer) {
    const bf16* MIX = WSP(bf16, WS_MIX); const float* W = F.in[10] + (size_t)layer * DM * DM;
    constexpr int NT = (M / 128) * 16;
    for (int tile = F.blk; tile < NT; tile += F.G) {
        const int rt = tile / 16, ct = tile % 16;
        EpiResid E{WSP(float, WS_H), rt * 128};
        ngemm_tile<false>(F, MIX + (size_t)rt * 128 * DM, DM, W, nullptr, DM, DM, ct * 64, E);
    }
}

__device__ __forceinline__ void norm2_route_generic(const Frame& F, int layer) {
    typedef short bf16x8_t __attribute__((ext_vector_type(8)));
    const float* H = WSP(float, WS_H); bf16* XN = WSP(bf16, WS_XN);
    int* TOKE = WSP(int, WS_TOKE); int* TOKR = WSP(int, WS_TOKR);
    unsigned* CNT = WSP(unsigned, WS_CTL) + CW_CNT + 64 * layer;
    const float* gain = F.in[11] + layer * DM; const float* bg = F.in[13] + layer * 4; const float* br = F.in[15] + layer * 32;
    const bf16* WThi = WSP(bf16, WS_WRT) + (size_t)(layer * 2) * 48 * 1024; const bf16* WTlo = WThi + 48 * 1024;
    const int RPB = (M + F.G - 1) / F.G, r0 = F.blk * RPB, r1 = (r0 + RPB < M) ? r0 + RPB : M, nrow = r1 - r0, lane = F.lane;
    LAS int* sE = (LAS int*)F.lds;
    LAS int* sRank = sE + 2048; LAS int* sBase = sRank + 2048;
    LAS float* sR = (LAS float*)(sBase + 64);
    LAS float* sL = sR + 1024;
    LAS float* sG = sL + 96 * 48;
    for (int m = r0 + F.wave; m < r1; m += 8) {
        float ss = 0.f;
#pragma unroll
        for (int j = 0; j < 4; ++j) { const f32x4 x = *(const f32x4*)(H + (size_t)m * DM + 4 * lane + 256 * j); ss += (x.x * x.x + x.y * x.y) + (x.z * x.z + x.w * x.w); }
        ss = wave_sum(ss);
        if (lane == 0) sR[m - r0] = rsqrtf(ss * (1.f / DM) + EPS);
    }
    __syncthreads();
    for (int tile = F.wave; tile * 16 < nrow; tile += 8) {
        const int lr = tile * 16 + (lane & 15), kg = lane >> 4; const bool rvalid = lr < nrow; const int row = r0 + (rvalid ? lr : nrow - 1);
        const float rr = sR[row - r0];
        f32x4 acc[3] = {(f32x4){0.f, 0.f, 0.f, 0.f}, (f32x4){0.f, 0.f, 0.f, 0.f}, (f32x4){0.f, 0.f, 0.f, 0.f}};
#pragma unroll 4
        for (int ks = 0; ks < 32; ++ks) {
            const int k0 = 32 * ks + 8 * kg;
            const f32x4 xa = *(const f32x4*)(H + (size_t)row * DM + k0), xb = *(const f32x4*)(H + (size_t)row * DM + k0 + 4);
            const f32x4 ga = *(const f32x4*)(gain + k0), gb = *(const f32x4*)(gain + k0 + 4);
            const f32x4 ua = xa * rr * ga, ub = xb * rr * gb;
            u32x4 hi4; hi4.x = pk2(ua.x, ua.y); hi4.y = pk2(ua.z, ua.w); hi4.z = pk2(ub.x, ub.y); hi4.w = pk2(ub.z, ub.w);
            u32x4 lo4; lo4.x = pk2(ua.x - bflo(hi4.x), ua.y - bfhi(hi4.x)); lo4.y = pk2(ua.z - bflo(hi4.y), ua.w - bfhi(hi4.y));
            lo4.z = pk2(ub.x - bflo(hi4.z), ub.y - bfhi(hi4.z)); lo4.w = pk2(ub.z - bflo(hi4.w), ub.w - bfhi(hi4.w));
            if (rvalid) *(u32x4*)(XN + (size_t)row * DM + k0) = hi4;
            const bf16x8_t ah = __builtin_bit_cast(bf16x8_t, hi4), al = __builtin_bit_cast(bf16x8_t, lo4);
#pragma unroll
            for (int ct = 0; ct < 3; ++ct) {
                const bf16x8_t wh = *(const bf16x8_t*)(WThi + (size_t)(16 * ct + (lane & 15)) * 1024 + k0), wl = *(const bf16x8_t*)(WTlo + (size_t)(16 * ct + (lane & 15)) * 1024 + k0);
                acc[ct] = __builtin_amdgcn_mfma_f32_16x16x32_bf16(ah, wh, acc[ct], 0, 0, 0);
                acc[ct] = __builtin_amdgcn_mfma_f32_16x16x32_bf16(ah, wl, acc[ct], 0, 0, 0);
                acc[ct] = __builtin_amdgcn_mfma_f32_16x16x32_bf16(al, wh, acc[ct], 0, 0, 0);
            }
        }
#pragma unroll
        for (int ct = 0; ct < 3; ++ct)
#pragma unroll
            for (int q = 0; q < 4; ++q) sL[(tile * 16 + 4 * kg + q) * 48 + 16 * ct + (lane & 15)] = acc[ct][q];
    }
    __syncthreads();
    if (F.tid < nrow) {
        const int li = F.tid, m = r0 + li; const LAS float* lg = sL + li * 48;
        const float g0 = lg[0] + bg[0], g1 = lg[1] + bg[1], g2 = lg[2] + bg[2], g3 = lg[3] + bg[3];
        int gs = 0; float gm = g0; if (g1 > gm) { gm = g1; gs = 1; } if (g2 > gm) { gm = g2; gs = 2; } if (g3 > gm) { gm = g3; gs = 3; }
        const float pg = 1.f / (expf(g0 - gm) + expf(g1 - gm) + expf(g2 - gm) + expf(g3 - gm));
        float e[8];
#pragma unroll
        for (int q = 0; q < 8; ++q) e[q] = lg[4 + gs * 8 + q] + br[gs * 8 + q];
        int i0 = 0; float m0 = e[0];
#pragma unroll
        for (int q = 1; q < 8; ++q) if (e[q] > m0) { m0 = e[q]; i0 = q; }
        int i1 = -1; float m1 = -INFINITY;
#pragma unroll
        for (int q = 0; q < 8; ++q) if (q != i0 && e[q] > m1) { m1 = e[q]; i1 = q; }
        if (i1 < 0) i1 = (i0 + 1) & 7;
        const float p1 = expf(m1 - m0), den = 1.f / (1.f + p1);
        TOKE[2 * m] = gs * 8 + i0; TOKE[2 * m + 1] = gs * 8 + i1;
        sE[2 * li] = gs * 8 + i0; sE[2 * li + 1] = gs * 8 + i1; sG[2 * li] = pg * den; sG[2 * li + 1] = pg * p1 * den;
    }
    __syncthreads();
    const int na = 2 * nrow;
    for (int i = F.tid; i < na; i += 512) { const int e = sE[i]; int r = 0; for (int j = 0; j < i; ++j) r += (sE[j] == e) ? 1 : 0; sRank[i] = r; }
    if (F.tid < NEXP) { int c = 0; for (int i = 0; i < na; ++i) c += (sE[i] == F.tid) ? 1 : 0;
        sBase[F.tid] = c ? (int)__hip_atomic_fetch_add(CNT + F.tid, (unsigned)c, __ATOMIC_RELAXED, __HIP_MEMORY_SCOPE_AGENT) : 0; }
    __syncthreads();
    int* LIST = WSP(int, WS_LIST); float* GLIST = WSP(float, WS_GLIST);
    for (int i = F.tid; i < na; i += 512) { const int e = sE[i], rank = sBase[e] + sRank[i]; TOKR[2 * r0 + i] = rank;
        LIST[(size_t)e * M + rank] = r0 + (i >> 1); GLIST[(size_t)e * M + rank] = sG[i]; }
    __syncthreads();
}

__device__ __forceinline__ void norm2_route(const Frame& F, int layer) {
    if (F.G * 65 != M) { norm2_route_generic(F, layer); return; }
    typedef short bf16x8_t __attribute__((ext_vector_type(8)));
    const float* H = WSP(float, WS_H); bf16* XN = WSP(bf16, WS_XN);
    int* TOKE = WSP(int, WS_TOKE); int* TOKR = WSP(int, WS_TOKR);
    unsigned* CNT = WSP(unsigned, WS_CTL) + CW_CNT + 64 * layer;
    const float* gain = F.in[11] + layer * DM; const float* bg = F.in[13] + layer * 4; const float* br = F.in[15] + layer * 32;
    const float* wgf = F.in[12] + (size_t)layer * DM * 4; const float* wrf = F.in[14] + (size_t)layer * DM * 32;
    const bf16* WThi = WSP(bf16, WS_WRT) + (size_t)(layer * 2) * 48 * 1024; const bf16* WTlo = WThi + 48 * 1024;
    const int lane = F.lane, wave = F.wave, nrow = 65;
#define GROW(li) ((li) < 64 ? 64 * F.blk + (li) : 64 * F.G + F.blk)
    LAS int* sE = (LAS int*)F.lds; LAS int* sRank = sE + 2048; LAS int* sBase = sRank + 2048;
    LAS float* sR = (LAS float*)(sBase + 64);
    LAS float* sL = sR + 1024;
    LAS float* sG = sL + 96 * 48;
    LAS float* slab = sG + 1024;
    LAS float* xl = slab + 4 * 64 * 48;
    const int kq = wave & 3, rh = wave >> 2, l15 = lane & 15, kg = lane >> 4;
    f32x4 xa[2][8], xb[2][8];
#pragma unroll
    for (int t = 0; t < 2; ++t)
#pragma unroll
        for (int ks = 0; ks < 8; ++ks) { const size_t row = (size_t)64 * F.blk + 32 * rh + 16 * t + l15; const int k0 = 256 * kq + 32 * ks + 8 * kg;
            xa[t][ks] = *(const f32x4*)(H + row * DM + k0); xb[t][ks] = *(const f32x4*)(H + row * DM + k0 + 4); }
    const size_t mx = GROW(64); const int kx = 128 * wave + 2 * lane;
    const f32x2 xv = *(const f32x2*)(H + mx * DM + kx);
#pragma unroll
    for (int t = 0; t < 2; ++t) { float ss = 0.f;
#pragma unroll
        for (int ks = 0; ks < 8; ++ks) ss += ((xa[t][ks].x * xa[t][ks].x + xa[t][ks].y * xa[t][ks].y) + (xa[t][ks].z * xa[t][ks].z + xa[t][ks].w * xa[t][ks].w))
                                           + ((xb[t][ks].x * xb[t][ks].x + xb[t][ks].y * xb[t][ks].y) + (xb[t][ks].z * xb[t][ks].z + xb[t][ks].w * xb[t][ks].w));
        ss += __shfl_xor(ss, 16); ss += __shfl_xor(ss, 32);
        if (lane < 16) sR[kq * 64 + 32 * rh + 16 * t + l15] = ss; }
    { const float sx = wave_sum(xv.x * xv.x + xv.y * xv.y); if (lane == 0) sR[256 + wave] = sx; }
    if (F.tid < 36) sR[512 + F.tid] = F.tid < 4 ? bg[F.tid] : br[F.tid - 4];
    float xu0, xu1;
    {
        const int k = kx; const f32x2 gv = *(const f32x2*)(gain + k);
        const float u0 = xv.x * gv.x, u1 = xv.y * gv.y; xu0 = u0; xu1 = u1;
        { const f32x4 a0 = *(const f32x4*)(wgf + (size_t)k * 4), a1 = *(const f32x4*)(wgf + (size_t)(k + 1) * 4);
          const float p0 = wave_sum(u0 * a0.x + u1 * a1.x), p1 = wave_sum(u0 * a0.y + u1 * a1.y), p2 = wave_sum(u0 * a0.z + u1 * a1.z), p3 = wave_sum(u0 * a0.w + u1 * a1.w);
          if (lane == 0) { xl[wave * 36 + 0] = p0; xl[wave * 36 + 1] = p1; xl[wave * 36 + 2] = p2; xl[wave * 36 + 3] = p3; } }
#pragma unroll
        for (int e4 = 0; e4 < 8; ++e4) { const f32x4 b0 = *(const f32x4*)(wrf + (size_t)k * 32 + 4 * e4), b1 = *(const f32x4*)(wrf + (size_t)(k + 1) * 32 + 4 * e4);
            const float p0 = wave_sum(u0 * b0.x + u1 * b1.x), p1 = wave_sum(u0 * b0.y + u1 * b1.y), p2 = wave_sum(u0 * b0.z + u1 * b1.z), p3 = wave_sum(u0 * b0.w + u1 * b1.w);
            if (lane == 0) { xl[wave * 36 + 4 + 4 * e4] = p0; xl[wave * 36 + 5 + 4 * e4] = p1; xl[wave * 36 + 6 + 4 * e4] = p2; xl[wave * 36 + 7 + 4 * e4] = p3; }
            __builtin_amdgcn_sched_barrier(0); }
    }
    __syncthreads();
    {
        float rr[2];
#pragma unroll
        for (int t = 0; t < 2; ++t) { const int li = 32 * rh + 16 * t + l15; rr[t] = rsqrtf(((sR[li] + sR[64 + li]) + (sR[128 + li] + sR[192 + li])) * (1.f / DM) + EPS); }
        f32x4 acc[2][3];
#pragma unroll
        for (int t = 0; t < 2; ++t)
#pragma unroll
            for (int ct = 0; ct < 3; ++ct) acc[t][ct] = (f32x4){0.f, 0.f, 0.f, 0.f};
#pragma unroll
        for (int ks = 0; ks < 8; ++ks) {
            const int k0 = 256 * kq + 32 * ks + 8 * kg;
            const f32x4 ga = *(const f32x4*)(gain + k0), gb = *(const f32x4*)(gain + k0 + 4);
            bf16x8_t wh[3], wl[3];
#pragma unroll
            for (int ct = 0; ct < 3; ++ct) { wh[ct] = *(const bf16x8_t*)(WThi + (size_t)(16 * ct + l15) * 1024 + k0); wl[ct] = *(const bf16x8_t*)(WTlo + (size_t)(16 * ct + l15) * 1024 + k0); }
#pragma unroll
            for (int t = 0; t < 2; ++t) { const size_t row = (size_t)64 * F.blk + 32 * rh + 16 * t + l15;
                const f32x4 ua = xa[t][ks] * rr[t] * ga, ub = xb[t][ks] * rr[t] * gb;
                u32x4 hi4; hi4.x = pk2(ua.x, ua.y); hi4.y = pk2(ua.z, ua.w); hi4.z = pk2(ub.x, ub.y); hi4.w = pk2(ub.z, ub.w);
                u32x4 lo4; lo4.x = pk2(ua.x - bflo(hi4.x), ua.y - bfhi(hi4.x)); lo4.y = pk2(ua.z - bflo(hi4.y), ua.w - bfhi(hi4.y));
                lo4.z = pk2(ub.x - bflo(hi4.z), ub.y - bfhi(hi4.z)); lo4.w = pk2(ub.z - bflo(hi4.w), ub.w - bfhi(hi4.w));
                *(u32x4*)(XN + row * DM + k0) = hi4;
                const bf16x8_t ah = __builtin_bit_cast(bf16x8_t, hi4), al = __builtin_bit_cast(bf16x8_t, lo4);
#pragma unroll
                for (int ct = 0; ct < 3; ++ct) {
                    acc[t][ct] = __builtin_amdgcn_mfma_f32_16x16x32_bf16(ah, wh[ct], acc[t][ct], 0, 0, 0);
                    acc[t][ct] = __builtin_amdgcn_mfma_f32_16x16x32_bf16(ah, wl[ct], acc[t][ct], 0, 0, 0);
                    acc[t][ct] = __builtin_amdgcn_mfma_f32_16x16x32_bf16(al, wh[ct], acc[t][ct], 0, 0, 0);
                } }
            __builtin_amdgcn_sched_barrier(0);
        }
#pragma unroll
        for (int t = 0; t < 2; ++t)
#pragma unroll
            for (int ct = 0; ct < 3; ++ct)
#pragma unroll
                for (int q = 0; q < 4; ++q) slab[(kq * 64 + 32 * rh + 16 * t + 4 * kg + q) * 48 + 16 * ct + l15] = acc[t][ct][q];
    }
    {
        float sx = 0.f;
#pragma unroll
        for (int w = 0; w < 8; ++w) sx += sR[256 + w];
        const float rr = rsqrtf(sx * (1.f / DM) + EPS);
        *(unsigned*)(XN + mx * DM + kx) = pk2(xu0 * rr, xu1 * rr);
    }
    __syncthreads();
    for (int idx = F.tid; idx < 65 * 36; idx += 512) { const int li = idx / 36, q = idx % 36;
        const float bias_q = sR[512 + q];
        float v_;
        if (li < 64) v_ = (slab[li * 48 + q] + slab[(64 + li) * 48 + q]) + (slab[(128 + li) * 48 + q] + slab[(192 + li) * 48 + q]);
        else { v_ = 0.f; float sx = 0.f;
#pragma unroll
            for (int w = 0; w < 8; ++w) { v_ += xl[w * 36 + q]; sx += sR[256 + w]; }
            v_ *= rsqrtf(sx * (1.f / DM) + EPS); }
        sL[li * 48 + q] = v_ + bias_q; }
    __syncthreads();
    if (F.tid < nrow) {
        const int li = F.tid; const size_t m = GROW(li); const LAS float* lg = sL + li * 48;
        const float g0 = lg[0], g1 = lg[1], g2 = lg[2], g3 = lg[3];
        int gs = 0; float gm = g0; if (g1 > gm) { gm = g1; gs = 1; } if (g2 > gm) { gm = g2; gs = 2; } if (g3 > gm) { gm = g3; gs = 3; }
        const float pg = 1.f / (expf(g0 - gm) + expf(g1 - gm) + expf(g2 - gm) + expf(g3 - gm));
        float e[8];
#pragma unroll
        for (int q = 0; q < 8; ++q) e[q] = lg[4 + gs * 8 + q];
        int i0 = 0; float m0 = e[0];
#pragma unroll
        for (int q = 1; q < 8; ++q) if (e[q] > m0) { m0 = e[q]; i0 = q; }
        int i1 = -1; float m1 = -INFINITY;
#pragma unroll
        for (int q = 0; q < 8; ++q) if (q != i0 && e[q] > m1) { m1 = e[q]; i1 = q; }
        if (i1 < 0) i1 = (i0 + 1) & 7;
        const float p1 = expf(m1 - m0), den = 1.f / (1.f + p1);
        TOKE[2 * m] = gs * 8 + i0; TOKE[2 * m + 1] = gs * 8 + i1;
        sE[2 * li] = gs * 8 + i0; sE[2 * li + 1] = gs * 8 + i1; sG[2 * li] = pg * den; sG[2 * li + 1] = pg * p1 * den;
    }
    __syncthreads();
    const int na = 2 * nrow;
    for (int i = F.tid; i < na; i += 512) { const int e = sE[i]; int r = 0; for (int j = 0; j < i; ++j) r += (sE[j] == e) ? 1 : 0; sRank[i] = r; }
    if (F.tid < NEXP) { int c = 0; for (int i = 0; i < na; ++i) c += (sE[i] == F.tid) ? 1 : 0;
        sBase[F.tid] = c ? (int)__hip_atomic_fetch_add(CNT + F.tid, (unsigned)c, __ATOMIC_RELAXED, __HIP_MEMORY_SCOPE_AGENT) : 0; }
    __syncthreads();
    int* LIST = WSP(int, WS_LIST); float* GLIST = WSP(float, WS_GLIST);
    for (int i = F.tid; i < na; i += 512) { const int e = sE[i], rank = sBase[e] + sRank[i]; const int m = GROW(i >> 1); TOKR[2 * m + (i & 1)] = rank;
        LIST[(size_t)e * M + rank] = m; GLIST[(size_t)e * M + rank] = sG[i]; }
    __syncthreads();
#undef GROW
}

__device__ __forceinline__ void moe_tile_bases(const Frame& F, int layer, LAS int* tb) {
    unsigned* CNT = WSP(unsigned, WS_CTL) + CW_CNT + 64 * layer;
    if (F.tid < NEXP) tb[40 + F.tid] = (int)__hip_atomic_load(CNT + F.tid, __ATOMIC_RELAXED, __HIP_MEMORY_SCOPE_AGENT);
    __syncthreads();
    if (F.tid == 0) { int acc = 0;
#pragma unroll
        for (int e = 0; e < NEXP; ++e) { tb[e] = acc; acc += (tb[40 + e] + 255) >> 8; } tb[NEXP] = acc; }
    __syncthreads();
    if (F.tid < 168) { int e = 0;
#pragma unroll
        for (int q = 1; q < NEXP; ++q) if (tb[q] <= F.tid) e = q;
        tb[256 + F.tid] = e; }
    __syncthreads();
}
__device__ __forceinline__ void moe_gather(const Frame& F, int layer) {
    LAS int* tb = (LAS int*)(F.lds + 131072);
    moe_tile_bases(F, layer, tb);
    const bf16* XN = WSP(bf16, WS_XN); bf16* XG = WSP(bf16, WS_XG); const int* TOKE = WSP(int, WS_TOKE); const float* TOKG = WSP(float, WS_TOKG); const int* TOKR = WSP(int, WS_TOKR);
    int* TOKS = WSP(int, WS_TOKS); float* SG = WSP(float, WS_SGATE);
    const int gw = F.blk * 8 + F.wave, NGW = F.G * 8, lane = F.lane;
    for (int it = gw; it < 2 * M; it += NGW) {
        const int m = it >> 1; const int e = TOKE[it]; const int slot = 256 * tb[e] + TOKR[it];
        const u32x4* src = (const u32x4*)(XN + (size_t)m * DM); u32x4* dst = (u32x4*)(XG + (size_t)slot * DM);
        dst[lane] = src[lane]; dst[64 + lane] = src[64 + lane];
        if (lane == 0) { TOKS[it] = slot; SG[slot] = TOKG[it]; }
    }
    __syncthreads();
}
struct EpiMoeUp { bf16* HB; int s0;
    __device__ __forceinline__ void operator()(int r, int c0, const float (&a)[4], const float (&b)[4]) const {
#pragma unroll
        for (int j = 0; j < 4; ++j) HB[(size_t)(s0 + r) * DE + c0 + 16 * j] = (bf16)f2bf(siluf_(a[j]) * b[j]); } };
struct EpiMoeDown { bf16* Y; const float* SG; int s0;
    __device__ __forceinline__ void operator()(int r, int c0, const float (&a)[4], const float (&)[4]) const {
        const float g = SG[s0 + r];
#pragma unroll
        for (int j = 0; j < 4; ++j) Y[(size_t)(s0 + r) * DM + c0 + 16 * j] = (bf16)f2bf(a[j] * g); } };
__device__ __forceinline__ int tile_expert(const LAS int* tb, int t256) { int e = 0;
#pragma unroll 1
    for (int q = 1; q < NEXP; ++q) if (tb[q] <= t256) e = q;
    return e; }
__device__ __forceinline__ void moe_up_naive(const Frame& F, int layer) {
    LAS int* tb = (LAS int*)(F.lds + 131072);
    moe_tile_bases(F, layer, tb);
    const int ntile = tb[NEXP] * 2 * 8;
    for (int tile = F.blk; tile < ntile; tile += F.G) {
        const int rt = tile / 8, ct = tile % 8, e = tile_expert(tb, rt >> 1);
        EpiMoeUp E{WSP(bf16, WS_HB), rt * 128};
        const size_t wo = ((size_t)layer * NEXP + e) * DM * DE;
        ngemm_tile<true>(F, WSP(bf16, WS_XG) + (size_t)rt * 128 * DM, DM, F.in[16] + wo, F.in[17] + wo, DE, DM, ct * 64, E);
    }
    __syncthreads();
}
__device__ __forceinline__ void moe_down_naive(const Frame& F, int layer) {
    LAS int* tb = (LAS int*)(F.lds + 131072);
    moe_tile_bases(F, layer, tb);
    const int ntile = tb[NEXP] * 2 * 16;
    for (int tile = F.blk; tile < ntile; tile += F.G) {
        const int rt = tile / 16, ct = tile % 16, e = tile_expert(tb, rt >> 1);
        EpiMoeDown E{WSP(bf16, WS_Y), WSP(float, WS_SGATE), rt * 128};
        const size_t wo = ((size_t)layer * NEXP + e) * DE * DM;
        ngemm_tile<false>(F, WSP(bf16, WS_HB) + (size_t)rt * 128 * DE, DE, F.in[18] + wo, nullptr, DM, DE, ct * 64, E);
    }
    __syncthreads();
}


__device__ __forceinline__ float fast_sigmoid(float x) { return __builtin_amdgcn_rcpf(1.f + __expf(-x)); }
__device__ __forceinline__ u32x4 pack8(const float (&y)[8]) { u32x4 w; w.x = pg8::cvt_pk_bf16(y[0], y[1]); w.y = pg8::cvt_pk_bf16(y[2], y[3]); w.z = pg8::cvt_pk_bf16(y[4], y[5]); w.w = pg8::cvt_pk_bf16(y[6], y[7]); return w; }
#define ACC8(x, ai, bj, m) float x[8]; { const pg8::f32x4 _a = acc[ai][bj][m][0], _b = acc[ai][bj][m][1]; x[0] = _a[0]; x[1] = _a[1]; x[2] = _a[2]; x[3] = _a[3]; x[4] = _b[0]; x[5] = _b[1]; x[6] = _b[2]; x[7] = _b[3]; }

struct EpiInprojM {
    static constexpr bool PERM = true, AFTER_DRAIN = false;
    unsigned char* ws; int layer;
    __device__ __forceinline__ void operator()(const pg8::f32x4 (&acc)[2][2][4][2], const pg8::Unit& u, int wr, int wc, int fr, int fq) const {
        const int pn = u.pn, row0 = u.pm * 256 + wr * 64 + fr, c8 = wc * 32 + 8 * fq;
        if (pn < 2 || (pn >= 4 && pn < 8)) {
            bf16* O = (bf16*)(ws + (pn < 2 ? WS_HQ : pn < 6 ? WS_HV : WS_HG)) + (pn & 1) * 256 + c8;
            const bool act = pn < 2 || pn >= 6; const float sc = pn < 2 ? 0.08838834764831845f : 1.f;
#pragma unroll
            for (int ai = 0; ai < 2; ++ai)
#pragma unroll
                for (int m = 0; m < 4; ++m) { const size_t ro = (size_t)(row0 + ai * 128 + m * 16) * 512;
#pragma unroll
                    for (int bj = 0; bj < 2; ++bj) { ACC8(x, ai, bj, m);
                        if (act) {
#pragma unroll
                            for (int e = 0; e < 8; ++e) x[e] = x[e] * fast_sigmoid(x[e]) * sc; }
                        *(u32x4*)(O + ro + bj * 128) = pack8(x); } }
        } else if (pn < 4) {
            float* LF = (float*)(ws + WS_HLF) + (pn & 1) * 256 + c8; bf16* KK = (bf16*)(ws + WS_HK) + (pn & 1) * 256 + c8;
            const float* LBV = (const float*)(ws + WS_LBV) + layer * 512 + (pn & 1) * 256 + c8;
            float lb[2][8];
#pragma unroll
            for (int bj = 0; bj < 2; ++bj) { const f32x4 a = *(const f32x4*)(LBV + bj * 128), b = *(const f32x4*)(LBV + bj * 128 + 4);
                lb[bj][0] = a.x; lb[bj][1] = a.y; lb[bj][2] = a.z; lb[bj][3] = a.w; lb[bj][4] = b.x; lb[bj][5] = b.y; lb[bj][6] = b.z; lb[bj][7] = b.w; }
#pragma unroll
            for (int ai = 0; ai < 2; ++ai)
#pragma unroll
                for (int m = 0; m < 4; ++m) { const int row = row0 + ai * 128 + m * 16; const size_t ro = (size_t)row * 512; const bool valid = (row % LSEQ) >= PADR;
#pragma unroll
                    for (int bj = 0; bj < 2; ++bj) { ACC8(x, ai, bj, m); float lf[8], kk[8];
#pragma unroll
                        for (int e = 0; e < 8; ++e) { const float sg = fast_sigmoid(x[e]), l = lb[bj][e]; const float f = l + (1.f - l) * sg;
                            lf[e] = valid ? __logf(fmaxf(f, TINYF)) : 0.f; kk[e] = valid ? (1.f - l) * (1.f - sg) : 0.f; }
                        *(f32x4*)(LF + ro + bj * 128) = (f32x4){lf[0], lf[1], lf[2], lf[3]}; *(f32x4*)(LF + ro + bj * 128 + 4) = (f32x4){lf[4], lf[5], lf[6], lf[7]};
                        *(u32x4*)(KK + ro + bj * 128) = pack8(kk); } }
        } else if (pn < 10) {
            bf16* O = (bf16*)(ws + (pn == 8 ? WS_DQ : WS_DK)) + 32 * (2 * wc + (fq >> 1)) + 8 * (fq & 1);
            const float sc = pn == 8 ? 0.17677669529663687f * LOG2E : 1.f;
            const float* COS = (const float*)(ws + WS_COS) + 8 * (fq & 1); const float* SIN = (const float*)(ws + WS_SIN) + 8 * (fq & 1);
#pragma unroll
            for (int ai = 0; ai < 2; ++ai)
#pragma unroll
                for (int m = 0; m < 4; ++m) { const int row = row0 + ai * 128 + m * 16, t = row % LSEQ; const size_t ro = (size_t)row * 256;
                    const f32x4 c0 = *(const f32x4*)(COS + t * 16), c1 = *(const f32x4*)(COS + t * 16 + 4), s0 = *(const f32x4*)(SIN + t * 16), s1 = *(const f32x4*)(SIN + t * 16 + 4);
                    const float cs[8] = {c0.x, c0.y, c0.z, c0.w, c1.x, c1.y, c1.z, c1.w}, sn[8] = {s0.x, s0.y, s0.z, s0.w, s1.x, s1.y, s1.z, s1.w};
                    ACC8(x1, ai, 0, m); ACC8(x2, ai, 1, m); float o1[8], o2[8];
#pragma unroll
                    for (int e = 0; e < 8; ++e) { o1[e] = (x1[e] * cs[e] - x2[e] * sn[e]) * sc; o2[e] = (x2[e] * cs[e] + x1[e] * sn[e]) * sc; }
                    *(u32x4*)(O + ro) = pack8(o1); *(u32x4*)(O + ro + 16) = pack8(o2); }
        } else {
            bf16* O = (bf16*)(ws + (pn == 10 ? WS_DV : pn == 11 ? WS_FQ : pn == 12 ? WS_FK : WS_FV)) + c8;
            const float sc = pn == 11 ? 0.125f * LOG2E : 1.f;
#pragma unroll
            for (int ai = 0; ai < 2; ++ai)
#pragma unroll
                for (int m = 0; m < 4; ++m) { const size_t ro = (size_t)(row0 + ai * 128 + m * 16) * 256;
#pragma unroll
                    for (int bj = 0; bj < 2; ++bj) { ACC8(x, ai, bj, m);
#pragma unroll
                        for (int e = 0; e < 8; ++e) x[e] *= sc;
                        *(u32x4*)(O + ro + bj * 128) = pack8(x); } }
        }
    }
};
struct EpiResidM {
    static constexpr bool PERM = true, AFTER_DRAIN = false;
    float* H; const float* x; const float* meta;
    __device__ __forceinline__ void operator()(const pg8::f32x4 (&acc)[2][2][4][2], const pg8::Unit& u, int wr, int wc, int fr, int fq) const {
        const int row0 = u.pm * 256 + wr * 64 + fr, col0 = u.pn * 256 + wc * 32 + 8 * fq;
#pragma unroll
        for (int ai = 0; ai < 2; ++ai)
#pragma unroll
            for (int m = 0; m < 4; ++m) { const int row = row0 + ai * 128 + m * 16; float* rp = H + (size_t)row * DM + col0;
                const float* bp = rp;
                if (x) { const int b = row / LSEQ, t = row % LSEQ; bp = t < PADR ? nullptr : t < 128 ? meta + (size_t)(t - PADR) * DM + col0 : x + ((size_t)b * SEQ + (t - 128)) * DM + col0; }
#pragma unroll
                for (int bj = 0; bj < 2; ++bj) { f32x4 a = (f32x4){0.f, 0.f, 0.f, 0.f}, b = a;
                    if (bp) { a = *(const f32x4*)(bp + bj * 128); b = *(const f32x4*)(bp + bj * 128 + 4); }
                    a += acc[ai][bj][m][0]; b += acc[ai][bj][m][1];
                    *(f32x4*)(rp + bj * 128) = a; *(f32x4*)(rp + bj * 128 + 4) = b; } }
    }
};
struct EpiMoeUpM {
    static constexpr bool PERM = true, AFTER_DRAIN = false;
    bf16* HB;
    __device__ __forceinline__ void operator()(const pg8::f32x4 (&acc)[2][2][4][2], const pg8::Unit& u, int wr, int wc, int fr, int fq) const {
        const int row0 = u.pm * 256 + wr * 64 + fr, col0 = (u.pn & 3) * 128 + wc * 32 + 8 * fq;
#pragma unroll
        for (int ai = 0; ai < 2; ++ai)
#pragma unroll
            for (int m = 0; m < 4; ++m) { ACC8(a, ai, 0, m); ACC8(b, ai, 1, m); float h[8];
#pragma unroll
                for (int e = 0; e < 8; ++e) h[e] = a[e] * fast_sigmoid(a[e]) * b[e];
                *(u32x4*)(HB + (size_t)(row0 + ai * 128 + m * 16) * DE + col0) = pack8(h); }
    }
};
struct EpiMoeDownM {
    static constexpr bool PERM = true, AFTER_DRAIN = false;
    bf16* Y; const float* GLIST; const LAS int* tb;
    __device__ __forceinline__ void operator()(const pg8::f32x4 (&acc)[2][2][4][2], const pg8::Unit& u, int wr, int wc, int fr, int fq) const {
        const int row0 = u.pm * 256 + wr * 64 + fr, col0 = (u.pn & 3) * 256 + wc * 32 + 8 * fq, e = u.pn >> 2, rk0 = 256 * (u.pm - tb[e]) + wr * 64 + fr, cnt = tb[40 + e];
#pragma unroll
        for (int ai = 0; ai < 2; ++ai)
#pragma unroll
            for (int m = 0; m < 4; ++m) { const int row = row0 + ai * 128 + m * 16, rk = rk0 + ai * 128 + m * 16; const float g = rk < cnt ? GLIST[(size_t)e * M + rk] : 0.f;
#pragma unroll
                for (int bj = 0; bj < 2; ++bj) { ACC8(x, ai, bj, m);
#pragma unroll
                    for (int e_ = 0; e_ < 8; ++e_) x[e_] *= g;
                    *(u32x4*)(Y + (size_t)row * DM + col0 + bj * 128) = pack8(x); } }
    }
};
template <bool GATHER_> struct MoeOrder {
    static constexpr bool GATHER = GATHER_;
    int nwg, G, c; const LAS int* tb; const int* LIST;
    __device__ __forceinline__ bool next(int i, pg8::Unit& u) const {
        const int L = i * G + c; if (L >= nwg) return false;
        const int q = nwg / 8, r = nwg % 8, xcd = L % 8, off = L / 8;
        const int id = (xcd < r ? xcd * (q + 1) : r * (q + 1) + (xcd - r) * q) + off;
        const int rt = id >> 2, e = tb[256 + rt];
        u.pm = rt; u.pn = e * 4 + (id & 3); return true;
    }
    __device__ __forceinline__ unsigned goff(const pg8::Unit& u, int row, int K) const {
        const int e = u.pn >> 2, rank = 256 * (u.pm - tb[e]) + row; const int tok = rank < tb[40 + e] ? LIST[(size_t)e * M + rank] : 0;
        return (unsigned)tok * (unsigned)K * 2u; }
    __device__ __forceinline__ void a_ready(const pg8::Unit&) const {}
    __device__ __forceinline__ void done(const pg8::Unit&) const {}
};

__device__ __forceinline__ void cvt_item(const float* W, int ld, int k0, int srccol  , bf16* WT, int K, int dr0, LAS float* scr, int lane) {
    float tv[32];
#pragma unroll
    for (int i = 0; i < 32; ++i) tv[i] = __builtin_nontemporal_load(W + (size_t)(k0 + 2 * i + (lane >> 5)) * ld + srccol);
#pragma unroll
    for (int i = 0; i < 32; ++i) scr[(2 * i + (lane >> 5)) * 33 + (lane & 31)] = tv[i];
    asm volatile("s_waitcnt lgkmcnt(0)" ::: "memory");
    const int c = lane & 7;
#pragma unroll
    for (int j = 0; j < 4; ++j) { const int n = (lane >> 3) + 8 * j; const LAS float* p = scr + (8 * c) * 33 + n;
        u32x4 o; o.x = pg8::cvt_pk_bf16(p[0 * 33], p[1 * 33]); o.y = pg8::cvt_pk_bf16(p[2 * 33], p[3 * 33]); o.z = pg8::cvt_pk_bf16(p[4 * 33], p[5 * 33]); o.w = pg8::cvt_pk_bf16(p[6 * 33], p[7 * 33]);
        *(u32x4*)(WT + (size_t)(dr0 + n) * K + k0 + 8 * c) = o; }
    asm volatile("s_waitcnt lgkmcnt(0)" ::: "memory");
}
__device__ __forceinline__ void convert_static_weights(const Frame& F) {
    LAS float* scr = (LAS float*)(F.lds + F.wave * 16384);
    const int gw = F.blk * 8 + F.wave, NGW = F.G * 8, lane = F.lane;
    constexpr int NA = 2 * 16 * 112, NB = 2 * 16 * 32;
    for (int it = gw; it < NA + NB; it += NGW) {
        if (it < NA) { const int l = it / (16 * 112), r = it % (16 * 112), kb = r / 112, nb = r % 112;
            const int n = nb * 32 + (lane & 31); int sc = n;
            if (n >= 2048 && n < 2560) { const int p = n & 255, hp = p & 127; sc = (n & ~255) + 32 * (hp >> 4) + (p >> 7) * 16 + (hp & 15); }
            cvt_item(F.in[3] + (size_t)l * DM * INW, INW, kb * 64, sc, WSP(bf16, WS_WIN) + (size_t)l * 3584 * DM, DM, nb * 32, scr, lane);
        } else { const int r0 = it - NA, l = r0 / (16 * 32), r = r0 % (16 * 32), kb = r / 32, nb = r % 32;
            cvt_item(F.in[10] + (size_t)l * DM * DM, DM, kb * 64, nb * 32 + (lane & 31), WSP(bf16, WS_WOUT) + (size_t)l * DM * DM, DM, nb * 32, scr, lane);
        }
    }
}
__device__ __forceinline__ void cvt_w13_item(const Frame& F, int layer, int it, LAS float* scr, int lane) {
    const int e = it / (16 * 32), r = it % (16 * 32), kb = r / 32, nb = r % 32;
    const int tile = nb >> 3, rr = (nb & 7) * 32;
    const float* src = (rr < 128 ? F.in[16] : F.in[17]) + ((size_t)layer * NEXP + e) * DM * DE;
    cvt_item(src, DE, kb * 64, 128 * tile + (rr & 127) + (lane & 31), WSP(bf16, WS_W13) + (size_t)e * DM * DM, DM, nb * 32, scr, lane);
}
__device__ __forceinline__ void cvt_w2_item(const Frame& F, int layer, int it, LAS float* scr, int lane) {
    const int le = layer * NEXP + it / (8 * 32), r = it % (8 * 32), kb = r / 32, nb = r % 32;
    cvt_item(F.in[18] + (size_t)le * DE * DM, DM, kb * 64, nb * 32 + (lane & 31), WSP(bf16, WS_W2) + (size_t)le * DM * DE, DE, nb * 32, scr, lane);
}
constexpr int NW13 = 32 * 16 * 32, NW2 = 32 * 8 * 32;
__device__ __forceinline__ void tail_convert(const Frame& F, int kind, int layer, int i0, int i1, int nwg, bool skip_last = false) {
    const int r = nwg % F.G; int prank = F.blk, np = F.G;
    if (r != 0 && F.G - r >= 32) { if (F.blk < r) return; prank = F.blk - r; np = F.G - r;
        if (skip_last) { if (F.blk == F.G - 1) return; --np; } }
    LAS float* scr = (LAS float*)(F.lds + F.wave * 16384);
#pragma unroll 1
    for (int it = i0 + prank * 8 + F.wave; it < i1; it += np * 8) { if (kind == 0) cvt_w13_item(F, layer, it, scr, F.lane); else cvt_w2_item(F, layer, it, scr, F.lane); }
}
__device__ __forceinline__ void gemm1_mfma(const Frame& F, int layer) {
    pg8::Gemm g{(const pg8::bf16_t*)WSP(bf16, WS_XN), (const pg8::bf16_t*)(WSP(bf16, WS_WIN) + (size_t)layer * 3584 * DM), M, 3584, DM};
    pg8::StaticOrder S; S.init(M, 3584, F.G, F.blk);
    EpiInprojM E{F.ws, layer};
    pg8::gemm_phase<EpiInprojM, pg8::StaticOrder, true, true>(F.lds, g, S, E);
}
constexpr int G2_PANELS = 64;
struct OneUnitOrder {
    static constexpr bool GATHER = false;
    int pm, pn;
    __device__ __forceinline__ unsigned goff(const pg8::Unit&, int, int) const { return 0u; }
    __device__ __forceinline__ bool next(int i, pg8::Unit& u) const { if (i != 0) return false; u.pm = pm; u.pn = pn; return true; }
    __device__ __forceinline__ void a_ready(const pg8::Unit&) const {}
    __device__ __forceinline__ void done(const pg8::Unit&) const {}
};
__device__ __forceinline__ void gemm2_unit(const Frame& F, int layer, int pm, int pn);
__device__ __forceinline__ void gemm2_mfma(const Frame& F, int layer) {
    pg8::Gemm g{(const pg8::bf16_t*)WSP(bf16, WS_MIX), (const pg8::bf16_t*)(WSP(bf16, WS_WOUT) + (size_t)layer * DM * DM), M, DM, DM};
    pg8::StaticOrder S; S.init(G2_PANELS * 256, DM, F.G, F.blk);
    EpiResidM E{WSP(float, WS_H), layer == 0 ? F.in[0] : nullptr, F.in[1]};
    pg8::gemm_phase<EpiResidM, pg8::StaticOrder, true, true>(F.lds, g, S, E);
}
__device__ __forceinline__ void gemm2_unit(const Frame& F, int layer, int pm, int pn) {
    pg8::Gemm g{(const pg8::bf16_t*)WSP(bf16, WS_MIX), (const pg8::bf16_t*)(WSP(bf16, WS_WOUT) + (size_t)layer * DM * DM), M, DM, DM};
    OneUnitOrder S{pm, pn};
    EpiResidM E{WSP(float, WS_H), layer == 0 ? F.in[0] : nullptr, F.in[1]};
    pg8::gemm_phase<EpiResidM, OneUnitOrder, true, true>(F.lds, g, S, E);
}
__device__ __forceinline__ void moe_up_mfma(const Frame& F, int layer) {
    LAS int* tb = (LAS int*)(F.lds + 131072);
    moe_tile_bases(F, layer, tb);
    pg8::Gemm g{(const pg8::bf16_t*)WSP(bf16, WS_XN), (const pg8::bf16_t*)WSP(bf16, WS_W13), MAXSLOT, NEXP * 1024, DM};
    MoeOrder<true> S{tb[NEXP] * 4, F.G, F.blk, tb, WSP(int, WS_LIST)};
    EpiMoeUpM E{WSP(bf16, WS_HB)};
    pg8::gemm_phase<EpiMoeUpM, MoeOrder<true>, true, true>(F.lds, g, S, E);
}
__device__ __forceinline__ void moe_down_mfma(const Frame& F, int layer) {
    LAS int* tb = (LAS int*)(F.lds + 131072);
    pg8::Gemm g{(const pg8::bf16_t*)WSP(bf16, WS_HB), (const pg8::bf16_t*)(WSP(bf16, WS_W2) + (size_t)layer * NEXP * DM * DE), MAXSLOT, NEXP * 1024, DE};
    MoeOrder<false> S{tb[NEXP] * 4, F.G, F.blk, tb, nullptr};
    EpiMoeDownM E{WSP(bf16, WS_Y), WSP(float, WS_GLIST), tb};
    pg8::gemm_phase<EpiMoeDownM, MoeOrder<false>, true, true>(F.lds, g, S, E);
}

namespace att {
typedef short bf16x8 __attribute__((ext_vector_type(8)));
typedef short s16x4 __attribute__((ext_vector_type(4)));
typedef float f32x16 __attribute__((ext_vector_type(16)));
constexpr int KSLOT = 10240, VSLOT = 8192;
constexpr int L_K = 0, L_V = 2 * KSLOT, L_WS = L_V + 2 * VSLOT, L_OA = L_WS + 2048, L_OB = L_OA + 32768, L_ITEM = L_OB + 32768;
constexpr float THR = 8.f;
__device__ __forceinline__ int crow(int r, int hi) { return (r & 3) + 8 * (r >> 2) + 4 * hi; }
__device__ __forceinline__ float max3f(float a, float b, float c) { float r; asm("v_max3_f32 %0, %1, %2, %3" : "=v"(r) : "v"(a), "v"(b), "v"(c)); return r; }
typedef float f32x2_t __attribute__((ext_vector_type(2))); typedef __bf16 bf16x2_t __attribute__((ext_vector_type(2)));
__device__ __forceinline__ unsigned cvtpk_s(float lo, float hi) { f32x2_t v = {lo, hi}; bf16x2_t b = __builtin_convertvector(v, bf16x2_t); return __builtin_bit_cast(unsigned, b); }
__device__ __forceinline__ void cmask(f32x16& p0, f32x16& p1, int jb, int qrel, int hi) {
    const float NEG = -INFINITY; const int kb = 64 * jb + 4 * hi;
#pragma unroll
    for (int r = 0; r < 16; ++r) { const int kv = kb + (r & 3) + 8 * (r >> 2); if (kv > qrel) p0[r] = NEG; if (kv + 32 > qrel) p1[r] = NEG; }
}
template <int NS> __device__ __forceinline__ void qkt(f32x16& p0, f32x16& p1, const LAS char* kb, const bf16x8* qr, const f32x16& negm) {
#pragma unroll
    for (int d0 = 0; d0 < NS; ++d0) {
        const bf16x8 b0 = *(const LAS bf16x8*)(kb + d0 * 2048), b1 = *(const LAS bf16x8*)(kb + d0 * 2048 + 512);
        if (d0 == 0) { p0 = __builtin_amdgcn_mfma_f32_32x32x16_bf16(b0, qr[0], negm, 0, 0, 0); p1 = __builtin_amdgcn_mfma_f32_32x32x16_bf16(b1, qr[0], negm, 0, 0, 0); }
        else { p0 = __builtin_amdgcn_mfma_f32_32x32x16_bf16(b0, qr[d0], p0, 0, 0, 0); p1 = __builtin_amdgcn_mfma_f32_32x32x16_bf16(b1, qr[d0], p1, 0, 0, 0); }
    }
}
__device__ __forceinline__ float rowmax(const f32x16& p0, const f32x16& p1) {
#define MX3_(a, b, c) __builtin_fmaxf(__builtin_fmaxf((a), (b)), (c))
    float a = MX3_(p0[0], p0[1], p1[0]), b = MX3_(p0[2], p0[3], p1[1]); a = MX3_(a, p1[2], p1[3]);
#pragma unroll
    for (int r = 4; r < 16; r += 4) { a = MX3_(a, p0[r], p0[r + 1]); b = MX3_(b, p0[r + 2], p0[r + 3]); a = MX3_(a, p1[r], p1[r + 1]); b = MX3_(b, p1[r + 2], p1[r + 3]); }
#undef MX3_
    const float m = __builtin_fmaxf(a, b);
    auto rr = __builtin_amdgcn_permlane32_swap(__float_as_uint(m), __float_as_uint(m), false, false);
    return __builtin_fmaxf(__uint_as_float(rr[0]), __uint_as_float(rr[1]));
}
__device__ __forceinline__ void pv(f32x16* o, int vb, bf16x8 pa0, bf16x8 pa1, bf16x8 pa2, bf16x8 pa3) {
#pragma unroll
    for (int d0 = 0; d0 < 2; ++d0) { s16x4 lo[4], hi[4];
#pragma unroll
        for (int ks = 0; ks < 4; ++ks) {
            asm volatile("ds_read_b64_tr_b16 %0,%1 offset:%c2" : "=&v"(lo[ks]) : "v"(vb), "i"(d0 * 4096 + ks * 1024) : "memory");
            asm volatile("ds_read_b64_tr_b16 %0,%1 offset:%c2" : "=&v"(hi[ks]) : "v"(vb), "i"(d0 * 4096 + ks * 1024 + 512) : "memory"); }
        asm volatile("s_waitcnt lgkmcnt(0)" ::: "memory"); __builtin_amdgcn_sched_barrier(0);
#define PK(k) (bf16x8){lo[k][0], lo[k][1], lo[k][2], lo[k][3], hi[k][0], hi[k][1], hi[k][2], hi[k][3]}
        o[d0] = __builtin_amdgcn_mfma_f32_32x32x16_bf16(pa0, PK(0), o[d0], 0, 0, 0);
        o[d0] = __builtin_amdgcn_mfma_f32_32x32x16_bf16(pa1, PK(1), o[d0], 0, 0, 0);
        o[d0] = __builtin_amdgcn_mfma_f32_32x32x16_bf16(pa2, PK(2), o[d0], 0, 0, 0);
        o[d0] = __builtin_amdgcn_mfma_f32_32x32x16_bf16(pa3, PK(3), o[d0], 0, 0, 0);
#undef PK
    }
}
template <bool DIFF>
__device__ __forceinline__ void attn_map(LAS unsigned char* lds, const bf16* Qrow, const bf16* Kb, const bf16* Vb, const bf16* KX, int NT, int wid, int lane, f32x16 (&o)[2]) {
    constexpr int NQK = DIFF ? 2 : 4, NS = NQK + 1, BAND = DIFF ? 2 : 4;
    const int r32 = lane & 31, hi = lane >> 5, wrow = DIFF ? (wid & 3) : wid, cmap = DIFF ? (wid >> 2) : 0;
    bf16x8 qr[NS];
#pragma unroll
    for (int d0 = 0; d0 < NQK; ++d0) qr[d0] = *(const bf16x8*)(Qrow + d0 * 16 + hi * 8);
    { const short m1 = hi == 0 ? (short)0xBF80 : (short)0; qr[NQK] = (bf16x8){m1, m1, 0, 0, 0, 0, 0, 0}; }
    float mhat = 0.f, l = 0.f; o[0] = f32x16{}; o[1] = f32x16{}; f32x16 negm = f32x16{};
    const int qrel = wrow * 32 + r32, tlast = NT - BAND + (wrow >> 1);
    LAS float* wsf = (LAS float*)(lds + L_WS) + wid * 64;
    const int vb0 = (int)(unsigned)(uintptr_t)(lds + L_V) + ((lane >> 4) & 1) * 32 + (lane & 3) * 8 + (4 * hi + ((lane & 15) >> 2)) * 64;
    const int kdoff = cmap * 4096 + hi * 1024 + r32 * 16;
    u32x4 sk = (u32x4){0u, 0u, 0u, 0u}, sx = sk, sv = sk;
#define LOADT(t) do { const size_t key0_ = (size_t)64 * ((t) + 1); \
        sk = *(const u32x4*)(Kb + (key0_ + lane) * 256 + wid * 8); \
        if (wid == 7) sx = *(const u32x4*)(KX + (key0_ + lane) * 8); \
        sv = *(const u32x4*)(Vb + (key0_ + 16 * (wid & 3) + (lane >> 2)) * 256 + (wid >> 2) * 32 + (lane & 3) * 8); } while (0)
#define STORET(buf) do { LAS unsigned char* kd_ = lds + L_K + (buf) * KSLOT; \
        *(LAS u32x4*)(kd_ + wid * 1024 + lane * 16) = sk; \
        if (wid == 7) *(LAS u32x4*)(kd_ + 8 * 1024 + lane * 16) = sx; \
        *(LAS u32x4*)(lds + L_V + (buf) * VSLOT + wid * 1024 + lane * 16) = sv; } while (0)
    if (wid == 6) { *(LAS u32x4*)(lds + L_K + 9 * 1024 + lane * 16) = (u32x4){0u, 0u, 0u, 0u}; *(LAS u32x4*)(lds + L_K + KSLOT + 9 * 1024 + lane * 16) = (u32x4){0u, 0u, 0u, 0u}; }
    LOADT(NT - 1); STORET(0);
    __syncthreads();
#pragma unroll 1
    for (int i_ = 0; i_ < NT; ++i_) {
        const int t = NT - 1 - i_;
        if (t > 0) LOADT(t - 1);
        const int buf = i_ & 1;
        if (t <= tlast) {
        f32x16 p0, p1;
        { const LAS char* kb = (const LAS char*)(lds + L_K + buf * KSLOT);
#pragma unroll
          for (int d0 = 0; d0 < NS; ++d0) { const LAS char* kp = d0 < NQK ? kb + kdoff + d0 * 2048 : kb + 8 * 1024 + hi * 1024 + r32 * 16;
            const bf16x8 b0 = *(const LAS bf16x8*)kp, b1 = *(const LAS bf16x8*)(kp + 512);
            if (d0 == 0) { p0 = __builtin_amdgcn_mfma_f32_32x32x16_bf16(b0, qr[0], negm, 0, 0, 0); p1 = __builtin_amdgcn_mfma_f32_32x32x16_bf16(b1, qr[0], negm, 0, 0, 0); }
            else { p0 = __builtin_amdgcn_mfma_f32_32x32x16_bf16(b0, qr[d0], p0, 0, 0, 0); p1 = __builtin_amdgcn_mfma_f32_32x32x16_bf16(b1, qr[d0], p1, 0, 0, 0); } } }
        if (t >= NT - BAND) cmask(p0, p1, t - (NT - BAND), qrel, hi);
        const float rm = rowmax(p0, p1);
        const bool first = (t == tlast);
        if (first || __any(rm > THR)) {
            const float dl = first ? rm : fmaxf(rm, 0.f);
            mhat += dl;
#pragma unroll
            for (int r = 0; r < 16; ++r) { p0[r] -= dl; p1[r] -= dl; }
#pragma unroll
            for (int r = 0; r < 16; ++r) negm[r] = -mhat;
            if (!first) {
                const float f = __builtin_amdgcn_exp2f(-dl); l *= f;
                if (hi == 0) wsf[r32] = f;
                asm volatile("s_waitcnt lgkmcnt(0)" ::: "memory");
#pragma unroll
                for (int r = 0; r < 16; ++r) { const float fr = wsf[crow(r, hi)]; o[0][r] *= fr; o[1][r] *= fr; }
            }
        }
        float sacc = 0.f;
#pragma unroll
        for (int r = 0; r < 16; ++r) { p0[r] = __builtin_amdgcn_exp2f(p0[r]); p1[r] = __builtin_amdgcn_exp2f(p1[r]); sacc += p0[r] + p1[r]; }
        l += sacc;
        u32x4 pw0, pw1, pw2, pw3;
        pw0 = (u32x4){cvtpk_s(p0[0], p0[1]), cvtpk_s(p0[2], p0[3]), cvtpk_s(p0[4], p0[5]), cvtpk_s(p0[6], p0[7])};
        pw1 = (u32x4){cvtpk_s(p0[8], p0[9]), cvtpk_s(p0[10], p0[11]), cvtpk_s(p0[12], p0[13]), cvtpk_s(p0[14], p0[15])};
        pw2 = (u32x4){cvtpk_s(p1[0], p1[1]), cvtpk_s(p1[2], p1[3]), cvtpk_s(p1[4], p1[5]), cvtpk_s(p1[6], p1[7])};
        pw3 = (u32x4){cvtpk_s(p1[8], p1[9]), cvtpk_s(p1[10], p1[11]), cvtpk_s(p1[12], p1[13]), cvtpk_s(p1[14], p1[15])};
        pv(o, vb0 + buf * VSLOT, __builtin_bit_cast(bf16x8, pw0), __builtin_bit_cast(bf16x8, pw1), __builtin_bit_cast(bf16x8, pw2), __builtin_bit_cast(bf16x8, pw3));
        }
        if (t > 0) STORET((i_ + 1) & 1);
        __syncthreads();
    }
#undef LOADT
#undef STORET
    { auto rr = __builtin_amdgcn_permlane32_swap(__float_as_uint(l), __float_as_uint(l), false, false); l = __uint_as_float(rr[0]) + __uint_as_float(rr[1]); }
    if (hi == 0) wsf[32 + r32] = l;
    asm volatile("s_waitcnt lgkmcnt(0)" ::: "memory");
#pragma unroll
    for (int r = 0; r < 16; ++r) { const float rl = __builtin_amdgcn_rcpf(wsf[32 + crow(r, hi)]); o[0][r] *= rl; o[1][r] *= rl; }
}
__device__ __forceinline__ void stage_o(LAS unsigned char* stg_base, int blk32, int lane, const f32x16 (&o)[2]) {
    LAS bf16* stg = (LAS bf16*)stg_base + blk32 * 2048; const int r32 = lane & 31, hi = lane >> 5;
#pragma unroll
    for (int r = 0; r < 16; ++r) { const int orow = crow(r, hi);
#pragma unroll
        for (int d0 = 0; d0 < 2; ++d0) stg[orow * 64 + d0 * 32 + r32] = (bf16)f2bf(o[d0][r]); }
    asm volatile("s_waitcnt lgkmcnt(0)" ::: "memory");
}
}


namespace att2 {
using att::bf16x8; using att::s16x4; using att::f32x16; using att::crow; using att::cvtpk_s;
typedef short v4i16_t __attribute__((ext_vector_type(4)));
typedef const LAS char* lds_cptr;
constexpr int SLOTB = 8192, T_K = 0, T_V = 3 * SLOTB, T_WS = 6 * SLOTB, T_OA = T_WS + 2048, T_OB = T_OA + 32768, T_END = T_OB + 32768;
static_assert(T_END <= 131072, "att2 LDS map");
constexpr float THRL = 8.f;
__device__ __forceinline__ s16x4 vtr(lds_cptr p) { return __builtin_bit_cast(s16x4, __builtin_amdgcn_ds_read_tr16_b64_v4i16((LAS v4i16_t*)p)); }
#define SBAR() __builtin_amdgcn_sched_barrier(0)
__device__ __forceinline__ void diff_unit(LAS unsigned char* lds, const bf16* Qrow, const bf16* Kb, const bf16* Vb, int NT, int wid, int lane, f32x16 (&o)[2]) {
    const int r32 = lane & 31, hi = lane >> 5, wrow = wid & 3, cmap = wid >> 2;
    bf16x8 qr[2];
#pragma unroll
    for (int d0 = 0; d0 < 2; ++d0) qr[d0] = *(const bf16x8*)(Qrow + d0 * 16 + hi * 8);
    float mhat = 0.f; o[0] = f32x16{}; o[1] = f32x16{}; f32x16 negm = f32x16{}; asm volatile("" : "+v"(negm));
    f32x16 o2 = f32x16{};
    const bf16x8 ones = (r32 == 0) ? (bf16x8){(short)0x3F80, (short)0x3F80, (short)0x3F80, (short)0x3F80, (short)0x3F80, (short)0x3F80, (short)0x3F80, (short)0x3F80} : (bf16x8){0, 0, 0, 0, 0, 0, 0, 0};
    const int qrel = wrow * 32 + r32;
    LAS float* wsf = (LAS float*)(lds + T_WS) + wid * 64;
    const lds_cptr kp0 = (lds_cptr)(lds + T_K) + cmap * 4096 + hi * 1024 + r32 * 16;
    const lds_cptr vp0 = (lds_cptr)(lds + T_V) + ((lane >> 4) & 1) * 32 + (lane & 3) * 8 + (4 * hi + ((lane & 15) >> 2)) * 64;
    u32x4 sk = (u32x4){0u, 0u, 0u, 0u}, sv = sk, skA = sk, svA = sk, skB = sk, svB = sk;
#define PT(t) ((t) < 2 ? 1 - (t) : (t))
#define LOADKR(R, t) do { const size_t key0_ = (size_t)64 * PT(t); R = *(const u32x4*)(Kb + (key0_ + lane) * 256 + wid * 8); } while (0)
#define LOADK(t) LOADKR(sk, t)
#define LOADVR(R, t) do { const size_t key0_ = (size_t)64 * PT(t); R = *(const u32x4*)(Vb + (key0_ + 16 * (wid & 3) + (lane >> 2)) * 256 + (wid >> 2) * 32 + (lane & 3) * 8); } while (0)
#define LOADV(t) LOADVR(sv, t)
#define STOREKR(R, slot) do { *(LAS u32x4*)(lds + T_K + (slot) + wid * 1024 + lane * 16) = R; } while (0)
#define STOREK(slot) STOREKR(sk, slot)
#define STOREVR(R, slot) do { *(LAS u32x4*)(lds + T_V + (slot) + wid * 1024 + lane * 16) = R; } while (0)
#define STOREV(slot) STOREVR(sv, slot)
#define KLOAD2(j, kp) do { kf[2 * (j)] = *(const LAS bf16x8*)((kp) + (j) * 2048); kf[2 * (j) + 1] = *(const LAS bf16x8*)((kp) + (j) * 2048 + 512); } while (0)
#define CMASKT(P0, P1, t) do { const int jb_ = (t) - (NT - 2); \
        if ((t) == 1) { _Pragma("unroll") for (int r = 0; r < 16; ++r) { P0[r] = -INFINITY; P1[r] = -INFINITY; } } \
        else if (jb_ >= 0) { const int kb_ = 64 * jb_ + 4 * hi; _Pragma("unroll") for (int r = 0; r < 16; ++r) { const int kv_ = kb_ + (r & 3) + 8 * (r >> 2); if (kv_ > qrel) P0[r] = -INFINITY; if (kv_ + 32 > qrel) P1[r] = -INFINITY; } } } while (0)
    LOADK(0); LOADV(0); STOREK(0); STOREV(0); LOADK(1); STOREK(SLOTB); LOADK(2); STOREK(2 * SLOTB);
    __syncthreads();
    f32x16 pA0, pA1, pB0, pB1;
    bool resc = false;
    { const lds_cptr kb = kp0;
#pragma unroll
      for (int d0 = 0; d0 < 2; ++d0) { const bf16x8 b0 = *(const LAS bf16x8*)(kb + d0 * 2048), b1 = *(const LAS bf16x8*)(kb + d0 * 2048 + 512);
        if (d0 == 0) { pA0 = __builtin_amdgcn_mfma_f32_32x32x16_bf16(b0, qr[0], negm, 0, 0, 0); pA1 = __builtin_amdgcn_mfma_f32_32x32x16_bf16(b1, qr[0], negm, 0, 0, 0); }
        else { pA0 = __builtin_amdgcn_mfma_f32_32x32x16_bf16(b0, qr[1], pA0, 0, 0, 0); pA1 = __builtin_amdgcn_mfma_f32_32x32x16_bf16(b1, qr[1], pA1, 0, 0, 0); } }
#pragma unroll
      for (int r = 0; r < 16; ++r) { pA0[r] = -INFINITY; if (crow(r, hi) < 16) pA1[r] = -INFINITY; }
      const float rm = att::rowmax(pA0, pA1);
      mhat += rm;
#pragma unroll
      for (int r = 0; r < 16; ++r) { pA0[r] -= rm; pA1[r] -= rm; }
#pragma unroll
      for (int r = 0; r < 16; ++r) negm[r] = -mhat;
      asm volatile("" : "+v"(negm));
#pragma unroll
      for (int r = 0; r < 16; ++r) { pA0[r] = __builtin_amdgcn_exp2f(pA0[r]); pA1[r] = __builtin_amdgcn_exp2f(pA1[r]); } }
    __syncthreads();
    if (3 < NT) { LOADK(3); STOREK(0); }
    LOADV(1); STOREV(SLOTB);
    int sl_prev = 0, sl_cur = SLOTB, sl_next = 2 * SLOTB;
    bf16x8 kf[4];
    KLOAD2(0, kp0 + sl_cur); KLOAD2(1, kp0 + sl_cur);
    __syncthreads();
    s16x4 vlo[8], vhi[8]; u32x4 pw0, pw1, pw2, pw3;
#define PKW(P, B) cvtpk_s(P[B], P[B + 1])
#define PAF(k) __builtin_bit_cast(bf16x8, pw##k)
#define VFR(i) (bf16x8){vlo[i][0], vlo[i][1], vlo[i][2], vlo[i][3], vhi[i][0], vhi[i][1], vhi[i][2], vhi[i][3]}
#define PIN(x) asm volatile("" : "+v"(x))
#define MX3(a, b, c) __builtin_fmaxf(__builtin_fmaxf((a), (b)), (c))
#define GAPA(MF, A0, A1, A2, A3, W0, W1, PW) do { MF; W0; W1; PIN(PW); SBAR(); } while (0)
#define OSUM(k) o2 = __builtin_amdgcn_mfma_f32_32x32x16_bf16(PAF(k), ones, o2, 0, 0, 0)
#define EX(v) __builtin_amdgcn_exp2f(v)
#define GAPB(MF, X, B) do { MF; X[B] = EX(X[B]); X[B + 1] = EX(X[B + 1]); X[B + 2] = EX(X[B + 2]); X[B + 3] = EX(X[B + 3]); PIN(X); SBAR(); } while (0)
#define VRD(i) do { vlo[i] = vtr(vp_ + (((i) >> 2) * 4096 + ((i) & 3) * 1024)); vhi[i] = vtr(vp_ + (((i) >> 2) * 4096 + ((i) & 3) * 1024 + 512)); } while (0)
#define KRD(G, j) do { if (G) { KLOAD2(j, kp0 + sl_next); SBAR(); } } while (0)
#define NOMF ((void)0)
#define STEP(C0, C1, P0, P1, t, MASKED, LK, LV, SK, SV) do { SBAR(); \
        if ((t) + 3 < NT) LOADKR(LK, (t) + 3); if ((t) + 1 < NT) LOADVR(LV, (t) + 1); \
        const lds_cptr vp_ = vp0 + sl_prev; \
        VRD(0); SBAR(); \
        GAPA(C0 = __builtin_amdgcn_mfma_f32_32x32x16_bf16(kf[0], qr[0], negm, 0, 0, 0), P0[2], P0[3], P0[4], P0[5],     pw0[0] = PKW(P0, 0), pw0[1] = PKW(P0, 2), pw0); \
        VRD(4); SBAR(); GAPA(C1 = __builtin_amdgcn_mfma_f32_32x32x16_bf16(kf[1], qr[0], negm, 0, 0, 0), P0[6], P0[7], P0[8], P0[9],     pw0[2] = PKW(P0, 4), pw0[3] = PKW(P0, 6), pw0); \
        VRD(1); SBAR(); GAPA(C0 = __builtin_amdgcn_mfma_f32_32x32x16_bf16(kf[2], qr[1], C0, 0, 0, 0),   P0[10], P0[11], P0[12], P0[13], pw1[0] = PKW(P0, 8), pw1[1] = PKW(P0, 10), pw1); \
        VRD(5); SBAR(); GAPA(C1 = __builtin_amdgcn_mfma_f32_32x32x16_bf16(kf[3], qr[1], C1, 0, 0, 0),   P0[14], P0[15], P1[0], P1[1],   pw1[2] = PKW(P0, 12), pw1[3] = PKW(P0, 14), pw1); \
        VRD(2); SBAR(); GAPA(OSUM(0), P1[2], P1[3], P1[4], P1[5],     pw2[0] = PKW(P1, 0), pw2[1] = PKW(P1, 2), pw2); \
        VRD(6); SBAR(); GAPA(OSUM(1), P1[6], P1[7], P1[8], P1[9],     pw2[2] = PKW(P1, 4), pw2[3] = PKW(P1, 6), pw2); \
        VRD(3); SBAR(); GAPA(OSUM(2), P1[10], P1[11], P1[12], P1[13], pw3[0] = PKW(P1, 8), pw3[1] = PKW(P1, 10), pw3); \
        VRD(7); SBAR(); GAPA(NOMF, P1[14], P1[15], 0.f, 0.f,       pw3[2] = PKW(P1, 12), pw3[3] = PKW(P1, 14), pw3); \
        OSUM(3); \
        if (MASKED) CMASKT(C0, C1, t); \
        { float a = MX3(C0[0], C0[1], C1[0]), b = MX3(C0[2], C0[3], C1[1]); a = MX3(a, C1[2], C1[3]); \
          _Pragma("unroll") for (int r = 4; r < 16; r += 4) { a = MX3(a, C0[r], C0[r + 1]); b = MX3(b, C0[r + 2], C0[r + 3]); a = MX3(a, C1[r], C1[r + 1]); b = MX3(b, C1[r + 2], C1[r + 3]); } \
          float rm = __builtin_fmaxf(a, b); { auto rr = __builtin_amdgcn_permlane32_swap(__float_as_uint(rm), __float_as_uint(rm), false, false); rm = __builtin_fmaxf(__uint_as_float(rr[0]), __uint_as_float(rr[1])); } \
          resc = false; \
          if (__builtin_expect(__any(rm > THRL), 0)) { const float dl = __builtin_fmaxf(rm, 0.f); mhat += dl; \
            _Pragma("unroll") for (int r = 0; r < 16; ++r) { C0[r] -= dl; C1[r] -= dl; } \
            _Pragma("unroll") for (int r = 0; r < 16; ++r) negm[r] = -mhat; asm volatile("" : "+v"(negm)); \
            const float f = __builtin_amdgcn_exp2f(-dl); if (hi == 0) wsf[r32] = f; resc = true; } } \
        SBAR(); \
        GAPB(o[0] = __builtin_amdgcn_mfma_f32_32x32x16_bf16(PAF(0), VFR(0), o[0], 0, 0, 0), C0, 0); \
        GAPB(o[1] = __builtin_amdgcn_mfma_f32_32x32x16_bf16(PAF(0), VFR(4), o[1], 0, 0, 0), C0, 4); \
        KRD((t) + 1 < NT, 0); GAPB(o[0] = __builtin_amdgcn_mfma_f32_32x32x16_bf16(PAF(1), VFR(1), o[0], 0, 0, 0), C0, 8); \
        KRD((t) + 1 < NT, 1); GAPB(o[1] = __builtin_amdgcn_mfma_f32_32x32x16_bf16(PAF(1), VFR(5), o[1], 0, 0, 0), C0, 12); \
        GAPB(o[0] = __builtin_amdgcn_mfma_f32_32x32x16_bf16(PAF(2), VFR(2), o[0], 0, 0, 0), C1, 0); \
        GAPB(o[1] = __builtin_amdgcn_mfma_f32_32x32x16_bf16(PAF(2), VFR(6), o[1], 0, 0, 0), C1, 4); \
        GAPB(o[0] = __builtin_amdgcn_mfma_f32_32x32x16_bf16(PAF(3), VFR(3), o[0], 0, 0, 0), C1, 8); \
        GAPB(o[1] = __builtin_amdgcn_mfma_f32_32x32x16_bf16(PAF(3), VFR(7), o[1], 0, 0, 0), C1, 12); \
        if ((t) >= 2) { if ((t) + 2 < NT) STOREKR(SK, sl_prev); STOREVR(SV, sl_cur); } \
    } while (0)
#define RESC() do { if (resc) { asm volatile("s_waitcnt lgkmcnt(0)" ::: "memory"); \
        _Pragma("unroll") for (int r = 0; r < 16; ++r) { const float fr_ = wsf[crow(r, hi)]; o[0][r] *= fr_; o[1][r] *= fr_; o2[r] *= fr_; } } } while (0)
#define ROT() do { sl_prev = sl_cur; sl_cur = sl_next; sl_next = (sl_next == 2 * SLOTB) ? 0 : sl_next + SLOTB; } while (0)
#define ENDSTEP() do { __syncthreads(); RESC(); ROT(); } while (0)
    int t = 1;
    STEP(pB0, pB1, pA0, pA1, t, true, skA, svA, skB, svB); ENDSTEP(); ++t;
    if (t + 1 < NT) { STEP(pA0, pA1, pB0, pB1, t, true, skB, svB, skA, svA); ENDSTEP(); ++t; }
#pragma unroll 1
    for (; t + 3 < NT; t += 2) {
        STEP(pB0, pB1, pA0, pA1, t, false, skA, svA, skB, svB);     ENDSTEP();
        STEP(pA0, pA1, pB0, pB1, t + 1, false, skB, svB, skA, svA); ENDSTEP();
    }
#pragma unroll 1
    for (; t + 1 < NT; t += 2) {
        STEP(pB0, pB1, pA0, pA1, t, true, skA, svA, skB, svB);      ENDSTEP();
        STEP(pA0, pA1, pB0, pB1, t + 1, true, skB, svB, skA, svA);  ENDSTEP();
    }
    STEP(pB0, pB1, pA0, pA1, NT - 1, true, skA, svA, skB, svB); __syncthreads(); RESC();
    {
      pw0 = (u32x4){PKW(pB0, 0), PKW(pB0, 2), PKW(pB0, 4), PKW(pB0, 6)}; pw1 = (u32x4){PKW(pB0, 8), PKW(pB0, 10), PKW(pB0, 12), PKW(pB0, 14)};
      pw2 = (u32x4){PKW(pB1, 0), PKW(pB1, 2), PKW(pB1, 4), PKW(pB1, 6)}; pw3 = (u32x4){PKW(pB1, 8), PKW(pB1, 10), PKW(pB1, 12), PKW(pB1, 14)};
      OSUM(0); OSUM(1); OSUM(2); OSUM(3);
      SBAR();
      att::pv(o, (int)(unsigned)(uintptr_t)(lds + T_V) + ((lane >> 4) & 1) * 32 + (lane & 3) * 8 + (4 * hi + ((lane & 15) >> 2)) * 64 + sl_cur, PAF(0), PAF(1), PAF(2), PAF(3)); }
    asm volatile("s_nop 7\n\ts_nop 7" : "+v"(o2));
#pragma unroll
    for (int r = 0; r < 16; ++r) { const float l0_ = __shfl(o2[r], 0), l1_ = __shfl(o2[r], 32); const float rl = __builtin_amdgcn_rcpf(hi ? l1_ : l0_); o[0][r] *= rl; o[1][r] *= rl; }
    __syncthreads();
#undef PT
#undef LOADK
#undef LOADV
#undef STOREK
#undef STOREV
#undef LOADKR
#undef LOADVR
#undef STOREKR
#undef STOREVR
#undef KLOAD2
#undef CMASKT
#undef PKW
#undef PAF
#undef VFR
#undef PIN
#undef MX3
#undef GAPA
#undef OSUM
#undef EX
#undef GAPB
#undef VRD
#undef KRD
#undef NOMF
#undef STEP
#undef RESC
#undef ROT
#undef ENDSTEP
}
#undef SBAR
}

namespace hg {
typedef short bf16x8 __attribute__((ext_vector_type(8)));
typedef short s16x4 __attribute__((ext_vector_type(4)));
typedef float f32x16 __attribute__((ext_vector_type(16)));
constexpr int NCK = LSEQ / 64, NITEM = 8 * NCK;
constexpr int RS = 272;
__device__ __forceinline__ bf16x8 trfrag(unsigned addr) {
    s16x4 lo, hi;
    asm volatile("ds_read_b64_tr_b16 %0,%2\n\tds_read_b64_tr_b16 %1,%2 offset:512\n\ts_waitcnt lgkmcnt(0)" : "=&v"(lo), "=&v"(hi) : "v"(addr) : "memory");
    return (bf16x8){lo[0], lo[1], lo[2], lo[3], hi[0], hi[1], hi[2], hi[3]};
}
constexpr int A_SEG = 0, A_KH = 2048, A_VH = A_KH + 16384, A_ST = A_VH + 16384;
constexpr int C_SEG = 0, C_QS = 4096, C_QA = C_QS + 64 * RS, C_KA = C_QA + 64 * RS, C_VH = C_KA + 64 * RS, C_S = C_VH + 16384, C_OUT = C_QS, C_END = C_S + 128 * RS;
static_assert(C_END <= 131072 && 64 * 128 * 4 <= 2 * 64 * RS, "hg3 LDS map");
}
__device__ __forceinline__ void hg1_item(const Frame& F, int item) {
    using namespace hg;
    const int bh = item / NCK, ck = item % NCK, b = bh >> 2, h = bh & 3;
    const size_t m0 = (size_t)b * LSEQ + 64 * ck;
    const int tid = F.tid, seg = tid >> 7, c = tid & 127, wid = F.wave, lane = F.lane, r32 = lane & 31, hi = lane >> 5;
    const float* LF = WSP(float, WS_HLF) + m0 * 512 + 128 * h; const bf16* KK = WSP(bf16, WS_HK) + m0 * 512 + 128 * h; const bf16* VV = WSP(bf16, WS_HV) + m0 * 512 + 128 * h;
    LAS float* segtot = (LAS float*)(F.lds + A_SEG);
#pragma unroll
    for (int i = 0; i < 2; ++i) { const int p = tid + 512 * i, row = p >> 4, j = p & 15;
        *(LAS u32x4*)(F.lds + A_VH + (j >> 2) * 4096 + row * 64 + (j & 3) * 16) = *(const u32x4*)(VV + (size_t)row * 512 + j * 8); }
    float g[16]; bf16 kraw[16];
#pragma unroll
    for (int i = 0; i < 16; ++i) { g[i] = LF[(size_t)(16 * seg + i) * 512 + c]; kraw[i] = KK[(size_t)(16 * seg + i) * 512 + c]; }
    float run = 0.f;
#pragma unroll
    for (int i = 0; i < 16; ++i) { run += g[i]; g[i] = run; }
    segtot[seg * 128 + c] = run;
    __syncthreads();
    float off = 0.f, tot = 0.f;
#pragma unroll
    for (int q = 0; q < 4; ++q) { const float v = segtot[q * 128 + c]; tot += v; if (q < seg) off += v; }
#pragma unroll
    for (int i = 0; i < 16; ++i) { const int s_ = 16 * seg + i; const float e = __expf(tot - (g[i] + off));
        *(LAS bf16*)(F.lds + A_KH + (c >> 5) * 4096 + s_ * 64 + (c & 31) * 2) = (bf16)f2bf(bf2f(kraw[i]) * e); }
    if (seg == 0) st_wt(WSP(float, WS_DEC), WSP(float, WS_DEC) + (size_t)item * 128 + c, __expf(tot));
    __syncthreads();
    const unsigned tb = (unsigned)(uintptr_t)F.lds + ((lane >> 4) & 1) * 32 + (lane & 3) * 8 + (4 * hi + ((lane & 15) >> 2)) * 64;
    const int vblk = wid >> 1;
    bf16x8 af[4];
#pragma unroll
    for (int ks = 0; ks < 4; ++ks) af[ks] = trfrag(tb + A_VH + vblk * 4096 + ks * 1024);
    LAS bf16* stg = (LAS bf16*)(F.lds + A_ST);
#pragma unroll
    for (int cc = 0; cc < 2; ++cc) { const int cblk = (wid & 1) * 2 + cc; f32x16 acc = f32x16{};
#pragma unroll
        for (int ks = 0; ks < 4; ++ks) acc = __builtin_amdgcn_mfma_f32_32x32x16_bf16(af[ks], trfrag(tb + A_KH + cblk * 4096 + ks * 1024), acc, 0, 0, 0);
#pragma unroll
        for (int r = 0; r < 16; ++r) stg[(32 * vblk + att::crow(r, hi)) * 128 + 32 * cblk + r32] = (bf16)f2bf(acc[r]); }
    __syncthreads();
    bf16* UT = WSP(bf16, WS_UT) + (size_t)item * 16384;
#pragma unroll
    for (int i = 0; i < 4; ++i) { const int p = tid + 512 * i; st_wt(WSP(bf16, WS_UT), UT + p * 8, *(const LAS u32x4*)(F.lds + A_ST + p * 16)); }
    asm volatile("s_waitcnt vmcnt(0)" ::: "memory");
    __syncthreads();
}
__device__ __forceinline__ void hg2_item(const Frame& F, int item) {
    using namespace hg;
    const bf16* UT = WSP(bf16, WS_UT); bf16* ST = WSP(bf16, WS_ST); const float* DEC = WSP(float, WS_DEC);
    const int gid = item * 512 + F.tid;
    const int bh = gid >> 14, idx = gid & 16383, c = idx & 127;
    float S = 0.f;
    const size_t base = (size_t)bh * NCK * 16384 + idx; const float* dp = DEC + (size_t)bh * NCK * 128 + c;
#pragma unroll 1
    for (int j0 = 0; j0 < NCK; j0 += 65) {
        bf16 u[65]; float d[65];
#pragma unroll
        for (int j = 0; j < 65; ++j) { u[j] = UT[base + (size_t)(j0 + j) * 16384]; d[j] = dp[(j0 + j) * 128]; }
#pragma unroll
        for (int j = 0; j < 65; ++j) { st_wt(ST, ST + base + (size_t)(j0 + j) * 16384, (unsigned short)f2bf(S)); S = d[j] * S + bf2f(u[j]); }
    }
    asm volatile("s_waitcnt vmcnt(0)" ::: "memory");
    __syncthreads();
}
__device__ __forceinline__ void hand_post(const Frame& F, unsigned* c) { if (F.tid == 0) (void)__hip_atomic_fetch_add(c, 1u, __ATOMIC_RELAXED, __HIP_MEMORY_SCOPE_AGENT); }
__device__ __forceinline__ void hand_wait(const Frame& F, unsigned* c, unsigned target) {
    if (F.tid == 0) { unsigned sp = 0u; unsigned* tmo = WSP(unsigned, WS_CTL) + CW_BAR + XB_TMO;
        while (__hip_atomic_load(c, __ATOMIC_RELAXED, __HIP_MEMORY_SCOPE_AGENT) < target) { __builtin_amdgcn_s_sleep(2);
            if ((++sp & 255u) == 0u) { if (xb_ld(tmo)) break; if (sp > (1u << 22)) { atomicAdd(tmo, 1u); break; } } }
        __builtin_amdgcn_fence(__ATOMIC_ACQUIRE, "agent");
        asm volatile("s_waitcnt vmcnt(0)" ::: "memory"); }
    __syncthreads();
}
__device__ __forceinline__ void hg3_item(const Frame& F, int layer, int item, bool prod = false  ) {
    using namespace hg;
    const int bh = item / NCK, ck = item % NCK, b = bh >> 2, h = bh & 3;
    const size_t m0 = (size_t)b * LSEQ + 64 * ck;
    const int tid = F.tid, seg = tid >> 7, c = tid & 127, wid = F.wave, lane = F.lane, r32 = lane & 31, hi = lane >> 5;
    const float* LF = WSP(float, WS_HLF) + m0 * 512 + 128 * h; const bf16* KK = WSP(bf16, WS_HK) + m0 * 512 + 128 * h; const bf16* VV = WSP(bf16, WS_HV) + m0 * 512 + 128 * h;
    const bf16* QQ = WSP(bf16, WS_HQ) + m0 * 512 + 128 * h; const bf16* SG = WSP(bf16, WS_ST) + (size_t)item * 16384;
    LAS float* segtot = (LAS float*)(F.lds + C_SEG);
#pragma unroll
    for (int i = 0; i < 2; ++i) { const int p = tid + 512 * i, row = p >> 4, j = p & 15;
        *(LAS u32x4*)(F.lds + C_VH + (j >> 2) * 4096 + row * 64 + (j & 3) * 16) = *(const u32x4*)(VV + (size_t)row * 512 + j * 8); }
#pragma unroll
    for (int i = 0; i < 4; ++i) { const int p = tid + 512 * i, v = p >> 4, j = p & 15;
        *(LAS u32x4*)(F.lds + C_S + v * RS + j * 16) = *(const u32x4*)(SG + p * 8); }
    float g[16]; bf16 qraw[16], kraw[16];
#pragma unroll
    for (int i = 0; i < 16; ++i) { const size_t o_ = (size_t)(16 * seg + i) * 512 + c; g[i] = LF[o_]; qraw[i] = QQ[o_]; kraw[i] = KK[o_]; }
    const bf16* gp_ = WSP(bf16, WS_HG) + (m0 + (tid >> 3)) * 512 + 128 * h + (tid & 7) * 16;
    const u32x4 ga = *(const u32x4*)gp_, gb = *(const u32x4*)(gp_ + 8);
    float run = 0.f;
#pragma unroll
    for (int i = 0; i < 16; ++i) { run += g[i]; g[i] = run; }
    segtot[seg * 128 + c] = run;
    __syncthreads();
    const float t0_ = segtot[c], t1_ = segtot[128 + c], t2_ = segtot[256 + c];
    const float off = (seg > 0 ? t0_ : 0.f) + (seg > 1 ? t1_ : 0.f) + (seg > 2 ? t2_ : 0.f), R = t0_ + t1_;
#pragma unroll
    for (int i = 0; i < 16; ++i) { const int t = 16 * seg + i; const float G = g[i] + off;
        const float q = bf2f(qraw[i]), kk = bf2f(kraw[i]);
        *(LAS bf16*)(F.lds + C_QS + t * RS + c * 2) = (bf16)f2bf(q * __expf(G));
        *(LAS bf16*)(F.lds + C_QA + t * RS + c * 2) = (bf16)f2bf(q * __expf(G - R));
        *(LAS bf16*)(F.lds + C_KA + t * RS + c * 2) = (bf16)f2bf(kk * __expf(R - G)); }
    __syncthreads();
    const int tbk = wid >> 2, vb = wid & 3;
    f32x16 o = f32x16{};
    { const LAS unsigned char* qa = F.lds + C_QS + (32 * tbk + r32) * RS + hi * 16; const LAS unsigned char* sa = F.lds + C_S + (32 * vb + r32) * RS + hi * 16;
#pragma unroll
      for (int kk = 0; kk < 8; ++kk) o = __builtin_amdgcn_mfma_f32_32x32x16_bf16(*(const LAS bf16x8*)(qa + kk * 32), *(const LAS bf16x8*)(sa + kk * 32), o, 0, 0, 0); }
    const unsigned tb = (unsigned)(uintptr_t)F.lds + ((lane >> 4) & 1) * 32 + (lane & 3) * 8 + (4 * hi + ((lane & 15) >> 2)) * 64;
#pragma unroll
    for (int sb = 0; sb < 2; ++sb) {
        if (sb <= tbk) {
            f32x16 p = f32x16{};
            const LAS unsigned char* ka = F.lds + C_KA + (32 * sb + r32) * RS + hi * 16; const LAS unsigned char* qq = F.lds + C_QA + (32 * tbk + r32) * RS + hi * 16;
#pragma unroll
            for (int kk = 0; kk < 8; ++kk) p = __builtin_amdgcn_mfma_f32_32x32x16_bf16(*(const LAS bf16x8*)(ka + kk * 32), *(const LAS bf16x8*)(qq + kk * 32), p, 0, 0, 0);
            if (sb == tbk) {
#pragma unroll
                for (int r = 0; r < 16; ++r) if (att::crow(r, hi) > r32) p[r] = 0.f; }
            const u32x4 pw0 = (u32x4){att::cvtpk_s(p[0], p[1]), att::cvtpk_s(p[2], p[3]), att::cvtpk_s(p[4], p[5]), att::cvtpk_s(p[6], p[7])};
            const u32x4 pw1 = (u32x4){att::cvtpk_s(p[8], p[9]), att::cvtpk_s(p[10], p[11]), att::cvtpk_s(p[12], p[13]), att::cvtpk_s(p[14], p[15])};
            o = __builtin_amdgcn_mfma_f32_32x32x16_bf16(__builtin_bit_cast(bf16x8, pw0), trfrag(tb + C_VH + vb * 4096 + (2 * sb) * 1024), o, 0, 0, 0);
            o = __builtin_amdgcn_mfma_f32_32x32x16_bf16(__builtin_bit_cast(bf16x8, pw1), trfrag(tb + C_VH + vb * 4096 + (2 * sb + 1) * 1024), o, 0, 0, 0);
        }
    }
    __syncthreads();
    LAS float* ost = (LAS float*)(F.lds + C_OUT);
#pragma unroll
    for (int r = 0; r < 16; ++r) ost[(32 * tbk + att::crow(r, hi)) * 128 + 32 * vb + r32] = o[r];
    __syncthreads();
    { const int row = tid >> 3, s8 = tid & 7; float x[16];
#pragma unroll
      for (int q = 0; q < 4; ++q) { const f32x4 w = *(const LAS f32x4*)(ost + row * 128 + s8 * 16 + 4 * q); x[4 * q] = w.x; x[4 * q + 1] = w.y; x[4 * q + 2] = w.z; x[4 * q + 3] = w.w; }
      float ss = 0.f;
#pragma unroll
      for (int e = 0; e < 16; ++e) ss += x[e] * x[e];
      ss += __shfl_xor(ss, 1); ss += __shfl_xor(ss, 2); ss += __shfl_xor(ss, 4);
      const float rn = rsqrtf(ss * (1.f / 128.f) + EPS);
      const float* gn = F.in[5] + layer * 128 + s8 * 16;
      const float gt[16] = {bflo(ga.x), bfhi(ga.x), bflo(ga.y), bfhi(ga.y), bflo(ga.z), bfhi(ga.z), bflo(ga.w), bfhi(ga.w), bflo(gb.x), bfhi(gb.x), bflo(gb.y), bfhi(gb.y), bflo(gb.z), bfhi(gb.z), bflo(gb.w), bfhi(gb.w)};
      float y0[8], y1[8];
#pragma unroll
      for (int e = 0; e < 8; ++e) { y0[e] = x[e] * rn * gn[e] * gt[e]; y1[e] = x[8 + e] * rn * gn[8 + e] * gt[8 + e]; }
      bf16* mp = WSP(bf16, WS_MIX) + (m0 + row) * DM + 128 * h + s8 * 16;
      if (prod) { st_wt(WSP(bf16, WS_MIX), mp, pack8(y0)); st_wt(WSP(bf16, WS_MIX), mp + 8, pack8(y1)); asm volatile("s_waitcnt vmcnt(0)" ::: "memory"); }
      else { *(u32x4*)mp = pack8(y0); *(u32x4*)(mp + 8) = pack8(y1); } }
    __syncthreads();
}

__device__ __forceinline__ void attn_queue(const Frame& F, int layer) {
    using namespace att;
    const int lane0 = F.lane;
    unsigned* QC = WSP(unsigned, WS_CTL) + CW_QATT + 64 * layer;
    volatile LAS int* sItem = (volatile LAS int*)(F.lds + L_ITEM);
    const float* lv = F.in[6] + layer * 128;
    const float lam_init = 0.8f - 0.6f * expf(-0.3f * (float)layer);
    float lam; { float a = lane0 < 32 ? lv[lane0] * lv[32 + lane0] : 0.f, c = lane0 < 32 ? lv[64 + lane0] * lv[96 + lane0] : 0.f; a = wave_sum(a); c = wave_sum(c); lam = expf(a) - expf(c) + lam_init; }
    constexpr int NH1 = hg::NITEM, NATT = 768, NH2 = 256, NSERV = 64;
    unsigned* HC = WSP(unsigned, WS_CTL) + CW_HG + 64 * layer; unsigned* QS = QC + 32;
#define QCLAIM(q, dst) do { if (F.tid == 0) *sItem = (int)__hip_atomic_fetch_add(q, 1u, __ATOMIC_RELAXED, __HIP_MEMORY_SCOPE_AGENT); __syncthreads(); dst = *sItem; __syncthreads(); } while (0)
    if (F.blk < NSERV) {
        int s_; QCLAIM(QS, s_);
        unsigned seen1 = 0u, seen2 = 0u;
#pragma unroll 1
        while (s_ < NH1 / 8) {
#pragma unroll 1
            for (int k = 0; k < 8; ++k) { hg1_item(F, 8 * s_ + k); hand_post(F, HC + (8 * s_ + k) / hg::NCK); }
            QCLAIM(QS, s_); }
#pragma unroll 1
        while (s_ < NH1 / 8 + NH2) { const int i2 = s_ - NH1 / 8, bh2 = i2 >> 5;
            if (!((seen1 >> bh2) & 1u)) { hand_wait(F, HC + bh2, (unsigned)hg::NCK); seen1 |= 1u << bh2; }
            hg2_item(F, i2); hand_post(F, HC + 16 + bh2); QCLAIM(QS, s_); }
#pragma unroll 1
        while (s_ < NH1 / 8 + NH2 + NH1 / 4) {
#pragma unroll 1
            for (int k = 0; k < 4; ++k) { const int i3 = 4 * (s_ - NH1 / 8 - NH2) + k, bh3 = i3 / hg::NCK;
                if (!((seen2 >> bh3) & 1u)) { hand_wait(F, HC + 16 + bh3, 32u); seen2 |= 1u << bh3; }
                const bool prod3 = bh3 >= 4 && (i3 - bh3 * hg::NCK) >= hg::NCK - 4;
                hg3_item(F, layer, i3, prod3); if (prod3) hand_post(F, HC + 32); }
            QCLAIM(QS, s_); }
        const int c0 = NH1 / 8 + NH2 + NH1 / 4;
        { const int a0 = layer == 0 ? 9500 : 12000, nA = NW13 - a0, nT = nA + (layer == 0 ? 0 : 3000); LAS float* scr = (LAS float*)(F.lds + F.wave * 16384);
#pragma unroll 1
          while (s_ < c0 + (nT + 15) / 16) {
#pragma unroll 1
              for (int k = 0; k < 2; ++k) { const int idx = 16 * (s_ - c0) + 8 * k + F.wave;
                  if (idx < nA) cvt_w13_item(F, layer, a0 + idx, scr, F.lane); else if (idx < nT) cvt_w2_item(F, layer, idx - nA, scr, F.lane); }
              __syncthreads();
              QCLAIM(QS, s_); }
          const int c1 = c0 + (nT + 15) / 16;
#pragma unroll 1
          while (s_ < c1 + 4) { hand_wait(F, HC + 32, 28u); gemm2_unit(F, layer, G2_PANELS, s_ - c1); __syncthreads(); QCLAIM(QS, s_); } }
    }
    int qit; QCLAIM(QC, qit);
    for (;;) {
        if (qit >= NATT) break;
        const int it = qit;
        Frame Fi = F; asm volatile("" : "+v"(Fi.lane), "+v"(Fi.tid)); asm volatile("" : "+s"(Fi.ws), "+s"(Fi.wave));
        const int wid = Fi.wave, lane = Fi.lane; bf16* MIX = (bf16*)(Fi.ws + WS_MIX);
#define F Fi
        const int lvl = it / 24, r = it % 24, qb = 31 - lvl, bh = r & 7, b = bh >> 2, h = bh & 3;
        const size_t rb = (size_t)b * LSEQ;
        const int ch = lane & 7;
        if (r < 8) {
            const size_t row0 = rb + 128 + 256 * qb; const bool prodA = b == 1 && qb == 31;
            f32x16 o[2];
            attn_map<false>(F.lds, WSP(bf16, WS_FQ) + (row0 + wid * 32 + (lane & 31)) * 256 + 64 * h, WSP(bf16, WS_FK) + rb * 256 + 64 * h, WSP(bf16, WS_FV) + rb * 256 + 64 * h,
                            WSP(bf16, WS_KXF) + (size_t)bh * LSEQ * 8, 4 * qb + 5, wid, lane, o);
            stage_o(F.lds + L_OA, wid, lane, o);
            const LAS bf16* stg = (const LAS bf16*)(F.lds + L_OA) + wid * 2048; const float* gn = F.in[9] + layer * 64 + ch * 8;
#pragma unroll
            for (int i = 0; i < 4; ++i) { const int row = i * 8 + (lane >> 3); const u32x4 w = *(const LAS u32x4*)(stg + row * 64 + ch * 8);
                float x[8] = {bflo(w.x), bfhi(w.x), bflo(w.y), bfhi(w.y), bflo(w.z), bfhi(w.z), bflo(w.w), bfhi(w.w)};
                float ss = 0.f;
#pragma unroll
                for (int e = 0; e < 8; ++e) ss += x[e] * x[e];
                ss += __shfl_xor(ss, 1); ss += __shfl_xor(ss, 2); ss += __shfl_xor(ss, 4);
                const float rn = rsqrtf(ss * (1.f / 64.f) + EPS);
#pragma unroll
                for (int e = 0; e < 8; ++e) x[e] *= rn * gn[e];
                if (prodA) st_wt(MIX, MIX + (row0 + wid * 32 + row) * DM + 768 + 64 * h + ch * 8, pack8(x)); else *(u32x4*)(MIX + (row0 + wid * 32 + row) * DM + 768 + 64 * h + ch * 8) = pack8(x); }
            if (prodA) { asm volatile("s_waitcnt vmcnt(0)" ::: "memory"); __syncthreads(); hand_post(F, HC + 32); }
        } else {
            const int qd = 2 * qb + (r < 16 ? 1 : 0); const size_t row0 = rb + 128 + 128 * qd; const bool prodB = b == 1 && qd >= 62;
            f32x16 o[2];
            att2::diff_unit(F.lds, WSP(bf16, WS_DQ) + (row0 + (wid & 3) * 32 + (lane & 31)) * 256 + 32 * (2 * h + (wid >> 2)), WSP(bf16, WS_DK) + rb * 256 + 64 * h, WSP(bf16, WS_DV) + rb * 256 + 64 * h,
                            2 * qd + 4, wid, lane, o);
            stage_o(F.lds + (wid < 4 ? att2::T_OA : att2::T_OB), wid & 3, lane, o);
            __syncthreads();
            const LAS bf16* sa = (const LAS bf16*)(F.lds + att2::T_OA); const LAS bf16* sb = (const LAS bf16*)(F.lds + att2::T_OB); const float* gn = F.in[7] + layer * 64 + ch * 8;
#pragma unroll
            for (int i = 0; i < 2; ++i) { const int row = wid * 16 + i * 8 + (lane >> 3); const u32x4 wa = *(const LAS u32x4*)(sa + row * 64 + ch * 8), wb = *(const LAS u32x4*)(sb + row * 64 + ch * 8);
                float x[8] = {bflo(wa.x) - lam * bflo(wb.x), bfhi(wa.x) - lam * bfhi(wb.x), bflo(wa.y) - lam * bflo(wb.y), bfhi(wa.y) - lam * bfhi(wb.y),
                              bflo(wa.z) - lam * bflo(wb.z), bfhi(wa.z) - lam * bfhi(wb.z), bflo(wa.w) - lam * bflo(wb.w), bfhi(wa.w) - lam * bfhi(wb.w)};
                float ss = 0.f;
#pragma unroll
                for (int e = 0; e < 8; ++e) ss += x[e] * x[e];
                ss += __shfl_xor(ss, 1); ss += __shfl_xor(ss, 2); ss += __shfl_xor(ss, 4);
                const float rn = rsqrtf(ss * (1.f / 64.f) + EPS) * (1.f - lam_init);
#pragma unroll
                for (int e = 0; e < 8; ++e) x[e] *= rn * gn[e];
                if (prodB) st_wt(MIX, MIX + (row0 + row) * DM + 512 + 64 * h + ch * 8, pack8(x)); else *(u32x4*)(MIX + (row0 + row) * DM + 512 + 64 * h + ch * 8) = pack8(x); }
            if (prodB) asm volatile("s_waitcnt vmcnt(0)" ::: "memory");
            __syncthreads();
            if (prodB) hand_post(F, HC + 32);
        }
#undef F
        QCLAIM(QC, qit);
    }
#undef QCLAIM
}

__global__ void __launch_bounds__(512, 2) mega(Args args) {
    extern __shared__ __attribute__((aligned(16))) unsigned char lds[];
    Frame F;
    F.lds = (LAS unsigned char*)lds; F.ws = args.ws; F.out = args.out; F.in = args.in;
    F.tid = threadIdx.x; F.lane = F.tid & 63; F.wave = __builtin_amdgcn_readfirstlane(F.tid >> 6); F.G = gridDim.x; F.blk = blockIdx.x;
    volatile LAS unsigned* MISC = (volatile LAS unsigned*)(F.lds + MISC_OFF);
    if (F.tid < 32) MISC[F.tid] = 0u;
    __syncthreads();
    unsigned* ctl = (unsigned*)(args.ws + WS_CTL);
    XcdBarrier bar; bar.bar = ctl + CW_BAR; bar.x = 0; bar.st = nullptr;
    if (MK_ONE_LAUNCH) bar = xcd_barrier_post(ctl + CW_BAR, MISC + 8);
    const int lo = args.ph_lo, hi = args.ph_hi;
#define IN(k) (lo <= (k) && (k) < hi)
#define SEAM(k) do { if (MK_ONE_LAUNCH && IN((k) + 1)) xcd_barrier(bar); } while (0)

    if (IN(0)) { prologue_tables(F); convert_static_weights(F); __syncthreads(); norm_phase<0>(F, 0); SEAM(0); }
#define LAYER_BODY(layer) do { \
        const int pb = 1 + 9 * (layer); \
        if (IN(pb + 0)) { if (F.blk == F.G - 1) fd_scan(F); GEMM1(F, layer); if ((layer) == 0) tail_convert(F, 0, 0, 0, 9500, 910, true); else tail_convert(F, 0, 1, 3000, 12000, 910, true); SEAM(pb + 0); } \
          \
        if (IN(pb + 3)) { attn_naive(F, layer, F.blk, F.G, 2); attn_queue(F, layer); SEAM(pb + 3); } \
        if (IN(pb + 4)) { GEMM2(F, layer); SEAM(pb + 4); }        \
        if (IN(pb + 5)) { norm2_route(F, layer); SEAM(pb + 5); } \
        if (IN(pb + 6)) { MOEUP(F, layer); tail_convert(F, 1, layer, (layer) == 0 ? 0 : 3000, NW2, ((const LAS int*)(F.lds + 131072))[NEXP] * 4); SEAM(pb + 6); } \
        if (IN(pb + 7)) { MOEDOWN(F, layer); if ((layer) == 0) tail_convert(F, 0, 1, 0, 3000, ((const LAS int*)(F.lds + 131072))[NEXP] * 4); SEAM(pb + 7); } \
        if (IN(pb + 8)) { if (layer == 0) norm_phase<1>(F, 1); else norm_phase<2>(F, 0); SEAM(pb + 8); } \
    } while (0)
    LAYER_BODY(0);
    LAYER_BODY(1);
#undef LAYER_BODY
#undef IN
#undef SEAM
}

extern "C" void kernel_launch(void* const* d_in, const int* in_sizes, int n_in, void* d_out, int out_size, void* d_ws, size_t ws_size, hipStream_t stream) {
    static int grid = 0;
    if (grid == 0) {
        if (n_in != 20 || out_size != BATCH * SEQ * DM || ws_size < WS_END) { fprintf(stderr, "kernel_launch: unexpected problem (n_in %d out %d ws %zu)\n", n_in, out_size, ws_size); grid = -1; return; }
        int dev = 0, cus = 0;
        if (hipGetDevice(&dev) != hipSuccess || hipDeviceGetAttribute(&cus, hipDeviceAttributeMultiprocessorCount, dev) != hipSuccess) { grid = -1; return; }
        if (hipFuncSetAttribute((const void*)mega, hipFuncAttributeMaxDynamicSharedMemorySize, LDS_BYTES) != hipSuccess) { fprintf(stderr, "kernel_launch: hipFuncSetAttribute failed\n"); grid = -1; return; }
        int per_cu = 0;
        if (hipOccupancyMaxActiveBlocksPerMultiprocessor(&per_cu, (const void*)mega, 512, LDS_BYTES) != hipSuccess || per_cu < 1) { fprintf(stderr, "kernel_launch: occupancy query says %d\n", per_cu); }
        (void)hipGetLastError();
        grid = cus;
    }
    if (grid < 0) return;
    (void)hipMemsetAsync((char*)d_ws + WS_CTL, 0, CTL_ZERO_BYTES, stream);
    Args a{};
    for (int i = 0; i < 20; ++i) a.in[i] = (const float*)d_in[i];
    a.out = (float*)d_out; a.ws = (unsigned char*)d_ws;
#if MK_ONE_LAUNCH
    a.ph_lo = 0; a.ph_hi = NPH;
    hipLaunchKernelGGL(mega, dim3(grid), dim3(512), LDS_BYTES, stream, a);
#else
    for (int p = 0; p < NPH; ++p) { a.ph_lo = p; a.ph_hi = p + 1; hipLaunchKernelGGL(mega, dim3(grid), dim3(512), LDS_BYTES, stream, a); }
#endif
}
```

```cpp
#include <hip/hip_runtime.h>
#include <cstdio>
#include <cstdint>

#define GAS __attribute__((address_space(1)))
#define LAS __attribute__((address_space(3)))
typedef unsigned short bf16;
typedef float f32x4 __attribute__((ext_vector_type(4)));
typedef float f32x2 __attribute__((ext_vector_type(2)));
typedef unsigned u32x4 __attribute__((ext_vector_type(4)));
typedef unsigned u32x2 __attribute__((ext_vector_type(2)));

__device__ __forceinline__ __amdgpu_buffer_rsrc_t wt_rsrc(const void* base) { return __builtin_amdgcn_make_buffer_rsrc((void*)base, (short)0, 0x7FFFFFFF, 0x00020000); }
__device__ __forceinline__ void st_wt(const void* base, const void* p, u32x4 v) { __builtin_amdgcn_raw_buffer_store_b128(v, wt_rsrc(base), (int)((const char*)p - (const char*)base), 0, 16); }
__device__ __forceinline__ void st_wt(const void* base, const void* p, float v) { __builtin_amdgcn_raw_buffer_store_b32(__builtin_bit_cast(unsigned, v), wt_rsrc(base), (int)((const char*)p - (const char*)base), 0, 16); }
__device__ __forceinline__ void st_wt(const void* base, const void* p, unsigned short v) { __builtin_amdgcn_raw_buffer_store_b16(v, wt_rsrc(base), (int)((const char*)p - (const char*)base), 0, 16); }

#ifndef MK_NAIVE_GEMM
#define MK_NAIVE_GEMM 0
#endif
#if MK_NAIVE_GEMM
#define GEMM1 gemm1_naive
#define GEMM2 gemm2_naive
#define MOEUP moe_up_naive
#define MOEDOWN moe_down_naive
#else
#define GEMM1 gemm1_mfma
#define GEMM2 gemm2_mfma
#define MOEUP moe_up_mfma
#define MOEDOWN moe_down_mfma
#endif
#ifndef MK_NAIVE_ATTN
#define MK_NAIVE_ATTN 0
#endif
#if MK_NAIVE_ATTN
#define ATTN(F, layer) attn_naive(F, layer, F.blk - 2, F.G - 2, LSEQ / 64)
#else
#define ATTN(F, layer) do { attn_naive(F, layer, F.blk - 2, F.G - 2, 2); attn_queue(F, layer); } while (0)
#endif
#ifndef MK_ONE_LAUNCH
#define MK_ONE_LAUNCH 1
#endif

constexpr int BATCH = 2, SEQ = 8192, DM = 1024, LSEQ = 8320, PADR = 112, M = BATCH * LSEQ;
constexpr int INW = 3588, NEXP = 32, DE = 512, MAXSLOT = 41472;
constexpr float EPS = 1e-6f, LOG2E = 1.4426950408889634f, TINYF = 1e-30f;
constexpr int NPH = 19;

constexpr size_t MiB = 1u << 20;
constexpr size_t WS_CTL = 0, CTL_ZERO_BYTES = 1 * MiB;
constexpr size_t WS_COS = 1 * MiB, WS_SIN = 2 * MiB, WS_LBV = 3 * MiB;
constexpr size_t WS_FLS = 4 * MiB, WS_FD2 = 4 * MiB + 512 * 1024;
constexpr size_t WS_TOKE = 5 * MiB, WS_TOKG = WS_TOKE + 160 * 1024, WS_TOKR = WS_TOKG + 160 * 1024, WS_TOKS = WS_TOKR + 160 * 1024, WS_SGATE = WS_TOKS + 160 * 1024;
constexpr size_t WS_H = 6 * MiB;
constexpr size_t WS_XN = 71 * MiB;
constexpr size_t WS_MIX = WS_XN;
constexpr size_t WS_R = 104 * MiB;
constexpr size_t SZ512 = (size_t)M * 512 * 2, SZ256 = (size_t)M * 256 * 2;
constexpr size_t WS_HQ = WS_R, WS_HLF = WS_HQ + SZ512, WS_HK = WS_HLF + 2 * SZ512, WS_HV = WS_HK + SZ512, WS_HG = WS_HV + SZ512;
constexpr size_t WS_DQ = WS_HG + SZ512, WS_DK = WS_DQ + SZ256, WS_DV = WS_DK + SZ256, WS_FQ = WS_DV + SZ256, WS_FK = WS_FQ + SZ256, WS_FV = WS_FK + SZ256;
constexpr size_t WS_PROJ_END = WS_FV + SZ256;
constexpr size_t WS_ORAW = 251 * MiB;
constexpr size_t WS_XG = WS_R, WS_HB = WS_XG + (size_t)MAXSLOT * 1024 * 2, WS_Y = WS_HB + (size_t)MAXSLOT * 512 * 2, WS_MOE_END = WS_Y + (size_t)MAXSLOT * 1024 * 2;
constexpr size_t WS_REND = 316 * MiB;
constexpr size_t WS_WIN = 316 * MiB;
constexpr size_t WS_WOUT = 330 * MiB;
constexpr size_t WS_W13 = 334 * MiB;
constexpr size_t WS_W2 = 398 * MiB;
constexpr size_t WS_KXF = 462 * MiB, WS_KXD = 463 * MiB + 512 * 1024;
constexpr size_t WS_DEC = 464 * MiB;
constexpr size_t WS_UT = WS_ORAW, WS_ST = WS_ORAW + (size_t)1040 * 16384 * 2;
constexpr size_t WS_WRT = 465 * MiB;
constexpr size_t WS_WF = 465 * MiB + 512 * 1024;
constexpr size_t WS_LIST = 466 * MiB, WS_GLIST = 469 * MiB;
constexpr size_t WS_END = 472 * MiB;
static_assert(WS_PROJ_END <= WS_ORAW && WS_ORAW + (size_t)M * 512 * 4 <= WS_REND && WS_MOE_END <= WS_REND, "ws map");
static_assert(WS_SGATE + MAXSLOT * 4 <= WS_H, "ws map small");

constexpr int CW_TMO = 0, CW_BAR = 4096, CW_CNT = 8192, CW_QATT = 8448, CW_HG = 8704;

constexpr int LDS_BYTES = 147456;
constexpr int MISC_OFF = 131072 + 320;

__device__ __forceinline__ unsigned f2bf(float f) { unsigned u = __builtin_bit_cast(unsigned, f); return (u + 0x7fffu + ((u >> 16) & 1u)) >> 16; }
__device__ __forceinline__ unsigned pk2(float lo, float hi) { return f2bf(lo) | (f2bf(hi) << 16); }
__device__ __forceinline__ float bf2f(unsigned h) { return __builtin_bit_cast(float, h << 16); }
__device__ __forceinline__ float bflo(unsigned w) { return __builtin_bit_cast(float, w << 16); }
__device__ __forceinline__ float bfhi(unsigned w) { return __builtin_bit_cast(float, w & 0xffff0000u); }
__device__ __forceinline__ float wave_sum(float v) {
#pragma unroll
    for (int o = 1; o < 64; o <<= 1) v += __shfl_xor(v, o);
    return v;
}
__device__ __forceinline__ float sigmoidf_(float x) { return 1.f / (1.f + __expf(-x)); }
__device__ __forceinline__ float siluf_(float x) { return x / (1.f + __expf(-x)); }

#define XB_TMO      128
#define XB_XCNT(j)  (256  + 64 * (j))
#define XB_XSUB(j)  (1280 + 64 * (j))
#define XB_XGEN(j)  (2304 + 64 * (j))
#define XB_TOP      3328
#define XB_TOPGEN   3392
#define XCD_BAR_WORDS 3456
#define XB_SPIN_CAP (1u << 20)

__device__ __forceinline__ unsigned xb_ld(unsigned* p)              { return __hip_atomic_load(p, __ATOMIC_RELAXED, __HIP_MEMORY_SCOPE_AGENT); }
__device__ __forceinline__ unsigned xb_add(unsigned* p, unsigned v) { return __hip_atomic_fetch_add(p, v, __ATOMIC_RELAXED, __HIP_MEMORY_SCOPE_AGENT); }
__device__ __forceinline__ unsigned xb_xcc_id() { return (unsigned)__builtin_amdgcn_s_getreg((3 << 11) | 20) & 0xFu; }
#define XB_SPIN(cond, bar) do { unsigned _sp = 0; while (cond) { __builtin_amdgcn_s_sleep(1); \
    if ((++_sp & 255u) == 0u) { if (xb_ld(&(bar)[XB_TMO])) break; if (_sp > XB_SPIN_CAP) { atomicAdd(&(bar)[XB_TMO], 1u); break; } } } } while (0)

struct XcdBarrier {
    unsigned* bar; unsigned x;
    volatile LAS unsigned* st;
};
__device__ __forceinline__ XcdBarrier xcd_barrier_post(unsigned* bar, volatile LAS unsigned* st) {
    XcdBarrier b; b.bar = bar; b.x = xb_xcc_id(); b.st = st;
    if (threadIdx.x == 0) (void)xb_add(&bar[XB_XCNT(b.x)], 1u);
    return b;
}
__device__ __forceinline__ void xcd_barrier_complete(unsigned* bar, unsigned x, unsigned& nloc, unsigned& nx) {
    const unsigned G = gridDim.x * gridDim.y * gridDim.z;
    unsigned sum, cnt, mine, sp = 0u;
    for (;;) {
        sum = 0u; cnt = 0u; mine = 0u;
#pragma unroll
        for (unsigned j = 0; j < 16; ++j) { const unsigned c = xb_ld(&bar[XB_XCNT(j)]); sum += c; cnt += (c > 0u) ? 1u : 0u; mine = (j == x) ? c : mine; }
        if (sum == G) break;
        __builtin_amdgcn_s_sleep(1);
        if ((++sp & 255u) == 0u) { if (xb_ld(&bar[XB_TMO])) break; if (sp > XB_SPIN_CAP) { atomicAdd(&bar[XB_TMO], 1u); break; } }
    }
    nloc = mine > 0u ? mine : 1u; nx = cnt > 0u ? cnt : 1u;
}
__device__ __forceinline__ void xcd_barrier(const XcdBarrier& b) {
    asm volatile("s_waitcnt vmcnt(0)" ::: "memory");
    __syncthreads();
    if (threadIdx.x == 0) {
        unsigned* bar = b.bar;
        __builtin_amdgcn_s_waitcnt(0);
        unsigned nloc = b.st[0], nx = b.st[1];
        if (nloc == 0u) { xcd_barrier_complete(bar, b.x, nloc, nx); b.st[0] = nloc; b.st[1] = nx; }
        const unsigned old = xb_add(&bar[XB_XSUB(b.x)], 1u);
        const unsigned gen = old / nloc;
        if (old + 1u == (gen + 1u) * nloc) {
            __builtin_amdgcn_fence(__ATOMIC_RELEASE, "agent");
            asm volatile("s_waitcnt vmcnt(0)" ::: "memory");
            const unsigned og = xb_add(&bar[XB_TOP], 1u);
            const unsigned tg = og / nx;
            if (og + 1u == (tg + 1u) * nx) xb_add(&bar[XB_TOPGEN], 1u);
            else XB_SPIN(xb_ld(&bar[XB_TOPGEN]) == tg, bar);
            __builtin_amdgcn_fence(__ATOMIC_ACQUIRE, "agent");
            xb_add(&bar[XB_XGEN(b.x)], 1u);
            asm volatile("s_waitcnt vmcnt(0)" ::: "memory");
        } else {
            XB_SPIN(xb_ld(&bar[XB_XGEN(b.x)]) == gen, bar);
            __builtin_amdgcn_fence(__ATOMIC_ACQUIRE, "agent");
            asm volatile("s_waitcnt vmcnt(0)" ::: "memory");
        }
    }
    __syncthreads();
}

struct Args { const float* in[20]; float* out; unsigned char* ws; int ph_lo, ph_hi; };
struct Frame {
    LAS unsigned char* lds;
    unsigned char* ws;
    float* out;
    int tid, lane, wave, G, blk;
    const float* const* in;
};
#define WSP(T, off) ((T*)(F.ws + (off)))
#define WSG(T, off) ((const GAS T*)(F.ws + (off)))

namespace pg8 {
#define PG8_LAS __attribute__((address_space(3)))
typedef unsigned short bf16_t;
typedef short bf16x8 __attribute__((ext_vector_type(8)));
typedef float f32x4 __attribute__((ext_vector_type(4)));
typedef unsigned u32x4 __attribute__((ext_vector_type(4)));
constexpr int BM = 256, BK = 64, HALF = 128, HTB = HALF * BK * 2  , STAGE_BYTES = 8 * HTB, NXCD = 8, WGM = 8;

__host__ __device__ __forceinline__ int lds_byte(int r, int c) { const int st = (r >> 4) * 2 + (c >> 5), rr = r & 15, cc = c & 31, ob = rr * 64 + cc * 2; return st * 1024 + (ob ^ (((ob >> 9) & 1) << 5)); }
__host__ __device__ __forceinline__ void stage_rc(int b, int& R, int& C) { const int st = b / 1024, sb = b % 1024, swz = sb ^ (((sb >> 9) & 1) << 5); R = (st >> 1) * 16 + swz / 64; C = (st & 1) * 32 + (swz % 64) / 2; }
__host__ __device__ __forceinline__ int perm32(int rho) { const int n = rho >> 4, i = rho & 15; return 8 * (i >> 2) + 4 * n + (i & 3); }

struct Unit { int pm, pn; };
struct Gemm { const bf16_t* A; const bf16_t* Bt; int M, N, K; };

struct StaticOrder {
    static constexpr bool GATHER = false;
    __device__ __forceinline__ unsigned goff(const Unit&, int, int) const { return 0u; }
    int nM, nN, nwg, G, c;
    __host__ __device__ void init(int M, int N, int G_, int c_) { nM = M / BM; nN = N / BM; nwg = nM * nN; G = G_; c = c_; }
    __host__ __device__ bool next(int i, Unit& u) const {
        const long L = (long)i * G + c; if (L >= nwg) return false;
        int wgid = (int)L; { const int q = nwg / NXCD, r = nwg % NXCD, xcd = wgid % NXCD, off = wgid / NXCD; wgid = (xcd < r ? xcd * (q + 1) : r * (q + 1) + (xcd - r) * q) + off; }
        const int nig = WGM * nN, gid = wgid / nig, fm = gid * WGM, gsz = (nM - fm) < WGM ? (nM - fm) : WGM;
        u.pm = fm + ((wgid % nig) % gsz); u.pn = (wgid % nig) / gsz; return true;
    }
    __device__ __forceinline__ void a_ready(const Unit&) const {}
    __device__ __forceinline__ void done(const Unit&) const {}
};
__device__ __forceinline__ unsigned cvt_pk_bf16(float lo, float hi) { unsigned r; asm volatile("v_cvt_pk_bf16_f32 %0, %1, %2" : "=v"(r) : "v"(lo), "v"(hi)); return r; }
template <class Epi, class Sched, bool ALIGN_EPI = false, bool SP2 = false>
__device__ __forceinline__ void gemm_phase(PG8_LAS unsigned char* lds, const Gemm g, const Sched& S, const Epi& E) {
    const int tid = threadIdx.x, wid = __builtin_amdgcn_readfirstlane(tid >> 6), lane = tid & 63, wr = wid >> 2, wc = wid & 3, fr = lane & 15, fq = lane >> 4;
    const int K = g.K, nt = K / BK;
    constexpr bool GATHER = Sched::GATHER;
    static_assert(!GATHER || SP2, "the gathered A operand is wired into the SP2 loop only");
    unsigned voffA[2], voffB[2]; int gR[2]; unsigned gC2[2];
#pragma unroll
    for (int i = 0; i < 2; ++i) { int R, C; stage_rc(tid * 16 + i * 8192, R, C); const int Rb = Epi::PERM ? ((R & ~31) + perm32(R & 31)) : R;
        voffA[i] = (unsigned)(R * K + C) * 2u; voffB[i] = (unsigned)(Rb * K + C) * 2u; gR[i] = R; gC2[i] = (unsigned)C * 2u; }
    unsigned gCur0[2] = {0u, 0u}, gCur1[2] = {0u, 0u}, gNxt0[2] = {0u, 0u}, gNxt1[2] = {0u, 0u};
#define PG8_GOFF(u, g0, g1) do { _Pragma("unroll") for (int _i = 0; _i < 2; ++_i) { g0[_i] = S.goff(u, gR[_i], K) + gC2[_i]; g1[_i] = S.goff(u, HALF + gR[_i], K) + gC2[_i]; } } while (0)
    const size_t kstep = (size_t)(BK * 2);
    const size_t hstep = (size_t)HALF * K * 2;
    const size_t tstep = 2 * hstep;
    const unsigned ldsw = (unsigned)wid * 1024u;
    const int aoff = lds_byte(wr * 64 + fr, fq * 8), boff = lds_byte(wc * 32 + fr, fq * 8);
#define PG8_SA(b, h) (((b) * 2 + (h)) * HTB)
#define PG8_SB(b, h) ((4 + (b) * 2 + (h)) * HTB)
#define PG8_STAGE(bufoff, gbase, voff) do { _Pragma("unroll") for (int _i = 0; _i < 2; ++_i) \
        __builtin_amdgcn_global_load_lds((const unsigned*)((const char*)(gbase) + (voff)[_i]), (PG8_LAS unsigned*)(lds + (bufoff) + ldsw + _i * 8192), 16, 0, 0); } while (0)
#define PG8_LDA(dst, b, h) do { _Pragma("unroll") for (int m = 0; m < 4; ++m) _Pragma("unroll") for (int k = 0; k < 2; ++k) dst[m][k] = *(const PG8_LAS bf16x8*)(lds + PG8_SA(b, h) + aoff + m * 2048 + k * 1024); } while (0)
#define PG8_LDB(dst, b, h) do { _Pragma("unroll") for (int n = 0; n < 2; ++n) _Pragma("unroll") for (int k = 0; k < 2; ++k) dst[n][k] = *(const PG8_LAS bf16x8*)(lds + PG8_SB(b, h) + boff + n * 2048 + k * 1024); } while (0)
#define PG8_MMA(ai, bj, At, Bt) do { __builtin_amdgcn_s_setprio(1); _Pragma("unroll") for (int m = 0; m < 4; ++m) _Pragma("unroll") for (int n = 0; n < 2; ++n) _Pragma("unroll") for (int k = 0; k < 2; ++k) \
        acc[ai][bj][m][n] = __builtin_amdgcn_mfma_f32_16x16x32_bf16(Bt[n][k], At[m][k], acc[ai][bj][m][n], 0, 0, 0); __builtin_amdgcn_s_setprio(0); } while (0)
#define PG8_WAIT_V(n) asm volatile("s_waitcnt vmcnt(" #n ")" ::: "memory")
#define PG8_WAIT_L(n) asm volatile("s_waitcnt lgkmcnt(" #n ")" ::: "memory")
#define PG8_BAR __builtin_amdgcn_s_barrier()
#define PG8_SCHED __builtin_amdgcn_sched_barrier(0)
    Unit cur, nxt; int ui = 0;
    if (!S.next(0, cur)) return;
    f32x4 acc[2][2][4][2];
#pragma unroll
    for (int a = 0; a < 2; ++a)
#pragma unroll
        for (int b = 0; b < 2; ++b)
#pragma unroll
            for (int m = 0; m < 4; ++m)
#pragma unroll
                for (int n = 0; n < 2; ++n) acc[a][b][m][n] = (f32x4){0.f, 0.f, 0.f, 0.f};
    bf16x8 At[4][2], B0[2][2], B1[2][2];
    const char* cA = (const char*)g.A + (GATHER ? (size_t)0 : (size_t)cur.pm * tstep); const char* cB = (const char*)g.Bt + (size_t)cur.pn * tstep;
    const size_t hsA = GATHER ? (size_t)0 : hstep;
    if constexpr (GATHER) PG8_GOFF(cur, gCur0, gCur1);
    S.a_ready(cur);
    if constexpr (SP2) {
        PG8_STAGE(PG8_SB(0, 0), cB, voffB); PG8_STAGE(PG8_SB(0, 1), cB + hstep, voffB); PG8_STAGE(PG8_SA(0, 0), cA, (GATHER ? gCur0 : voffA)); PG8_STAGE(PG8_SA(0, 1), cA + hsA, (GATHER ? gCur1 : voffA));
        if (wr == 1) PG8_BAR;
        PG8_WAIT_V(2); PG8_BAR;
        PG8_STAGE(PG8_SB(1, 0), cB + kstep, voffB); PG8_STAGE(PG8_SA(1, 0), cA + kstep, (GATHER ? gCur0 : voffA)); PG8_STAGE(PG8_SB(1, 1), cB + hstep + kstep, voffB);
        PG8_WAIT_V(6); PG8_BAR;
    } else {
        PG8_STAGE(PG8_SB(0, 0), cB, voffB); PG8_STAGE(PG8_SA(0, 0), cA, voffA); PG8_STAGE(PG8_SB(0, 1), cB + hstep, voffB); PG8_STAGE(PG8_SA(0, 1), cA + hstep, voffA);
        if (wr == 1) PG8_BAR;
        PG8_WAIT_V(4); PG8_BAR;
        PG8_STAGE(PG8_SB(1, 0), cB + kstep, voffB); PG8_STAGE(PG8_SA(1, 0), cA + kstep, voffA); PG8_STAGE(PG8_SB(1, 1), cB + hstep + kstep, voffB);
        PG8_WAIT_V(6); PG8_BAR;
    }
    for (;;) {
        const bool has_next = S.next(ui + 1, nxt);
        const char* nA = (has_next && !GATHER) ? (const char*)g.A + (size_t)nxt.pm * tstep : cA; const char* nB = has_next ? (const char*)g.Bt + (size_t)nxt.pn * tstep : cB;
        if constexpr (GATHER) { if (has_next) PG8_GOFF(nxt, gNxt0, gNxt1); else { gNxt0[0] = gCur0[0]; gNxt0[1] = gCur0[1]; gNxt1[0] = gCur1[0]; gNxt1[1] = gCur1[1]; } }
        for (int t = 0; t < nt; t += 2) {
            const bool last = (t == nt - 2);
            unsigned gS0[2], gS1[2];
            gS0[0] = last ? gNxt0[0] : gCur0[0]; gS0[1] = last ? gNxt0[1] : gCur0[1]; gS1[0] = last ? gNxt1[0] : gCur1[0]; gS1[1] = last ? gNxt1[1] : gCur1[1];
            const char* a1 = cA + (size_t)(t + 1) * kstep;
            const char* a2 = last ? nA : cA + (size_t)(t + 2) * kstep; const char* b2 = last ? nB : cB + (size_t)(t + 2) * kstep;
            const char* a3 = a2 + kstep; const char* b3 = b2 + kstep;
            if (last && has_next) S.a_ready(nxt);
            if constexpr (SP2) {
            PG8_LDB(B0, 0, 0); PG8_LDB(B1, 0, 1); PG8_SCHED; PG8_LDA(At, 0, 0); PG8_STAGE(PG8_SA(1, 1), a1 + hsA, (GATHER ? gCur1 : voffA));
            PG8_WAIT_V(8); PG8_WAIT_L(0); PG8_BAR; PG8_MMA(0, 0, At, B0); PG8_MMA(0, 1, At, B1); PG8_BAR; PG8_SCHED;
            PG8_LDA(At, 0, 1); PG8_STAGE(PG8_SB(0, 0), b2, voffB); PG8_STAGE(PG8_SB(0, 1), b2 + hstep, voffB); PG8_STAGE(PG8_SA(0, 0), a2, (GATHER ? gS0 : voffA));
            PG8_WAIT_V(8); PG8_WAIT_L(0); PG8_BAR; PG8_MMA(1, 0, At, B0); PG8_MMA(1, 1, At, B1); PG8_BAR; PG8_SCHED;
            PG8_LDB(B0, 1, 0); PG8_LDB(B1, 1, 1); PG8_SCHED; PG8_LDA(At, 1, 0); PG8_STAGE(PG8_SA(0, 1), a2 + hsA, (GATHER ? gS1 : voffA));
            PG8_WAIT_V(8); PG8_WAIT_L(0); PG8_BAR; PG8_MMA(0, 0, At, B0); PG8_MMA(0, 1, At, B1); PG8_BAR; PG8_SCHED;
            PG8_LDA(At, 1, 1); PG8_STAGE(PG8_SB(1, 0), b3, voffB); PG8_STAGE(PG8_SB(1, 1), b3 + hstep, voffB); PG8_STAGE(PG8_SA(1, 0), a3, (GATHER ? gS0 : voffA));
            PG8_WAIT_V(8); PG8_WAIT_L(0); PG8_BAR; PG8_MMA(1, 0, At, B0); PG8_MMA(1, 1, At, B1); PG8_BAR; PG8_SCHED;
            } else {
            PG8_LDB(B0, 0, 0); PG8_SCHED; PG8_LDA(At, 0, 0); PG8_STAGE(PG8_SA(1, 1), a1 + hstep, voffA);
            PG8_WAIT_L(8); PG8_BAR; PG8_WAIT_L(0); PG8_MMA(0, 0, At, B0); PG8_BAR; PG8_SCHED;
            PG8_LDB(B1, 0, 1); PG8_STAGE(PG8_SB(0, 0), b2, voffB);
            PG8_BAR; PG8_WAIT_L(0); PG8_MMA(0, 1, At, B1); PG8_BAR;
            PG8_LDA(At, 0, 1); PG8_STAGE(PG8_SA(0, 0), a2, voffA);
            PG8_BAR; PG8_WAIT_L(0); PG8_MMA(1, 0, At, B0); PG8_BAR; PG8_SCHED;
            PG8_STAGE(PG8_SB(0, 1), b2 + hstep, voffB);
            PG8_WAIT_V(6); PG8_BAR; PG8_MMA(1, 1, At, B1); PG8_BAR;
            PG8_LDB(B0, 1, 0); PG8_SCHED; PG8_LDA(At, 1, 0); PG8_STAGE(PG8_SA(0, 1), a2 + hstep, voffA);
            PG8_WAIT_L(8); PG8_BAR; PG8_WAIT_L(0); PG8_MMA(0, 0, At, B0); PG8_BAR; PG8_SCHED;
            PG8_LDB(B1, 1, 1); PG8_STAGE(PG8_SB(1, 0), b3, voffB);
            PG8_BAR; PG8_WAIT_L(0); PG8_MMA(0, 1, At, B1); PG8_BAR;
            PG8_LDA(At, 1, 1); PG8_STAGE(PG8_SA(1, 0), a3, voffA);
            PG8_BAR; PG8_WAIT_L(0); PG8_MMA(1, 0, At, B0); PG8_BAR; PG8_SCHED;
            PG8_STAGE(PG8_SB(1, 1), b3 + hstep, voffB);
            PG8_WAIT_V(6); PG8_BAR; PG8_MMA(1, 1, At, B1); PG8_BAR;
            }
        }
        if constexpr (ALIGN_EPI) { if (wr == 0) PG8_BAR; }
        if constexpr (!Epi::AFTER_DRAIN) { E(acc, cur, wr, wc, fr, fq); S.done(cur); }
        if (!has_next) break;
#pragma unroll
        for (int a = 0; a < 2; ++a)
#pragma unroll
            for (int b = 0; b < 2; ++b)
#pragma unroll
                for (int m = 0; m < 4; ++m)
#pragma unroll
                    for (int n = 0; n < 2; ++n) acc[a][b][m][n] = (f32x4){0.f, 0.f, 0.f, 0.f};
        cur = nxt; cA = nA; cB = nB; ++ui;
        if constexpr (GATHER) { gCur0[0] = gNxt0[0]; gCur0[1] = gNxt0[1]; gCur1[0] = gNxt1[0]; gCur1[1] = gNxt1[1]; }
        if constexpr (ALIGN_EPI) { if (wr == 1) PG8_BAR; }
    }
    PG8_WAIT_V(0);
    if constexpr (!ALIGN_EPI) { if (wr == 0) PG8_BAR; }
    PG8_BAR;
    if constexpr (Epi::AFTER_DRAIN) { E.fused(acc, cur, wr, wc, fr, fq, lds, wid, lane); S.done(cur); }
#undef PG8_GOFF
#undef PG8_SA
#undef PG8_SB
#undef PG8_STAGE
#undef PG8_LDA
#undef PG8_LDB
#undef PG8_MMA
#undef PG8_WAIT_V
#undef PG8_WAIT_L
#undef PG8_BAR
#undef PG8_SCHED
}
}

__device__ __forceinline__ void prologue_tables(const Frame& F) {
    const int gt = F.blk * 512 + F.tid, NT = F.G * 512;
    float* COS = WSP(float, WS_COS); float* SIN = WSP(float, WS_SIN); float* LBV = WSP(float, WS_LBV);
    for (int i = gt; i < LSEQ * 16; i += NT) {
        const int t = i >> 4, j = i & 15;
        const float inv = powf(10000.f, -(float)(2 * j) / 32.f);
        const float ang = (float)(t - PADR) * inv;
        const double a = (double)ang; const double n = rint(a * 0.15915494309189535); const float r = (float)(a - n * 6.283185307179586);
        COS[i] = cosf(r); SIN[i] = sinf(r);
    }
    { u32x4* KXD = WSP(u32x4, WS_KXD); for (int i = gt; i < LSEQ; i += NT) KXD[i] = (u32x4){i < PADR ? 0x7F00u : 0u, 0u, 0u, 0u}; }
    { bf16* WRT = WSP(bf16, WS_WRT); float* WF = WSP(float, WS_WF);
      for (int i = gt; i < 2 * 48 * 1024; i += NT) { const int l = i / (48 * 1024), r = i % (48 * 1024), col = r >> 10, k = r & 1023;
          float w = 0.f; if (col < 4) w = F.in[12][((size_t)l * DM + k) * 4 + col]; else if (col < 36) w = F.in[14][((size_t)l * DM + k) * 32 + (col - 4)];
          const unsigned hb = f2bf(w), lb2 = f2bf(w - bf2f(hb));
          WRT[(size_t)(l * 2 + 0) * 48 * 1024 + r] = (bf16)hb; WRT[(size_t)(l * 2 + 1) * 48 * 1024 + r] = (bf16)lb2; }
      for (int i = gt; i < 2 * 1024 * 4; i += NT) { const int l = i >> 12, r = i & 4095, k = r >> 2, q = r & 3; WF[i] = F.in[3][((size_t)l * DM + k) * INW + 3584 + q]; } }
    const float* lbp = F.in[4];
    for (int i = gt; i < 1024; i += NT) { const int l = i >> 9, c = i & 511; LBV[i] = l == 0 ? 0.f : sigmoidf_(lbp[512 + c] - lbp[c]); }
}

__device__ __forceinline__ void moe_tile_bases(const Frame& F, int layer, LAS int* tb);
template <int MODE> __device__ __forceinline__ void norm_phase(const Frame& F, int layer) {
    const int gw = F.blk * 8 + F.wave, NGW = F.G * 8, lane = F.lane;
    float* H = WSP(float, WS_H); bf16* XN = WSP(bf16, WS_XN); const bf16* Y = WSP(bf16, WS_Y); const int* TOKE = WSP(int, WS_TOKE); const int* TOKR = WSP(int, WS_TOKR); float* FLS = WSP(float, WS_FLS);
    LAS int* tbs = (LAS int*)(F.lds + 131072);
    const float* gain = (MODE == 2) ? F.in[19] : F.in[2] + layer * DM;
    const float* fb = F.in[8] + layer * 4;
    LAS f32x4* sWF = (LAS f32x4*)F.lds;
    if (MODE != 2) { const float* win = F.in[3] + (size_t)layer * DM * INW + 3584;
        for (int i = F.tid; i < 1024; i += 512) sWF[i] = *(const f32x4*)(win + (size_t)i * INW); __syncthreads(); }
#define NP_LOAD(mm, vv) do { const int b_ = (mm) / LSEQ, t_ = (mm) % LSEQ; \
        if (MODE == 0) { _Pragma("unroll") for (int j = 0; j < 4; ++j) { const int col = 4 * lane + 256 * j; \
                if (t_ < PADR) vv[j] = (f32x4){0.f, 0.f, 0.f, 0.f}; \
                else if (t_ < 128) vv[j] = *(const f32x4*)(F.in[1] + (size_t)(t_ - PADR) * DM + col); \
                else vv[j] = *(const f32x4*)(F.in[0] + ((size_t)b_ * SEQ + (t_ - 128)) * DM + col); } } \
        else { const int s0 = 256 * tbs[TOKE[2 * (mm)]] + TOKR[2 * (mm)], s1 = 256 * tbs[TOKE[2 * (mm) + 1]] + TOKR[2 * (mm) + 1]; \
            _Pragma("unroll") for (int j = 0; j < 4; ++j) { const int col = 4 * lane + 256 * j; \
                const f32x4 hv = *(const f32x4*)(H + (size_t)(mm) * DM + col); \
                const u32x2 y0 = *(const u32x2*)(Y + (size_t)s0 * DM + col), y1 = *(const u32x2*)(Y + (size_t)s1 * DM + col); \
                vv[j].x = hv.x + bflo(y0.x) + bflo(y1.x); vv[j].y = hv.y + bfhi(y0.x) + bfhi(y1.x); \
                vv[j].z = hv.z + bflo(y0.y) + bflo(y1.y); vv[j].w = hv.w + bfhi(y0.y) + bfhi(y1.y); } } } while (0)
    f32x4 v[4], vn[4];
#pragma unroll
    for (int j = 0; j < 4; ++j) { v[j] = (f32x4){0.f, 0.f, 0.f, 0.f}; vn[j] = v[j]; }
    if (gw < M) NP_LOAD(gw, v);
#pragma unroll 1
    for (int m = gw; m < M; m += NGW) {
        const int b = m / LSEQ, t = m % LSEQ;
        if (m + NGW < M) NP_LOAD(m + NGW, vn);
        float ss = 0.f;
#pragma unroll
        for (int j = 0; j < 4; ++j) ss += (v[j].x * v[j].x + v[j].y * v[j].y) + (v[j].z * v[j].z + v[j].w * v[j].w);
        ss = wave_sum(ss);
        const float r = rsqrtf(ss * (1.f / DM) + EPS);
        if (MODE != 2) {
            float fa[4] = {0.f, 0.f, 0.f, 0.f};
#pragma unroll
            for (int j = 0; j < 4; ++j) {
                const int col = 4 * lane + 256 * j;
                if (MODE != 0) *(f32x4*)(H + (size_t)m * DM + col) = v[j];
                const f32x4 g = *(const f32x4*)(gain + col);
                const f32x4 u = v[j] * r * g;
                u32x2 o; o.x = pk2(u.x, u.y); o.y = pk2(u.z, u.w);
                *(u32x2*)(XN + (size_t)m * DM + col) = o;
#pragma unroll
                for (int q = 0; q < 4; ++q) {
                    const f32x4 w = sWF[col + q];
                    const float uq = u[q];
                    fa[0] += uq * w.x; fa[1] += uq * w.y; fa[2] += uq * w.z; fa[3] += uq * w.w;
                }
            }
#pragma unroll
            for (int q = 0; q < 4; ++q) fa[q] = wave_sum(fa[q]);
            if (lane < 4) {
                const float z = (lane == 0 ? fa[0] : lane == 1 ? fa[1] : lane == 2 ? fa[2] : fa[3]) + fb[lane];
                FLS[(size_t)m * 4 + lane] = fminf(z, 0.f) - log1pf(__expf(-fabsf(z)));
            }
        } else {
            if (t >= 128) {
                float* orow = F.out + ((size_t)b * SEQ + (t - 128)) * DM;
#pragma unroll
                for (int j = 0; j < 4; ++j) {
                    const int col = 4 * lane + 256 * j;
                    const f32x4 g = *(const f32x4*)(gain + col);
                    __builtin_nontemporal_store(v[j] * r * g, (f32x4*)(orow + col));
                }
            }
        }
#pragma unroll
        for (int j = 0; j < 4; ++j) v[j] = vn[j];
    }
#undef NP_LOAD
    if (MODE != 2) __syncthreads();
}

__device__ __forceinline__ void fd_scan(const Frame& F) {
    const float* FLS = WSP(float, WS_FLS); float* FD2 = WSP(float, WS_FD2); u32x4* KXF = WSP(u32x4, WS_KXF);
    const int bh = F.wave, b = bh >> 2, h = bh & 3, lane = F.lane;
    float carry = 0.f;
#pragma unroll 1
    for (int t0 = 0; t0 < LSEQ; t0 += 512) {
        const int tb = t0 + lane * 8;
        float v[8];
#pragma unroll
        for (int j = 0; j < 8; ++j) v[j] = (tb + j < LSEQ) ? FLS[((size_t)b * LSEQ + tb + j) * 4 + h] : 0.f;
#pragma unroll
        for (int j = 1; j < 8; ++j) v[j] += v[j - 1];
        float tot = v[7], inc = tot;
#pragma unroll
        for (int o = 1; o < 64; o <<= 1) { const float u = __shfl_up(inc, o); if (lane >= o) inc += u; }
        const float base = carry + inc - tot;
#pragma unroll
        for (int j = 0; j < 8; ++j) if (tb + j < LSEQ) { const float d2 = (base + v[j]) * LOG2E; FD2[(size_t)bh * LSEQ + tb + j] = d2;
            const unsigned hb = f2bf(d2), lb = f2bf(d2 - bf2f(hb)); KXF[(size_t)bh * LSEQ + tb + j] = (u32x4){(tb + j) < PADR ? 0x7F00u : (hb | (lb << 16)), 0u, 0u, 0u}; }
        carry += __shfl(inc, 63);
    }
}

template <bool DUAL, class Epi>
__device__ __forceinline__ void ngemm_tile(const Frame& F, const bf16* A, int lda, const float* B, const float* B2, int ldb, int K, int n0, const Epi& epi) {
    LAS float* As = (LAS float*)F.lds;
    LAS float* Bs = As + 16 * 132;
    LAS float* Bs2 = Bs + 16 * 64;
    const int tid = F.tid, tx = tid & 15, ty = tid >> 4;
    float acc[4][4], acc2[4][4];
#pragma unroll
    for (int i = 0; i < 4; ++i)
#pragma unroll
        for (int j = 0; j < 4; ++j) { acc[i][j] = 0.f; acc2[i][j] = 0.f; }
    const int ar = tid >> 2, akq = (tid & 3) * 4, bkr = tid >> 5, bcc = (tid & 31) * 2;
    for (int k0 = 0; k0 < K; k0 += 16) {
        const u32x2 raw = *(const u32x2*)(A + (size_t)ar * lda + k0 + akq);
        const f32x2 bv = *(const f32x2*)(B + (size_t)(k0 + bkr) * ldb + n0 + bcc);
        f32x2 bv2 = (f32x2){0.f, 0.f};
        if (DUAL) bv2 = *(const f32x2*)(B2 + (size_t)(k0 + bkr) * ldb + n0 + bcc);
        As[(akq + 0) * 132 + ar] = bflo(raw.x); As[(akq + 1) * 132 + ar] = bfhi(raw.x); As[(akq + 2) * 132 + ar] = bflo(raw.y); As[(akq + 3) * 132 + ar] = bfhi(raw.y);
        Bs[bkr * 64 + bcc] = bv.x; Bs[bkr * 64 + bcc + 1] = bv.y;
        if (DUAL) { Bs2[bkr * 64 + bcc] = bv2.x; Bs2[bkr * 64 + bcc + 1] = bv2.y; }
        __syncthreads();
#pragma unroll
        for (int k = 0; k < 16; ++k) {
            const f32x4 a = *(const LAS f32x4*)(As + k * 132 + ty * 4);
            float bb[4], bb2[4];
#pragma unroll
            for (int j = 0; j < 4; ++j) { bb[j] = Bs[k * 64 + tx + 16 * j]; if (DUAL) bb2[j] = Bs2[k * 64 + tx + 16 * j]; }
#pragma unroll
            for (int i = 0; i < 4; ++i)
#pragma unroll
                for (int j = 0; j < 4; ++j) { acc[i][j] += a[i] * bb[j]; if (DUAL) acc2[i][j] += a[i] * bb2[j]; }
        }
        __syncthreads();
    }
#pragma unroll
    for (int i = 0; i < 4; ++i) epi(ty * 4 + i, n0 + tx, acc[i], acc2[i]);
}

struct EpiInproj {
    unsigned char* ws; int layer; int m0;
    __device__ __forceinline__ void operator()(int r, int c0, const float (&v)[4], const float (&)[4]) const {
        const int m = m0 + r, t = m % LSEQ; const bool valid = t >= PADR;
        const int reg = c0 >> 8;
        if (reg < 2) { bf16* O = (bf16*)(ws + WS_HQ);
#pragma unroll
            for (int j = 0; j < 4; ++j) O[(size_t)m * 512 + c0 + 16 * j] = (bf16)f2bf(siluf_(v[j]) * 0.08838834764831845f);
        } else if (reg < 4) { float* LF = (float*)(ws + WS_HLF); bf16* KK = (bf16*)(ws + WS_HK); const float* LBV = (const float*)(ws + WS_LBV) + layer * 512;
#pragma unroll
            for (int j = 0; j < 4; ++j) { const int cc = c0 - 512 + 16 * j; const float lb = LBV[cc], sg = sigmoidf_(v[j]);
                const float f = lb + (1.f - lb) * sg; float lf = __logf(fmaxf(f, TINYF)), kk = (1.f - lb) * (1.f - sg);
                if (!valid) { lf = 0.f; kk = 0.f; }
                LF[(size_t)m * 512 + cc] = lf; KK[(size_t)m * 512 + cc] = (bf16)f2bf(kk); }
        } else if (reg < 6) { bf16* O = (bf16*)(ws + WS_HV);
#pragma unroll
            for (int j = 0; j < 4; ++j) O[(size_t)m * 512 + c0 - 1024 + 16 * j] = (bf16)f2bf(v[j]);
        } else if (reg < 8) { bf16* O = (bf16*)(ws + WS_HG);
#pragma unroll
            for (int j = 0; j < 4; ++j) O[(size_t)m * 512 + c0 - 1536 + 16 * j] = (bf16)f2bf(siluf_(v[j]));
        } else if (reg < 10) {
            bf16* O = (bf16*)(ws + (reg == 8 ? WS_DQ : WS_DK)); const int cc = c0 - reg * 256;
            const float sc = reg == 8 ? 0.17677669529663687f * LOG2E : 1.f;
            const int i = cc & 15;
            const float cs = ((const float*)(ws + WS_COS))[t * 16 + i], sn = ((const float*)(ws + WS_SIN))[t * 16 + i];
#pragma unroll
            for (int p = 0; p < 2; ++p) { const float x1 = v[2 * p], x2 = v[2 * p + 1];
                O[(size_t)m * 256 + cc + 32 * p] = (bf16)f2bf((x1 * cs - x2 * sn) * sc);
                O[(size_t)m * 256 + cc + 32 * p + 16] = (bf16)f2bf((x2 * cs + x1 * sn) * sc); }
        } else { const size_t off = reg == 10 ? WS_DV : reg == 11 ? WS_FQ : reg == 12 ? WS_FK : WS_FV; bf16* O = (bf16*)(ws + off);
            const float sc = reg == 11 ? 0.125f * LOG2E : 1.f; const int cc = c0 - reg * 256;
#pragma unroll
            for (int j = 0; j < 4; ++j) O[(size_t)m * 256 + cc + 16 * j] = (bf16)f2bf(v[j] * sc);
        }
    }
};
__device__ __forceinline__ void gemm1_naive(const Frame& F, int layer) {
    const bf16* XN = WSP(bf16, WS_XN); const float* W = F.in[3] + (size_t)layer * DM * INW;
    constexpr int NT = (M / 128) * 56;
    for (int tile = F.blk; tile < NT; tile += F.G) {
        const int rt = tile / 56, ct = tile % 56;
        EpiInproj E{F.ws, layer, rt * 128};
        ngemm_tile<false>(F, XN + (size_t)rt * 128 * DM, DM, W, nullptr, INW, DM, ct * 64, E);
    }
}

__device__ __forceinline__ void hgrn_naive(const Frame& F, int layer, int which) {
    const bf16* HQ = WSP(bf16, WS_HQ); const float* HLF = WSP(float, WS_HLF); const bf16* HK = WSP(bf16, WS_HK); const bf16* HV = WSP(bf16, WS_HV); float* ORAW = WSP(float, WS_ORAW);
    const int grp = F.tid >> 7, v = F.tid & 127, bh = which * 4 + grp, b = bh >> 2, h = bh & 3;
    LAS float* sm = (LAS float*)F.lds;
    float S[128];
#pragma unroll
    for (int k = 0; k < 128; ++k) S[k] = 0.f;
    const size_t base = (size_t)b * LSEQ * 512 + 128 * h + v;
    float nq = bf2f(HQ[base]), nf = __expf(HLF[base]), nk = bf2f(HK[base]), nv = bf2f(HV[base]);
    for (int t = 0; t < LSEQ; ++t) {
        LAS float* bufp = sm + (t & 1) * 1536 + grp * 384;
        bufp[v] = nq; bufp[128 + v] = nf; bufp[256 + v] = nk; const float vt = nv;
        __syncthreads();
        if (t + 1 < LSEQ) { const size_t o = base + (size_t)(t + 1) * 512; nq = bf2f(HQ[o]); nf = __expf(HLF[o]); nk = bf2f(HK[o]); nv = bf2f(HV[o]); }
        float o = 0.f;
#pragma unroll
        for (int k4 = 0; k4 < 32; ++k4) {
            const f32x4 q4 = *(const LAS f32x4*)(bufp + 4 * k4), f4 = *(const LAS f32x4*)(bufp + 128 + 4 * k4), kk4 = *(const LAS f32x4*)(bufp + 256 + 4 * k4);
#pragma unroll
            for (int e = 0; e < 4; ++e) { const int k = 4 * k4 + e; S[k] = f4[e] * S[k] + kk4[e] * vt; o += q4[e] * S[k]; }
        }
        ORAW[base + (size_t)t * 512] = o;
    }
}

template <int DQK>
__device__ __forceinline__ void attn_lane(const float (&q)[DQK], const bf16* Kp, int kpitch, const bf16* Vp, int vpitch, const float* FDrow, float fdq, int t, int smax, float (&o)[64]) {
    float acc[64]; float mx = -INFINITY, l = 0.f;
#pragma unroll
    for (int d = 0; d < 64; ++d) acc[d] = 0.f;
    for (int s = PADR; s <= smax; ++s) {
        const u32x4* kp = (const u32x4*)(Kp + (size_t)s * kpitch);
        float sc = FDrow ? fdq - FDrow[s] : 0.f;
#pragma unroll
        for (int c = 0; c < DQK / 8; ++c) { const u32x4 w = kp[c];
            sc += q[8 * c + 0] * bflo(w.x) + q[8 * c + 1] * bfhi(w.x) + q[8 * c + 2] * bflo(w.y) + q[8 * c + 3] * bfhi(w.y)
                + q[8 * c + 4] * bflo(w.z) + q[8 * c + 5] * bfhi(w.z) + q[8 * c + 6] * bflo(w.w) + q[8 * c + 7] * bfhi(w.w); }
        if (s <= t) {
            if (sc > mx) { const float al = exp2f(mx - sc); l *= al;
#pragma unroll
                for (int d = 0; d < 64; ++d) acc[d] *= al;
                mx = sc; }
            const float p = exp2f(sc - mx); l += p;
            const u32x4* vp = (const u32x4*)(Vp + (size_t)s * vpitch);
#pragma unroll
            for (int c = 0; c < 8; ++c) { const u32x4 w = vp[c];
                acc[8 * c + 0] += p * bflo(w.x); acc[8 * c + 1] += p * bfhi(w.x); acc[8 * c + 2] += p * bflo(w.y); acc[8 * c + 3] += p * bfhi(w.y);
                acc[8 * c + 4] += p * bflo(w.z); acc[8 * c + 5] += p * bfhi(w.z); acc[8 * c + 6] += p * bflo(w.w); acc[8 * c + 7] += p * bfhi(w.w); }
        }
    }
    const float il = l > 0.f ? 1.f / l : 0.f;
#pragma unroll
    for (int d = 0; d < 64; ++d) o[d] = acc[d] * il;
}
__device__ __forceinline__ void attn_naive(const Frame& F, int layer, int vblk, int nblk, int nqb  ) {
    const int lane = F.lane;
    bf16* MIX = WSP(bf16, WS_MIX);
    const float* lv = F.in[6] + layer * 128;
    float lam; { float a = lane < 32 ? lv[lane] * lv[32 + lane] : 0.f, c = lane < 32 ? lv[64 + lane] * lv[96 + lane] : 0.f; a = wave_sum(a); c = wave_sum(c);
        const float lam_init = 0.8f - 0.6f * expf(-0.3f * (float)layer); lam = expf(a) - expf(c) + lam_init; }
    const float lam_init = 0.8f - 0.6f * expf(-0.3f * (float)layer);
    const int NQB = nqb, NTASK = 2 * 8 * NQB;
    for (int task = vblk * 8 + F.wave; task < NTASK; task += nblk * 8) {
        const int qb = NQB - 1 - task / 16, r = task % 16, type = r >> 3, bh = r & 7, b = bh >> 2, h = bh & 3;
        const int t = qb * 64 + lane, smax = qb * 64 + 63; const size_t m = (size_t)b * LSEQ + t; const size_t rb = (size_t)b * LSEQ;
        float o[64];
        if (type == 0) {
            const bf16* FQ = WSP(bf16, WS_FQ); const float* FD = WSP(float, WS_FD2) + (size_t)bh * LSEQ;
            float q[64];
#pragma unroll
            for (int c = 0; c < 8; ++c) { const u32x4 w = *(const u32x4*)(FQ + m * 256 + 64 * h + 8 * c);
                q[8 * c] = bflo(w.x); q[8 * c + 1] = bfhi(w.x); q[8 * c + 2] = bflo(w.y); q[8 * c + 3] = bfhi(w.y); q[8 * c + 4] = bflo(w.z); q[8 * c + 5] = bfhi(w.z); q[8 * c + 6] = bflo(w.w); q[8 * c + 7] = bfhi(w.w); }
            attn_lane<64>(q, WSP(bf16, WS_FK) + rb * 256 + 64 * h, 256, WSP(bf16, WS_FV) + rb * 256 + 64 * h, 256, FD, FD[t], t, smax, o);
            float ss = 0.f;
#pragma unroll
            for (int d = 0; d < 64; ++d) ss += o[d] * o[d];
            const float rn = rsqrtf(ss * (1.f / 64.f) + EPS); const float* gn = F.in[9] + layer * 64;
#pragma unroll
            for (int d = 0; d < 64; d += 2) *(unsigned*)(MIX + m * DM + 768 + 64 * h + d) = t >= PADR ? pk2(o[d] * rn * gn[d], o[d + 1] * rn * gn[d + 1]) : 0u;
        } else {
            const bf16* DQ = WSP(bf16, WS_DQ);
            float o0[64];
#pragma unroll
            for (int comp = 0; comp < 2; ++comp) {
                float q[32];
#pragma unroll
                for (int c = 0; c < 4; ++c) { const u32x4 w = *(const u32x4*)(DQ + m * 256 + 32 * (2 * h + comp) + 8 * c);
                    q[8 * c] = bflo(w.x); q[8 * c + 1] = bfhi(w.x); q[8 * c + 2] = bflo(w.y); q[8 * c + 3] = bfhi(w.y); q[8 * c + 4] = bflo(w.z); q[8 * c + 5] = bfhi(w.z); q[8 * c + 6] = bflo(w.w); q[8 * c + 7] = bfhi(w.w); }
                if (comp == 0) attn_lane<32>(q, WSP(bf16, WS_DK) + rb * 256 + 32 * (2 * h + comp), 256, WSP(bf16, WS_DV) + rb * 256 + 64 * h, 256, nullptr, 0.f, t, smax, o0);
                else attn_lane<32>(q, WSP(bf16, WS_DK) + rb * 256 + 32 * (2 * h + comp), 256, WSP(bf16, WS_DV) + rb * 256 + 64 * h, 256, nullptr, 0.f, t, smax, o);
            }
            float ss = 0.f;
#pragma unroll
            for (int d = 0; d < 64; ++d) { o[d] = o0[d] - lam * o[d]; ss += o[d] * o[d]; }
            const float rn = rsqrtf(ss * (1.f / 64.f) + EPS) * (1.f - lam_init); const float* gn = F.in[7] + layer * 64;
#pragma unroll
            for (int d = 0; d < 64; d += 2) *(unsigned*)(MIX + m * DM + 512 + 64 * h + d) = t >= PADR ? pk2(o[d] * rn * gn[d], o[d + 1] * rn * gn[d + 1]) : 0u;
        }
    }
}

__device__ __forceinline__ void hgrn_post(const Frame& F, int layer) {
    const float* ORAW = WSP(float, WS_ORAW); const bf16* HG = WSP(bf16, WS_HG); bf16* MIX = WSP(bf16, WS_MIX); const float* gn = F.in[5] + layer * 128;
    const int gw = F.blk * 8 + F.wave, NGW = F.G * 8, lane = F.lane;
    for (int it = gw; it < M * 4; it += NGW) {
        const int m = it >> 2, h = it & 3;
        const f32x2 o = *(const f32x2*)(ORAW + (size_t)m * 512 + 128 * h + 2 * lane);
        const float ss = wave_sum(o.x * o.x + o.y * o.y), rn = rsqrtf(ss * (1.f / 128.f) + EPS);
        const unsigned g = *(const unsigned*)(HG + (size_t)m * 512 + 128 * h + 2 * lane);
        *(unsigned*)(MIX + (size_t)m * DM + 128 * h + 2 * lane) = pk2(o.x * rn * gn[2 * lane] * bflo(g), o.y * rn * gn[2 * lane + 1] * bfhi(g));
    }
}

struct EpiResid { float* H; int m0;
    __device__ __forceinline__ void operator()(int r, int c0, const float (&v)[4], const float (&)[4]) const {
#pragma unroll
        for (int j = 0; j < 4; ++j) H[(size_t)(m0 + r) * DM + c0 + 16 * j] += v[j]; } };
__device__ __forceinline__ void gemm2_naive(const Frame& F, int layer) {
    const bf16* MIX = WSP(bf16, WS_MIX); const float* W = F.in[10] + (size_t)layer * DM * DM;
    constexpr int NT = (M / 128) * 16;
    for (int tile = F.blk; tile < NT; tile += F.G) {
        const int rt = tile / 16, ct = tile % 16;
        EpiResid E{WSP(float, WS_H), rt * 128};
        ngemm_tile<false>(F, MIX + (size_t)rt * 128 * DM, DM, W, nullptr, DM, DM, ct * 64, E);
    }
}

__device__ __forceinline__ void norm2_route_generic(const Frame& F, int layer) {
    typedef short bf16x8_t __attribute__((ext_vector_type(8)));
    const float* H = WSP(float, WS_H); bf16* XN = WSP(bf16, WS_XN);
    int* TOKE = WSP(int, WS_TOKE); int* TOKR = WSP(int, WS_TOKR);
    unsigned* CNT = WSP(unsigned, WS_CTL) + CW_CNT + 64 * layer;
    const float* gain = F.in[11] + layer * DM; const float* bg = F.in[13] + layer * 4; const float* br = F.in[15] + layer * 32;
    const bf16* WThi = WSP(bf16, WS_WRT) + (size_t)(layer * 2) * 48 * 1024; const bf16* WTlo = WThi + 48 * 1024;
    const int RPB = (M + F.G - 1) / F.G, r0 = F.blk * RPB, r1 = (r0 + RPB < M) ? r0 + RPB : M, nrow = r1 - r0, lane = F.lane;
    LAS int* sE = (LAS int*)F.lds;
    LAS int* sRank = sE + 2048; LAS int* sBase = sRank + 2048;
    LAS float* sR = (LAS float*)(sBase + 64);
    LAS float* sL = sR + 1024;
    LAS float* sG = sL + 96 * 48;
    for (int m = r0 + F.wave; m < r1; m += 8) {
        float ss = 0.f;
#pragma unroll
        for (int j = 0; j < 4; ++j) { const f32x4 x = *(const f32x4*)(H + (size_t)m * DM + 4 * lane + 256 * j); ss += (x.x * x.x + x.y * x.y) + (x.z * x.z + x.w * x.w); }
        ss = wave_sum(ss);
        if (lane == 0) sR[m - r0] = rsqrtf(ss * (1.f / DM) + EPS);
    }
    __syncthreads();
    for (int tile = F.wave; tile * 16 < nrow; tile += 8) {
        const int lr = tile * 16 + (lane & 15), kg = lane >> 4; const bool rvalid = lr < nrow; const int row = r0 + (rvalid ? lr : nrow - 1);
        const float rr = sR[row - r0];
        f32x4 acc[3] = {(f32x4){0.f, 0.f, 0.f, 0.f}, (f32x4){0.f, 0.f, 0.f, 0.f}, (f32x4){0.f, 0.f, 0.f, 0.f}};
#pragma unroll 4
        for (int ks = 0; ks < 32; ++ks) {
            const int k0 = 32 * ks + 8 * kg;
            const f32x4 xa = *(const f32x4*)(H + (size_t)row * DM + k0), xb = *(const f32x4*)(H + (size_t)row * DM + k0 + 4);
            const f32x4 ga = *(const f32x4*)(gain + k0), gb = *(const f32x4*)(gain + k0 + 4);
            const f32x4 ua = xa * rr * ga, ub = xb * rr * gb;
            u32x4 hi4; hi4.x = pk2(ua.x, ua.y); hi4.y = pk2(ua.z, ua.w); hi4.z = pk2(ub.x, ub.y); hi4.w = pk2(ub.z, ub.w);
            u32x4 lo4; lo4.x = pk2(ua.x - bflo(hi4.x), ua.y - bfhi(hi4.x)); lo4.y = pk2(ua.z - bflo(hi4.y), ua.w - bfhi(hi4.y));
            lo4.z = pk2(ub.x - bflo(hi4.z), ub.y - bfhi(hi4.z)); lo4.w = pk2(ub.z - bflo(hi4.w), ub.w - bfhi(hi4.w));
            if (rvalid) *(u32x4*)(XN + (size_t)row * DM + k0) = hi4;
            const bf16x8_t ah = __builtin_bit_cast(bf16x8_t, hi4), al = __builtin_bit_cast(bf16x8_t, lo4);
#pragma unroll
            for (int ct = 0; ct < 3; ++ct) {
                const bf16x8_t wh = *(const bf16x8_t*)(WThi + (size_t)(16 * ct + (lane & 15)) * 1024 + k0), wl = *(const bf16x8_t*)(WTlo + (size_t)(16 * ct + (lane & 15)) * 1024 + k0);
                acc[ct] = __builtin_amdgcn_mfma_f32_16x16x32_bf16(ah, wh, acc[ct], 0, 0, 0);
                acc[ct] = __builtin_amdgcn_mfma_f32_16x16x32_bf16(ah, wl, acc[ct], 0, 0, 0);
                acc[ct] = __builtin_amdgcn_mfma_f32_16x16x32_bf16(al, wh, acc[ct], 0, 0, 0);
            }
        }
#pragma unroll
        for (int ct = 0; ct < 3; ++ct)
#pragma unroll
            for (int q = 0; q < 4; ++q) sL[(tile * 16 + 4 * kg + q) * 48 + 16 * ct + (lane & 15)] = acc[ct][q];
    }
    __syncthreads();
    if (F.tid < nrow) {
        const int li = F.tid, m = r0 + li; const LAS float* lg = sL + li * 48;
        const float g0 = lg[0] + bg[0], g1 = lg[1] + bg[1], g2 = lg[2] + bg[2], g3 = lg[3] + bg[3];
        int gs = 0; float gm = g0; if (g1 > gm) { gm = g1; gs = 1; } if (g2 > gm) { gm = g2; gs = 2; } if (g3 > gm) { gm = g3; gs = 3; }
        const float pg = 1.f / (expf(g0 - gm) + expf(g1 - gm) + expf(g2 - gm) + expf(g3 - gm));
        float e[8];
#pragma unroll
        for (int q = 0; q < 8; ++q) e[q] = lg[4 + gs * 8 + q] + br[gs * 8 + q];
        int i0 = 0; float m0 = e[0];
#pragma unroll
        for (int q = 1; q < 8; ++q) if (e[q] > m0) { m0 = e[q]; i0 = q; }
        int i1 = -1; float m1 = -INFINITY;
#pragma unroll
        for (int q = 0; q < 8; ++q) if (q != i0 && e[q] > m1) { m1 = e[q]; i1 = q; }
        if (i1 < 0) i1 = (i0 + 1) & 7;
        const float p1 = expf(m1 - m0), den = 1.f / (1.f + p1);
        TOKE[2 * m] = gs * 8 + i0; TOKE[2 * m + 1] = gs * 8 + i1;
        sE[2 * li] = gs * 8 + i0; sE[2 * li + 1] = gs * 8 + i1; sG[2 * li] = pg * den; sG[2 * li + 1] = pg * p1 * den;
    }
    __syncthreads();
    const int na = 2 * nrow;
    for (int i = F.tid; i < na; i += 512) { const int e = sE[i]; int r = 0; for (int j = 0; j < i; ++j) r += (sE[j] == e) ? 1 : 0; sRank[i] = r; }
    if (F.tid < NEXP) { int c = 0; for (int i = 0; i < na; ++i) c += (sE[i] == F.tid) ? 1 : 0;
        sBase[F.tid] = c ? (int)__hip_atomic_fetch_add(CNT + F.tid, (unsigned)c, __ATOMIC_RELAXED, __HIP_MEMORY_SCOPE_AGENT) : 0; }
    __syncthreads();
    int* LIST = WSP(int, WS_LIST); float* GLIST = WSP(float, WS_GLIST);
    for (int i = F.tid; i < na; i += 512) { const int e = sE[i], rank = sBase[e] + sRank[i]; TOKR[2 * r0 + i] = rank;
        LIST[(size_t)e * M + rank] = r0 + (i >> 1); GLIST[(size_t)e * M + rank] = sG[i]; }
    __syncthreads();
}

__device__ __forceinline__ void norm2_route(const Frame& F, int layer) {
    if (F.G * 65 != M) { norm2_route_generic(F, layer); return; }
    typedef short bf16x8_t __attribute__((ext_vector_type(8)));
    const float* H = WSP(float, WS_H); bf16* XN = WSP(bf16, WS_XN);
    int* TOKE = WSP(int, WS_TOKE); int* TOKR = WSP(int, WS_TOKR);
    unsigned* CNT = WSP(unsigned, WS_CTL) + CW_CNT + 64 * layer;
    const float* gain = F.in[11] + layer * DM; const float* bg = F.in[13] + layer * 4; const float* br = F.in[15] + layer * 32;
    const float* wgf = F.in[12] + (size_t)layer * DM * 4; const float* wrf = F.in[14] + (size_t)layer * DM * 32;
    const bf16* WThi = WSP(bf16, WS_WRT) + (size_t)(layer * 2) * 48 * 1024; const bf16* WTlo = WThi + 48 * 1024;
    const int lane = F.lane, wave = F.wave, nrow = 65;
#define GROW(li) ((li) < 64 ? 64 * F.blk + (li) : 64 * F.G + F.blk)
    LAS int* sE = (LAS int*)F.lds; LAS int* sRank = sE + 2048; LAS int* sBase = sRank + 2048;
    LAS float* sR = (LAS float*)(sBase + 64);
    LAS float* sL = sR + 1024;
    LAS float* sG = sL + 96 * 48;
    LAS float* slab = sG + 1024;
    LAS float* xl = slab + 4 * 64 * 48;
    const int kq = wave & 3, rh = wave >> 2, l15 = lane & 15, kg = lane >> 4;
    f32x4 xa[2][8], xb[2][8];
#pragma unroll
    for (int t = 0; t < 2; ++t)
#pragma unroll
        for (int ks = 0; ks < 8; ++ks) { const size_t row = (size_t)64 * F.blk + 32 * rh + 16 * t + l15; const int k0 = 256 * kq + 32 * ks + 8 * kg;
            xa[t][ks] = *(const f32x4*)(H + row * DM + k0); xb[t][ks] = *(const f32x4*)(H + row * DM + k0 + 4); }
    const size_t mx = GROW(64); const int kx = 128 * wave + 2 * lane;
    const f32x2 xv = *(const f32x2*)(H + mx * DM + kx);
#pragma unroll
    for (int t = 0; t < 2; ++t) { float ss = 0.f;
#pragma unroll
        for (int ks = 0; ks < 8; ++ks) ss += ((xa[t][ks].x * xa[t][ks].x + xa[t][ks].y * xa[t][ks].y) + (xa[t][ks].z * xa[t][ks].z + xa[t][ks].w * xa[t][ks].w))
                                           + ((xb[t][ks].x * xb[t][ks].x + xb[t][ks].y * xb[t][ks].y) + (xb[t][ks].z * xb[t][ks].z + xb[t][ks].w * xb[t][ks].w));
        ss += __shfl_xor(ss, 16); ss += __shfl_xor(ss, 32);
        if (lane < 16) sR[kq * 64 + 32 * rh + 16 * t + l15] = ss; }
    { const float sx = wave_sum(xv.x * xv.x + xv.y * xv.y); if (lane == 0) sR[256 + wave] = sx; }
    if (F.tid < 36) sR[512 + F.tid] = F.tid < 4 ? bg[F.tid] : br[F.tid - 4];
    float xu0, xu1;
    {
        const int k = kx; const f32x2 gv = *(const f32x2*)(gain + k);
        const float u0 = xv.x * gv.x, u1 = xv.y * gv.y; xu0 = u0; xu1 = u1;
        { const f32x4 a0 = *(const f32x4*)(wgf + (size_t)k * 4), a1 = *(const f32x4*)(wgf + (size_t)(k + 1) * 4);
          const float p0 = wave_sum(u0 * a0.x + u1 * a1.x), p1 = wave_sum(u0 * a0.y + u1 * a1.y), p2 = wave_sum(u0 * a0.z + u1 * a1.z), p3 = wave_sum(u0 * a0.w + u1 * a1.w);
          if (lane == 0) { xl[wave * 36 + 0] = p0; xl[wave * 36 + 1] = p1; xl[wave * 36 + 2] = p2; xl[wave * 36 + 3] = p3; } }
#pragma unroll
        for (int e4 = 0; e4 < 8; ++e4) { const f32x4 b0 = *(const f32x4*)(wrf + (size_t)k * 32 + 4 * e4), b1 = *(const f32x4*)(wrf + (size_t)(k + 1) * 32 + 4 * e4);
            const float p0 = wave_sum(u0 * b0.x + u1 * b1.x), p1 = wave_sum(u0 * b0.y + u1 * b1.y), p2 = wave_sum(u0 * b0.z + u1 * b1.z), p3 = wave_sum(u0 * b0.w + u1 * b1.w);
            if (lane == 0) { xl[wave * 36 + 4 + 4 * e4] = p0; xl[wave * 36 + 5 + 4 * e4] = p1; xl[wave * 36 + 6 + 4 * e4] = p2; xl[wave * 36 + 7 + 4 * e4] = p3; }
            __builtin_amdgcn_sched_barrier(0); }
    }
    __syncthreads();
    {
        float rr[2];
#pragma unroll
        for (int t = 0; t < 2; ++t) { const int li = 32 * rh + 16 * t + l15; rr[t] = rsqrtf(((sR[li] + sR[64 + li]) + (sR[128 + li] + sR[192 + li])) * (1.f / DM) + EPS); }
        f32x4 acc[2][3];
#pragma unroll
        for (int t = 0; t < 2; ++t)
#pragma unroll
            for (int ct = 0; ct < 3; ++ct) acc[t][ct] = (f32x4){0.f, 0.f, 0.f, 0.f};
#pragma unroll
        for (int ks = 0; ks < 8; ++ks) {
            const int k0 = 256 * kq + 32 * ks + 8 * kg;
            const f32x4 ga = *(const f32x4*)(gain + k0), gb = *(const f32x4*)(gain + k0 + 4);
            bf16x8_t wh[3], wl[3];
#pragma unroll
            for (int ct = 0; ct < 3; ++ct) { wh[ct] = *(const bf16x8_t*)(WThi + (size_t)(16 * ct + l15) * 1024 + k0); wl[ct] = *(const bf16x8_t*)(WTlo + (size_t)(16 * ct + l15) * 1024 + k0); }
#pragma unroll
            for (int t = 0; t < 2; ++t) { const size_t row = (size_t)64 * F.blk + 32 * rh + 16 * t + l15;
                const f32x4 ua = xa[t][ks] * rr[t] * ga, ub = xb[t][ks] * rr[t] * gb;
                u32x4 hi4; hi4.x = pk2(ua.x, ua.y); hi4.y = pk2(ua.z, ua.w); hi4.z = pk2(ub.x, ub.y); hi4.w = pk2(ub.z, ub.w);
                u32x4 lo4; lo4.x = pk2(ua.x - bflo(hi4.x), ua.y - bfhi(hi4.x)); lo4.y = pk2(ua.z - bflo(hi4.y), ua.w - bfhi(hi4.y));
                lo4.z = pk2(ub.x - bflo(hi4.z), ub.y - bfhi(hi4.z)); lo4.w = pk2(ub.z - bflo(hi4.w), ub.w - bfhi(hi4.w));
                *(u32x4*)(XN + row * DM + k0) = hi4;
                const bf16x8_t ah = __builtin_bit_cast(bf16x8_t, hi4), al = __builtin_bit_cast(bf16x8_t, lo4);
#pragma unroll
                for (int ct = 0; ct < 3; ++ct) {
                    acc[t][ct] = __builtin_amdgcn_mfma_f32_16x16x32_bf16(ah, wh[ct], acc[t][ct], 0, 0, 0);
                    acc[t][ct] = __builtin_amdgcn_mfma_f32_16x16x32_bf16(ah, wl[ct], acc[t][ct], 0, 0, 0);
                    acc[t][ct] = __builtin_amdgcn_mfma_f32_16x16x32_bf16(al, wh[ct], acc[t][ct], 0, 0, 0);
                } }
            __builtin_amdgcn_sched_barrier(0);
        }
#pragma unroll
        for (int t = 0; t < 2; ++t)
#pragma unroll
            for (int ct = 0; ct < 3; ++ct)
#pragma unroll
                for (int q = 0; q < 4; ++q) slab[(kq * 64 + 32 * rh + 16 * t + 4 * kg + q) * 48 + 16 * ct + l15] = acc[t][ct][q];
    }
    {
        float sx = 0.f;
#pragma unroll
        for (int w = 0; w < 8; ++w) sx += sR[256 + w];
        const float rr = rsqrtf(sx * (1.f / DM) + EPS);
        *(unsigned*)(XN + mx * DM + kx) = pk2(xu0 * rr, xu1 * rr);
    }
    __syncthreads();
    for (int idx = F.tid; idx < 65 * 36; idx += 512) { const int li = idx / 36, q = idx % 36;
        const float bias_q = sR[512 + q];
        float v_;
        if (li < 64) v_ = (slab[li * 48 + q] + slab[(64 + li) * 48 + q]) + (slab[(128 + li) * 48 + q] + slab[(192 + li) * 48 + q]);
        else { v_ = 0.f; float sx = 0.f;
#pragma unroll
            for (int w = 0; w < 8; ++w) { v_ += xl[w * 36 + q]; sx += sR[256 + w]; }
            v_ *= rsqrtf(sx * (1.f / DM) + EPS); }
        sL[li * 48 + q] = v_ + bias_q; }
    __syncthreads();
    if (F.tid < nrow) {
        const int li = F.tid; const size_t m = GROW(li); const LAS float* lg = sL + li * 48;
        const float g0 = lg[0], g1 = lg[1], g2 = lg[2], g3 = lg[3];
        int gs = 0; float gm = g0; if (g1 > gm) { gm = g1; gs = 1; } if (g2 > gm) { gm = g2; gs = 2; } if (g3 > gm) { gm = g3; gs = 3; }
        const float pg = 1.f / (expf(g0 - gm) + expf(g1 - gm) + expf(g2 - gm) + expf(g3 - gm));
        float e[8];
#pragma unroll
        for (int q = 0; q < 8; ++q) e[q] = lg[4 + gs * 8 + q];
        int i0 = 0; float m0 = e[0];
#pragma unroll
        for (int q = 1; q < 8; ++q) if (e[q] > m0) { m0 = e[q]; i0 = q; }
        int i1 = -1; float m1 = -INFINITY;
#pragma unroll
        for (int q = 0; q < 8; ++q) if (q != i0 && e[q] > m1) { m1 = e[q]; i1 = q; }
        if (i1 < 0) i1 = (i0 + 1) & 7;
        const float p1 = expf(m1 - m0), den = 1.f / (1.f + p1);
        TOKE[2 * m] = gs * 8 + i0; TOKE[2 * m + 1] = gs * 8 + i1;
        sE[2 * li] = gs * 8 + i0; sE[2 * li + 1] = gs * 8 + i1; sG[2 * li] = pg * den; sG[2 * li + 1] = pg * p1 * den;
    }
    __syncthreads();
    const int na = 2 * nrow;
    for (int i = F.tid; i < na; i += 512) { const int e = sE[i]; int r = 0; for (int j = 0; j < i; ++j) r += (sE[j] == e) ? 1 : 0; sRank[i] = r; }
    if (F.tid < NEXP) { int c = 0; for (int i = 0; i < na; ++i) c += (sE[i] == F.tid) ? 1 : 0;
        sBase[F.tid] = c ? (int)__hip_atomic_fetch_add(CNT + F.tid, (unsigned)c, __ATOMIC_RELAXED, __HIP_MEMORY_SCOPE_AGENT) : 0; }
    __syncthreads();
    int* LIST = WSP(int, WS_LIST); float* GLIST = WSP(float, WS_GLIST);
    for (int i = F.tid; i < na; i += 512) { const int e = sE[i], rank = sBase[e] + sRank[i]; const int m = GROW(i >> 1); TOKR[2 * m + (i & 1)] = rank;
        LIST[(size_t)e * M + rank] = m; GLIST[(size_t)e * M + rank] = sG[i]; }
    __syncthreads();
#undef GROW
}

__device__ __forceinline__ void moe_tile_bases(const Frame& F, int layer, LAS int* tb) {
    unsigned* CNT = WSP(unsigned, WS_CTL) + CW_CNT + 64 * layer;
    if (F.tid < NEXP) tb[40 + F.tid] = (int)__hip_atomic_load(CNT + F.tid, __ATOMIC_RELAXED, __HIP_MEMORY_SCOPE_AGENT);
    __syncthreads();
    if (F.tid == 0) { int acc = 0;
#pragma unroll
        for (int e = 0; e < NEXP; ++e) { tb[e] = acc; acc += (tb[40 + e] + 255) >> 8; } tb[NEXP] = acc; }
    __syncthreads();
    if (F.tid < 168) { int e = 0;
#pragma unroll
        for (int q = 1; q < NEXP; ++q) if (tb[q] <= F.tid) e = q;
        tb[256 + F.tid] = e; }
    __syncthreads();
}
__device__ __forceinline__ void moe_gather(const Frame& F, int layer) {
    LAS int* tb = (LAS int*)(F.lds + 131072);
    moe_tile_bases(F, layer, tb);
    const bf16* XN = WSP(bf16, WS_XN); bf16* XG = WSP(bf16, WS_XG); const int* TOKE = WSP(int, WS_TOKE); const float* TOKG = WSP(float, WS_TOKG); const int* TOKR = WSP(int, WS_TOKR);
    int* TOKS = WSP(int, WS_TOKS); float* SG = WSP(float, WS_SGATE);
    const int gw = F.blk * 8 + F.wave, NGW = F.G * 8, lane = F.lane;
    for (int it = gw; it < 2 * M; it += NGW) {
        const int m = it >> 1; const int e = TOKE[it]; const int slot = 256 * tb[e] + TOKR[it];
        const u32x4* src = (const u32x4*)(XN + (size_t)m * DM); u32x4* dst = (u32x4*)(XG + (size_t)slot * DM);
        dst[lane] = src[lane]; dst[64 + lane] = src[64 + lane];
        if (lane == 0) { TOKS[it] = slot; SG[slot] = TOKG[it]; }
    }
    __syncthreads();
}
struct EpiMoeUp { bf16* HB; int s0;
    __device__ __forceinline__ void operator()(int r, int c0, const float (&a)[4], const float (&b)[4]) const {
#pragma unroll
        for (int j = 0; j < 4; ++j) HB[(size_t)(s0 + r) * DE + c0 + 16 * j] = (bf16)f2bf(siluf_(a[j]) * b[j]); } };
struct EpiMoeDown { bf16* Y; const float* SG; int s0;
    __device__ __forceinline__ void operator()(int r, int c0, const float (&a)[4], const float (&)[4]) const {
        const float g = SG[s0 + r];
#pragma unroll
        for (int j = 0; j < 4; ++j) Y[(size_t)(s0 + r) * DM + c0 + 16 * j] = (bf16)f2bf(a[j] * g); } };
__device__ __forceinline__ int tile_expert(const LAS int* tb, int t256) { int e = 0;
#pragma unroll 1
    for (int q = 1; q < NEXP; ++q) if (tb[q] <= t256) e = q;
    return e; }
__device__ __forceinline__ void moe_up_naive(const Frame& F, int layer) {
    LAS int* tb = (LAS int*)(F.lds + 131072);
    moe_tile_bases(F, layer, tb);
    const int ntile = tb[NEXP] * 2 * 8;
    for (int tile = F.blk; tile < ntile; tile += F.G) {
        const int rt = tile / 8, ct = tile % 8, e = tile_expert(tb, rt >> 1);
        EpiMoeUp E{WSP(bf16, WS_HB), rt * 128};
        const size_t wo = ((size_t)layer * NEXP + e) * DM * DE;
        ngemm_tile<true>(F, WSP(bf16, WS_XG) + (size_t)rt * 128 * DM, DM, F.in[16] + wo, F.in[17] + wo, DE, DM, ct * 64, E);
    }
    __syncthreads();
}
__device__ __forceinline__ void moe_down_naive(const Frame& F, int layer) {
    LAS int* tb = (LAS int*)(F.lds + 131072);
    moe_tile_bases(F, layer, tb);
    const int ntile = tb[NEXP] * 2 * 16;
    for (int tile = F.blk; tile < ntile; tile += F.G) {
        const int rt = tile / 16, ct = tile % 16, e = tile_expert(tb, rt >> 1);
        EpiMoeDown E{WSP(bf16, WS_Y), WSP(float, WS_SGATE), rt * 128};
        const size_t wo = ((size_t)layer * NEXP + e) * DE * DM;
        ngemm_tile<false>(F, WSP(bf16, WS_HB) + (size_t)rt * 128 * DE, DE, F.in[18] + wo, nullptr, DM, DE, ct * 64, E);
    }
    __syncthreads();
}


__device__ __forceinline__ float fast_sigmoid(float x) { return __builtin_amdgcn_rcpf(1.f + __expf(-x)); }
__device__ __forceinline__ u32x4 pack8(const float (&y)[8]) { u32x4 w; w.x = pg8::cvt_pk_bf16(y[0], y[1]); w.y = pg8::cvt_pk_bf16(y[2], y[3]); w.z = pg8::cvt_pk_bf16(y[4], y[5]); w.w = pg8::cvt_pk_bf16(y[6], y[7]); return w; }
#define ACC8(x, ai, bj, m) float x[8]; { const pg8::f32x4 _a = acc[ai][bj][m][0], _b = acc[ai][bj][m][1]; x[0] = _a[0]; x[1] = _a[1]; x[2] = _a[2]; x[3] = _a[3]; x[4] = _b[0]; x[5] = _b[1]; x[6] = _b[2]; x[7] = _b[3]; }

struct EpiInprojM {
    static constexpr bool PERM = true, AFTER_DRAIN = false;
    unsigned char* ws; int layer;
    __device__ __forceinline__ void operator()(const pg8::f32x4 (&acc)[2][2][4][2], const pg8::Unit& u, int wr, int wc, int fr, int fq) const {
        const int pn = u.pn, row0 = u.pm * 256 + wr * 64 + fr, c8 = wc * 32 + 8 * fq;
        if (pn < 2 || (pn >= 4 && pn < 8)) {
            bf16* O = (bf16*)(ws + (pn < 2 ? WS_HQ : pn < 6 ? WS_HV : WS_HG)) + (pn & 1) * 256 + c8;
            const bool act = pn < 2 || pn >= 6; const float sc = pn < 2 ? 0.08838834764831845f : 1.f;
#pragma unroll
            for (int ai = 0; ai < 2; ++ai)
#pragma unroll
                for (int m = 0; m < 4; ++m) { const size_t ro = (size_t)(row0 + ai * 128 + m * 16) * 512;
#pragma unroll
                    for (int bj = 0; bj < 2; ++bj) { ACC8(x, ai, bj, m);
                        if (act) {
#pragma unroll
                            for (int e = 0; e < 8; ++e) x[e] = x[e] * fast_sigmoid(x[e]) * sc; }
                        *(u32x4*)(O + ro + bj * 128) = pack8(x); } }
        } else if (pn < 4) {
            float* LF = (float*)(ws + WS_HLF) + (pn & 1) * 256 + c8; bf16* KK = (bf16*)(ws + WS_HK) + (pn & 1) * 256 + c8;
            const float* LBV = (const float*)(ws + WS_LBV) + layer * 512 + (pn & 1) * 256 + c8;
            float lb[2][8];
#pragma unroll
            for (int bj = 0; bj < 2; ++bj) { const f32x4 a = *(const f32x4*)(LBV + bj * 128), b = *(const f32x4*)(LBV + bj * 128 + 4);
                lb[bj][0] = a.x; lb[bj][1] = a.y; lb[bj][2] = a.z; lb[bj][3] = a.w; lb[bj][4] = b.x; lb[bj][5] = b.y; lb[bj][6] = b.z; lb[bj][7] = b.w; }
#pragma unroll
            for (int ai = 0; ai < 2; ++ai)
#pragma unroll
                for (int m = 0; m < 4; ++m) { const int row = row0 + ai * 128 + m * 16; const size_t ro = (size_t)row * 512; const bool valid = (row % LSEQ) >= PADR;
#pragma unroll
                    for (int bj = 0; bj < 2; ++bj) { ACC8(x, ai, bj, m); float lf[8], kk[8];
#pragma unroll
                        for (int e = 0; e < 8; ++e) { const float sg = fast_sigmoid(x[e]), l = lb[bj][e]; const float f = l + (1.f - l) * sg;
                            lf[e] = valid ? __logf(fmaxf(f, TINYF)) : 0.f; kk[e] = valid ? (1.f - l) * (1.f - sg) : 0.f; }
                        *(f32x4*)(LF + ro + bj * 128) = (f32x4){lf[0], lf[1], lf[2], lf[3]}; *(f32x4*)(LF + ro + bj * 128 + 4) = (f32x4){lf[4], lf[5], lf[6], lf[7]};
                        *(u32x4*)(KK + ro + bj * 128) = pack8(kk); } }
        } else if (pn < 10) {
            bf16* O = (bf16*)(ws + (pn == 8 ? WS_DQ : WS_DK)) + 32 * (2 * wc + (fq >> 1)) + 8 * (fq & 1);
            const float sc = pn == 8 ? 0.17677669529663687f * LOG2E : 1.f;
            const float* COS = (const float*)(ws + WS_COS) + 8 * (fq & 1); const float* SIN = (const float*)(ws + WS_SIN) + 8 * (fq & 1);
#pragma unroll
            for (int ai = 0; ai < 2; ++ai)
#pragma unroll
                for (int m = 0; m < 4; ++m) { const int row = row0 + ai * 128 + m * 16, t = row % LSEQ; const size_t ro = (size_t)row * 256;
                    const f32x4 c0 = *(const f32x4*)(COS + t * 16), c1 = *(const f32x4*)(COS + t * 16 + 4), s0 = *(const f32x4*)(SIN + t * 16), s1 = *(const f32x4*)(SIN + t * 16 + 4);
                    const float cs[8] = {c0.x, c0.y, c0.z, c0.w, c1.x, c1.y, c1.z, c1.w}, sn[8] = {s0.x, s0.y, s0.z, s0.w, s1.x, s1.y, s1.z, s1.w};
                    ACC8(x1, ai, 0, m); ACC8(x2, ai, 1, m); float o1[8], o2[8];
#pragma unroll
                    for (int e = 0; e < 8; ++e) { o1[e] = (x1[e] * cs[e] - x2[e] * sn[e]) * sc; o2[e] = (x2[e] * cs[e] + x1[e] * sn[e]) * sc; }
                    *(u32x4*)(O + ro) = pack8(o1); *(u32x4*)(O + ro + 16) = pack8(o2); }
        } else {
            bf16* O = (bf16*)(ws + (pn == 10 ? WS_DV : pn == 11 ? WS_FQ : pn == 12 ? WS_FK : WS_FV)) + c8;
            const float sc = pn == 11 ? 0.125f * LOG2E : 1.f;
#pragma unroll
            for (int ai = 0; ai < 2; ++ai)
#pragma unroll
                for (int m = 0; m < 4; ++m) { const size_t ro = (size_t)(row0 + ai * 128 + m * 16) * 256;
#pragma unroll
                    for (int bj = 0; bj < 2; ++bj) { ACC8(x, ai, bj, m);
#pragma unroll
                        for (int e = 0; e < 8; ++e) x[e] *= sc;
                        *(u32x4*)(O + ro + bj * 128) = pack8(x); } }
        }
    }
};
struct EpiResidM {
    static constexpr bool PERM = true, AFTER_DRAIN = false;
    float* H; const float* x; const float* meta;
    __device__ __forceinline__ void operator()(const pg8::f32x4 (&acc)[2][2][4][2], const pg8::Unit& u, int wr, int wc, int fr, int fq) const {
        const int row0 = u.pm * 256 + wr * 64 + fr, col0 = u.pn * 256 + wc * 32 + 8 * fq;
#pragma unroll
        for (int ai = 0; ai < 2; ++ai)
#pragma unroll
            for (int m = 0; m < 4; ++m) { const int row = row0 + ai * 128 + m * 16; float* rp = H + (size_t)row * DM + col0;
                const float* bp = rp;
                if (x) { const int b = row / LSEQ, t = row % LSEQ; bp = t < PADR ? nullptr : t < 128 ? meta + (size_t)(t - PADR) * DM + col0 : x + ((size_t)b * SEQ + (t - 128)) * DM + col0; }
#pragma unroll
                for (int bj = 0; bj < 2; ++bj) { f32x4 a = (f32x4){0.f, 0.f, 0.f, 0.f}, b = a;
                    if (bp) { a = *(const f32x4*)(bp + bj * 128); b = *(const f32x4*)(bp + bj * 128 + 4); }
                    a += acc[ai][bj][m][0]; b += acc[ai][bj][m][1];
                    *(f32x4*)(rp + bj * 128) = a; *(f32x4*)(rp + bj * 128 + 4) = b; } }
    }
};
struct EpiMoeUpM {
    static constexpr bool PERM = true, AFTER_DRAIN = false;
    bf16* HB;
    __device__ __forceinline__ void operator()(const pg8::f32x4 (&acc)[2][2][4][2], const pg8::Unit& u, int wr, int wc, int fr, int fq) const {
        const int row0 = u.pm * 256 + wr * 64 + fr, col0 = (u.pn & 3) * 128 + wc * 32 + 8 * fq;
#pragma unroll
        for (int ai = 0; ai < 2; ++ai)
#pragma unroll
            for (int m = 0; m < 4; ++m) { ACC8(a, ai, 0, m); ACC8(b, ai, 1, m); float h[8];
#pragma unroll
                for (int e = 0; e < 8; ++e) h[e] = a[e] * fast_sigmoid(a[e]) * b[e];
                *(u32x4*)(HB + (size_t)(row0 + ai * 128 + m * 16) * DE + col0) = pack8(h); }
    }
};
struct EpiMoeDownM {
    static constexpr bool PERM = true, AFTER_DRAIN = false;
    bf16* Y; const float* GLIST; const LAS int* tb;
    __device__ __forceinline__ void operator()(const pg8::f32x4 (&acc)[2][2][4][2], const pg8::Unit& u, int wr, int wc, int fr, int fq) const {
        const int row0 = u.pm * 256 + wr * 64 + fr, col0 = (u.pn & 3) * 256 + wc * 32 + 8 * fq, e = u.pn >> 2, rk0 = 256 * (u.pm - tb[e]) + wr * 64 + fr, cnt = tb[40 + e];
#pragma unroll
        for (int ai = 0; ai < 2; ++ai)
#pragma unroll
            for (int m = 0; m < 4; ++m) { const int row = row0 + ai * 128 + m * 16, rk = rk0 + ai * 128 + m * 16; const float g = rk < cnt ? GLIST[(size_t)e * M + rk] : 0.f;
#pragma unroll
                for (int bj = 0; bj < 2; ++bj) { ACC8(x, ai, bj, m);
#pragma unroll
                    for (int e_ = 0; e_ < 8; ++e_) x[e_] *= g;
                    *(u32x4*)(Y + (size_t)row * DM + col0 + bj * 128) = pack8(x); } }
    }
};
template <bool GATHER_> struct MoeOrder {
    static constexpr bool GATHER = GATHER_;
    int nwg, G, c; const LAS int* tb; const int* LIST;
    __device__ __forceinline__ bool next(int i, pg8::Unit& u) const {
        const int L = i * G + c; if (L >= nwg) return false;
        const int q = nwg / 8, r = nwg % 8, xcd = L % 8, off = L / 8;
        const int id = (xcd < r ? xcd * (q + 1) : r * (q + 1) + (xcd - r) * q) + off;
        const int rt = id >> 2, e = tb[256 + rt];
        u.pm = rt; u.pn = e * 4 + (id & 3); return true;
    }
    __device__ __forceinline__ unsigned goff(const pg8::Unit& u, int row, int K) const {
        const int e = u.pn >> 2, rank = 256 * (u.pm - tb[e]) + row; const int tok = rank < tb[40 + e] ? LIST[(size_t)e * M + rank] : 0;
        return (unsigned)tok * (unsigned)K * 2u; }
    __device__ __forceinline__ void a_ready(const pg8::Unit&) const {}
    __device__ __forceinline__ void done(const pg8::Unit&) const {}
};

__device__ __forceinline__ void cvt_item(const float* W, int ld, int k0, int srccol  , bf16* WT, int K, int dr0, LAS float* scr, int lane) {
    float tv[32];
#pragma unroll
    for (int i = 0; i < 32; ++i) tv[i] = __builtin_nontemporal_load(W + (size_t)(k0 + 2 * i + (lane >> 5)) * ld + srccol);
#pragma unroll
    for (int i = 0; i < 32; ++i) scr[(2 * i + (lane >> 5)) * 33 + (lane & 31)] = tv[i];
    asm volatile("s_waitcnt lgkmcnt(0)" ::: "memory");
    const int c = lane & 7;
#pragma unroll
    for (int j = 0; j < 4; ++j) { const int n = (lane >> 3) + 8 * j; const LAS float* p = scr + (8 * c) * 33 + n;
        u32x4 o; o.x = pg8::cvt_pk_bf16(p[0 * 33], p[1 * 33]); o.y = pg8::cvt_pk_bf16(p[2 * 33], p[3 * 33]); o.z = pg8::cvt_pk_bf16(p[4 * 33], p[5 * 33]); o.w = pg8::cvt_pk_bf16(p[6 * 33], p[7 * 33]);
        *(u32x4*)(WT + (size_t)(dr0 + n) * K + k0 + 8 * c) = o; }
    asm volatile("s_waitcnt lgkmcnt(0)" ::: "memory");
}
__device__ __forceinline__ void convert_static_weights(const Frame& F) {
    LAS float* scr = (LAS float*)(F.lds + F.wave * 16384);
    const int gw = F.blk * 8 + F.wave, NGW = F.G * 8, lane = F.lane;
    constexpr int NA = 2 * 16 * 112, NB = 2 * 16 * 32;
    for (int it = gw; it < NA + NB; it += NGW) {
        if (it < NA) { const int l = it / (16 * 112), r = it % (16 * 112), kb = r / 112, nb = r % 112;
            const int n = nb * 32 + (lane & 31); int sc = n;
            if (n >= 2048 && n < 2560) { const int p = n & 255, hp = p & 127; sc = (n & ~255) + 32 * (hp >> 4) + (p >> 7) * 16 + (hp & 15); }
            cvt_item(F.in[3] + (size_t)l * DM * INW, INW, kb * 64, sc, WSP(bf16, WS_WIN) + (size_t)l * 3584 * DM, DM, nb * 32, scr, lane);
        } else { const int r0 = it - NA, l = r0 / (16 * 32), r = r0 % (16 * 32), kb = r / 32, nb = r % 32;
            cvt_item(F.in[10] + (size_t)l * DM * DM, DM, kb * 64, nb * 32 + (lane & 31), WSP(bf16, WS_WOUT) + (size_t)l * DM * DM, DM, nb * 32, scr, lane);
        }
    }
}
__device__ __forceinline__ void cvt_w13_item(const Frame& F, int layer, int it, LAS float* scr, int lane) {
    const int e = it / (16 * 32), r = it % (16 * 32), kb = r / 32, nb = r % 32;
    const int tile = nb >> 3, rr = (nb & 7) * 32;
    const float* src = (rr < 128 ? F.in[16] : F.in[17]) + ((size_t)layer * NEXP + e) * DM * DE;
    cvt_item(src, DE, kb * 64, 128 * tile + (rr & 127) + (lane & 31), WSP(bf16, WS_W13) + (size_t)e * DM * DM, DM, nb * 32, scr, lane);
}
__device__ __forceinline__ void cvt_w2_item(const Frame& F, int layer, int it, LAS float* scr, int lane) {
    const int le = layer * NEXP + it / (8 * 32), r = it % (8 * 32), kb = r / 32, nb = r % 32;
    cvt_item(F.in[18] + (size_t)le * DE * DM, DM, kb * 64, nb * 32 + (lane & 31), WSP(bf16, WS_W2) + (size_t)le * DM * DE, DE, nb * 32, scr, lane);
}
constexpr int NW13 = 32 * 16 * 32, NW2 = 32 * 8 * 32;
__device__ __forceinline__ void tail_convert(const Frame& F, int kind, int layer, int i0, int i1, int nwg, bool skip_last = false) {
    const int r = nwg % F.G; int prank = F.blk, np = F.G;
    if (r != 0 && F.G - r >= 32) { if (F.blk < r) return; prank = F.blk - r; np = F.G - r;
        if (skip_last) { if (F.blk == F.G - 1) return; --np; } }
    LAS float* scr = (LAS float*)(F.lds + F.wave * 16384);
#pragma unroll 1
    for (int it = i0 + prank * 8 + F.wave; it < i1; it += np * 8) { if (kind == 0) cvt_w13_item(F, layer, it, scr, F.lane); else cvt_w2_item(F, layer, it, scr, F.lane); }
}
__device__ __forceinline__ void gemm1_mfma(const Frame& F, int layer) {
    pg8::Gemm g{(const pg8::bf16_t*)WSP(bf16, WS_XN), (const pg8::bf16_t*)(WSP(bf16, WS_WIN) + (size_t)layer * 3584 * DM), M, 3584, DM};
    pg8::StaticOrder S; S.init(M, 3584, F.G, F.blk);
    EpiInprojM E{F.ws, layer};
    pg8::gemm_phase<EpiInprojM, pg8::StaticOrder, true, true>(F.lds, g, S, E);
}
constexpr int G2_PANELS = 64;
struct OneUnitOrder {
    static constexpr bool GATHER = false;
    int pm, pn;
    __device__ __forceinline__ unsigned goff(const pg8::Unit&, int, int) const { return 0u; }
    __device__ __forceinline__ bool next(int i, pg8::Unit& u) const { if (i != 0) return false; u.pm = pm; u.pn = pn; return true; }
    __device__ __forceinline__ void a_ready(const pg8::Unit&) const {}
    __device__ __forceinline__ void done(const pg8::Unit&) const {}
};
__device__ __forceinline__ void gemm2_unit(const Frame& F, int layer, int pm, int pn);
__device__ __forceinline__ void gemm2_mfma(const Frame& F, int layer) {
    pg8::Gemm g{(const pg8::bf16_t*)WSP(bf16, WS_MIX), (const pg8::bf16_t*)(WSP(bf16, WS_WOUT) + (size_t)layer * DM * DM), M, DM, DM};
    pg8::StaticOrder S; S.init(G2_PANELS * 256, DM, F.G, F.blk);
    EpiResidM E{WSP(float, WS_H), layer == 0 ? F.in[0] : nullptr, F.in[1]};
    pg8::gemm_phase<EpiResidM, pg8::StaticOrder, true, true>(F.lds, g, S, E);
}
__device__ __forceinline__ void gemm2_unit(const Frame& F, int layer, int pm, int pn) {
    pg8::Gemm g{(const pg8::bf16_t*)WSP(bf16, WS_MIX), (const pg8::bf16_t*)(WSP(bf16, WS_WOUT) + (size_t)layer * DM * DM), M, DM, DM};
    OneUnitOrder S{pm, pn};
    EpiResidM E{WSP(float, WS_H), layer == 0 ? F.in[0] : nullptr, F.in[1]};
    pg8::gemm_phase<EpiResidM, OneUnitOrder, true, true>(F.lds, g, S, E);
}
__device__ __forceinline__ void moe_up_mfma(const Frame& F, int layer) {
    LAS int* tb = (LAS int*)(F.lds + 131072);
    moe_tile_bases(F, layer, tb);
    pg8::Gemm g{(const pg8::bf16_t*)WSP(bf16, WS_XN), (const pg8::bf16_t*)WSP(bf16, WS_W13), MAXSLOT, NEXP * 1024, DM};
    MoeOrder<true> S{tb[NEXP] * 4, F.G, F.blk, tb, WSP(int, WS_LIST)};
    EpiMoeUpM E{WSP(bf16, WS_HB)};
    pg8::gemm_phase<EpiMoeUpM, MoeOrder<true>, true, true>(F.lds, g, S, E);
}
__device__ __forceinline__ void moe_down_mfma(const Frame& F, int layer) {
    LAS int* tb = (LAS int*)(F.lds + 131072);
    pg8::Gemm g{(const pg8::bf16_t*)WSP(bf16, WS_HB), (const pg8::bf16_t*)(WSP(bf16, WS_W2) + (size_t)layer * NEXP * DM * DE), MAXSLOT, NEXP * 1024, DE};
    MoeOrder<false> S{tb[NEXP] * 4, F.G, F.blk, tb, nullptr};
    EpiMoeDownM E{WSP(bf16, WS_Y), WSP(float, WS_GLIST), tb};
    pg8::gemm_phase<EpiMoeDownM, MoeOrder<false>, true, true>(F.lds, g, S, E);
}

namespace att {
typedef short bf16x8 __attribute__((ext_vector_type(8)));
typedef short s16x4 __attribute__((ext_vector_type(4)));
typedef float f32x16 __attribute__((ext_vector_type(16)));
constexpr int KSLOT = 10240, VSLOT = 8192;
constexpr int L_K = 0, L_V = 2 * KSLOT, L_WS = L_V + 2 * VSLOT, L_OA = L_WS + 2048, L_OB = L_OA + 32768, L_ITEM = L_OB + 32768;
constexpr float THR = 8.f;
__device__ __forceinline__ int crow(int r, int hi) { return (r & 3) + 8 * (r >> 2) + 4 * hi; }
__device__ __forceinline__ float max3f(float a, float b, float c) { float r; asm("v_max3_f32 %0, %1, %2, %3" : "=v"(r) : "v"(a), "v"(b), "v"(c)); return r; }
typedef float f32x2_t __attribute__((ext_vector_type(2))); typedef __bf16 bf16x2_t __attribute__((ext_vector_type(2)));
__device__ __forceinline__ unsigned cvtpk_s(float lo, float hi) { f32x2_t v = {lo, hi}; bf16x2_t b = __builtin_convertvector(v, bf16x2_t); return __builtin_bit_cast(unsigned, b); }
__device__ __forceinline__ void cmask(f32x16& p0, f32x16& p1, int jb, int qrel, int hi) {
    const float NEG = -INFINITY; const int kb = 64 * jb + 4 * hi;
#pragma unroll
    for (int r = 0; r < 16; ++r) { const int kv = kb + (r & 3) + 8 * (r >> 2); if (kv > qrel) p0[r] = NEG; if (kv + 32 > qrel) p1[r] = NEG; }
}
template <int NS> __device__ __forceinline__ void qkt(f32x16& p0, f32x16& p1, const LAS char* kb, const bf16x8* qr, const f32x16& negm) {
#pragma unroll
    for (int d0 = 0; d0 < NS; ++d0) {
        const bf16x8 b0 = *(const LAS bf16x8*)(kb + d0 * 2048), b1 = *(const LAS bf16x8*)(kb + d0 * 2048 + 512);
        if (d0 == 0) { p0 = __builtin_amdgcn_mfma_f32_32x32x16_bf16(b0, qr[0], negm, 0, 0, 0); p1 = __builtin_amdgcn_mfma_f32_32x32x16_bf16(b1, qr[0], negm, 0, 0, 0); }
        else { p0 = __builtin_amdgcn_mfma_f32_32x32x16_bf16(b0, qr[d0], p0, 0, 0, 0); p1 = __builtin_amdgcn_mfma_f32_32x32x16_bf16(b1, qr[d0], p1, 0, 0, 0); }
    }
}
__device__ __forceinline__ float rowmax(const f32x16& p0, const f32x16& p1) {
#define MX3_(a, b, c) __builtin_fmaxf(__builtin_fmaxf((a), (b)), (c))
    float a = MX3_(p0[0], p0[1], p1[0]), b = MX3_(p0[2], p0[3], p1[1]); a = MX3_(a, p1[2], p1[3]);
#pragma unroll
    for (int r = 4; r < 16; r += 4) { a = MX3_(a, p0[r], p0[r + 1]); b = MX3_(b, p0[r + 2], p0[r + 3]); a = MX3_(a, p1[r], p1[r + 1]); b = MX3_(b, p1[r + 2], p1[r + 3]); }
#undef MX3_
    const float m = __builtin_fmaxf(a, b);
    auto rr = __builtin_amdgcn_permlane32_swap(__float_as_uint(m), __float_as_uint(m), false, false);
    return __builtin_fmaxf(__uint_as_float(rr[0]), __uint_as_float(rr[1]));
}
__device__ __forceinline__ void pv(f32x16* o, int vb, bf16x8 pa0, bf16x8 pa1, bf16x8 pa2, bf16x8 pa3) {
#pragma unroll
    for (int d0 = 0; d0 < 2; ++d0) { s16x4 lo[4], hi[4];
#pragma unroll
        for (int ks = 0; ks < 4; ++ks) {
            asm volatile("ds_read_b64_tr_b16 %0,%1 offset:%c2" : "=&v"(lo[ks]) : "v"(vb), "i"(d0 * 4096 + ks * 1024) : "memory");
            asm volatile("ds_read_b64_tr_b16 %0,%1 offset:%c2" : "=&v"(hi[ks]) : "v"(vb), "i"(d0 * 4096 + ks * 1024 + 512) : "memory"); }
        asm volatile("s_waitcnt lgkmcnt(0)" ::: "memory"); __builtin_amdgcn_sched_barrier(0);
#define PK(k) (bf16x8){lo[k][0], lo[k][1], lo[k][2], lo[k][3], hi[k][0], hi[k][1], hi[k][2], hi[k][3]}
        o[d0] = __builtin_amdgcn_mfma_f32_32x32x16_bf16(pa0, PK(0), o[d0], 0, 0, 0);
        o[d0] = __builtin_amdgcn_mfma_f32_32x32x16_bf16(pa1, PK(1), o[d0], 0, 0, 0);
        o[d0] = __builtin_amdgcn_mfma_f32_32x32x16_bf16(pa2, PK(2), o[d0], 0, 0, 0);
        o[d0] = __builtin_amdgcn_mfma_f32_32x32x16_bf16(pa3, PK(3), o[d0], 0, 0, 0);
#undef PK
    }
}
template <bool DIFF>
__device__ __forceinline__ void attn_map(LAS unsigned char* lds, const GAS bf16* Qrow, const GAS bf16* Kb, const GAS bf16* Vb, const GAS bf16* KX, int NT, int wid, int lane, f32x16 (&o)[2]) {
    constexpr int NQK = DIFF ? 2 : 4, NS = NQK + 1, BAND = DIFF ? 2 : 4;
    const int r32 = lane & 31, hi = lane >> 5, wrow = DIFF ? (wid & 3) : wid, cmap = DIFF ? (wid >> 2) : 0;
    bf16x8 qr[NS];
#pragma unroll
    for (int d0 = 0; d0 < NQK; ++d0) qr[d0] = *(const GAS bf16x8*)(Qrow + d0 * 16 + hi * 8);
    { const short m1 = hi == 0 ? (short)0xBF80 : (short)0; qr[NQK] = (bf16x8){m1, m1, 0, 0, 0, 0, 0, 0}; }
    float mhat = 0.f, l = 0.f; o[0] = f32x16{}; o[1] = f32x16{}; f32x16 negm = f32x16{};
    const int qrel = wrow * 32 + r32, tlast = NT - BAND + (wrow >> 1);
    LAS float* wsf = (LAS float*)(lds + L_WS) + wid * 64;
    const int vb0 = (int)(unsigned)(uintptr_t)(lds + L_V) + ((lane >> 4) & 1) * 32 + (lane & 3) * 8 + (4 * hi + ((lane & 15) >> 2)) * 64;
    const int kdoff = cmap * 4096 + hi * 1024 + r32 * 16;
    u32x4 sk = (u32x4){0u, 0u, 0u, 0u}, sx = sk, sv = sk;
#define LOADT(t) do { const size_t key0_ = (size_t)64 * ((t) + 1); \
        sk = *(const GAS u32x4*)(Kb + (key0_ + lane) * 256 + wid * 8); \
        if (wid == 7) sx = *(const GAS u32x4*)(KX + (key0_ + lane) * 8); \
        sv = *(const GAS u32x4*)(Vb + (key0_ + 16 * (wid & 3) + (lane >> 2)) * 256 + (wid >> 2) * 32 + (lane & 3) * 8); } while (0)
#define STORET(buf) do { LAS unsigned char* kd_ = lds + L_K + (buf) * KSLOT; \
        *(LAS u32x4*)(kd_ + wid * 1024 + lane * 16) = sk; \
        if (wid == 7) *(LAS u32x4*)(kd_ + 8 * 1024 + lane * 16) = sx; \
        *(LAS u32x4*)(lds + L_V + (buf) * VSLOT + wid * 1024 + lane * 16) = sv; } while (0)
    if (wid == 6) { *(LAS u32x4*)(lds + L_K + 9 * 1024 + lane * 16) = (u32x4){0u, 0u, 0u, 0u}; *(LAS u32x4*)(lds + L_K + KSLOT + 9 * 1024 + lane * 16) = (u32x4){0u, 0u, 0u, 0u}; }
    LOADT(NT - 1); STORET(0);
    __syncthreads();
#pragma unroll 1
    for (int i_ = 0; i_ < NT; ++i_) {
        const int t = NT - 1 - i_;
        if (t > 0) LOADT(t - 1);
        const int buf = i_ & 1;
        if (t <= tlast) {
        f32x16 p0, p1;
        { const LAS char* kb = (const LAS char*)(lds + L_K + buf * KSLOT);
#pragma unroll
          for (int d0 = 0; d0 < NS; ++d0) { const LAS char* kp = d0 < NQK ? kb + kdoff + d0 * 2048 : kb + 8 * 1024 + hi * 1024 + r32 * 16;
            const bf16x8 b0 = *(const LAS bf16x8*)kp, b1 = *(const LAS bf16x8*)(kp + 512);
            if (d0 == 0) { p0 = __builtin_amdgcn_mfma_f32_32x32x16_bf16(b0, qr[0], negm, 0, 0, 0); p1 = __builtin_amdgcn_mfma_f32_32x32x16_bf16(b1, qr[0], negm, 0, 0, 0); }
            else { p0 = __builtin_amdgcn_mfma_f32_32x32x16_bf16(b0, qr[d0], p0, 0, 0, 0); p1 = __builtin_amdgcn_mfma_f32_32x32x16_bf16(b1, qr[d0], p1, 0, 0, 0); } } }
        if (t >= NT - BAND) cmask(p0, p1, t - (NT - BAND), qrel, hi);
        const float rm = rowmax(p0, p1);
        const bool first = (t == tlast);
        if (first || __any(rm > THR)) {
            const float dl = first ? rm : fmaxf(rm, 0.f);
            mhat += dl;
#pragma unroll
            for (int r = 0; r < 16; ++r) { p0[r] -= dl; p1[r] -= dl; }
#pragma unroll
            for (int r = 0; r < 16; ++r) negm[r] = -mhat;
            if (!first) {
                const float f = __builtin_amdgcn_exp2f(-dl); l *= f;
                if (hi == 0) wsf[r32] = f;
                asm volatile("s_waitcnt lgkmcnt(0)" ::: "memory");
#pragma unroll
                for (int r = 0; r < 16; ++r) { const float fr = wsf[crow(r, hi)]; o[0][r] *= fr; o[1][r] *= fr; }
            }
        }
        float sacc = 0.f;
#pragma unroll
        for (int r = 0; r < 16; ++r) { p0[r] = __builtin_amdgcn_exp2f(p0[r]); p1[r] = __builtin_amdgcn_exp2f(p1[r]); sacc += p0[r] + p1[r]; }
        l += sacc;
        u32x4 pw0, pw1, pw2, pw3;
        pw0 = (u32x4){cvtpk_s(p0[0], p0[1]), cvtpk_s(p0[2], p0[3]), cvtpk_s(p0[4], p0[5]), cvtpk_s(p0[6], p0[7])};
        pw1 = (u32x4){cvtpk_s(p0[8], p0[9]), cvtpk_s(p0[10], p0[11]), cvtpk_s(p0[12], p0[13]), cvtpk_s(p0[14], p0[15])};
        pw2 = (u32x4){cvtpk_s(p1[0], p1[1]), cvtpk_s(p1[2], p1[3]), cvtpk_s(p1[4], p1[5]), cvtpk_s(p1[6], p1[7])};
        pw3 = (u32x4){cvtpk_s(p1[8], p1[9]), cvtpk_s(p1[10], p1[11]), cvtpk_s(p1[12], p1[13]), cvtpk_s(p1[14], p1[15])};
        pv(o, vb0 + buf * VSLOT, __builtin_bit_cast(bf16x8, pw0), __builtin_bit_cast(bf16x8, pw1), __builtin_bit_cast(bf16x8, pw2), __builtin_bit_cast(bf16x8, pw3));
        }
        if (t > 0) STORET((i_ + 1) & 1);
        __syncthreads();
    }
#undef LOADT
#undef STORET
    { auto rr = __builtin_amdgcn_permlane32_swap(__float_as_uint(l), __float_as_uint(l), false, false); l = __uint_as_float(rr[0]) + __uint_as_float(rr[1]); }
    if (hi == 0) wsf[32 + r32] = l;
    asm volatile("s_waitcnt lgkmcnt(0)" ::: "memory");
#pragma unroll
    for (int r = 0; r < 16; ++r) { const float rl = __builtin_amdgcn_rcpf(wsf[32 + crow(r, hi)]); o[0][r] *= rl; o[1][r] *= rl; }
}
__device__ __forceinline__ void stage_o(LAS unsigned char* stg_base, int blk32, int lane, const f32x16 (&o)[2]) {
    LAS bf16* stg = (LAS bf16*)stg_base + blk32 * 2048; const int r32 = lane & 31, hi = lane >> 5;
#pragma unroll
    for (int r = 0; r < 16; ++r) { const int orow = crow(r, hi);
#pragma unroll
        for (int d0 = 0; d0 < 2; ++d0) stg[orow * 64 + d0 * 32 + r32] = (bf16)f2bf(o[d0][r]); }
    asm volatile("s_waitcnt lgkmcnt(0)" ::: "memory");
}
}


namespace att2 {
using att::bf16x8; using att::s16x4; using att::f32x16; using att::crow; using att::cvtpk_s;
typedef short v4i16_t __attribute__((ext_vector_type(4)));
typedef const LAS char* lds_cptr;
constexpr int SLOTB = 8192, T_K = 0, T_V = 3 * SLOTB, T_WS = 6 * SLOTB, T_OA = T_WS + 2048, T_OB = T_OA + 32768, T_END = T_OB + 32768;
static_assert(T_END <= 131072, "att2 LDS map");
constexpr float THRL = 8.f;
__device__ __forceinline__ s16x4 vtr(lds_cptr p) { return __builtin_bit_cast(s16x4, __builtin_amdgcn_ds_read_tr16_b64_v4i16((LAS v4i16_t*)p)); }
#define SBAR() __builtin_amdgcn_sched_barrier(0)
__device__ __forceinline__ void diff_unit(LAS unsigned char* lds, const GAS bf16* Qrow, const GAS bf16* Kb, const GAS bf16* Vb, int NT, int wid, int lane, f32x16 (&o)[2]) {
    const int r32 = lane & 31, hi = lane >> 5, wrow = wid & 3, cmap = wid >> 2;
    bf16x8 qr[2];
#pragma unroll
    for (int d0 = 0; d0 < 2; ++d0) qr[d0] = *(const GAS bf16x8*)(Qrow + d0 * 16 + hi * 8);
    float mhat = 0.f; o[0] = f32x16{}; o[1] = f32x16{}; f32x16 negm = f32x16{}; asm volatile("" : "+v"(negm));
    f32x16 o2 = f32x16{};
    const bf16x8 ones = (r32 == 0) ? (bf16x8){(short)0x3F80, (short)0x3F80, (short)0x3F80, (short)0x3F80, (short)0x3F80, (short)0x3F80, (short)0x3F80, (short)0x3F80} : (bf16x8){0, 0, 0, 0, 0, 0, 0, 0};
    const int qrel = wrow * 32 + r32;
    LAS float* wsf = (LAS float*)(lds + T_WS) + wid * 64;
    const lds_cptr kp0 = (lds_cptr)(lds + T_K) + cmap * 4096 + hi * 1024 + r32 * 16;
    const lds_cptr vp0 = (lds_cptr)(lds + T_V) + ((lane >> 4) & 1) * 32 + (lane & 3) * 8 + (4 * hi + ((lane & 15) >> 2)) * 64;
    u32x4 sk = (u32x4){0u, 0u, 0u, 0u}, sv = sk, skA = sk, svA = sk, skB = sk, svB = sk;
#define PT(t) ((t) < 2 ? 1 - (t) : (t))
#define LOADKR(R, t) do { const size_t key0_ = (size_t)64 * PT(t); R = *(const GAS u32x4*)(Kb + (key0_ + lane) * 256 + wid * 8); } while (0)
#define LOADK(t) LOADKR(sk, t)
#define LOADVR(R, t) do { const size_t key0_ = (size_t)64 * PT(t); R = *(const GAS u32x4*)(Vb + (key0_ + 16 * (wid & 3) + (lane >> 2)) * 256 + (wid >> 2) * 32 + (lane & 3) * 8); } while (0)
#define LOADV(t) LOADVR(sv, t)
#define STOREKR(R, slot) do { *(LAS u32x4*)(lds + T_K + (slot) + wid * 1024 + lane * 16) = R; } while (0)
#define STOREK(slot) STOREKR(sk, slot)
#define STOREVR(R, slot) do { *(LAS u32x4*)(lds + T_V + (slot) + wid * 1024 + lane * 16) = R; } while (0)
#define STOREV(slot) STOREVR(sv, slot)
#define KLOAD2(j, kp) do { kf[2 * (j)] = *(const LAS bf16x8*)((kp) + (j) * 2048); kf[2 * (j) + 1] = *(const LAS bf16x8*)((kp) + (j) * 2048 + 512); } while (0)
#define CMASKT(P0, P1, t) do { const int jb_ = (t) - (NT - 2); \
        if ((t) == 1) { _Pragma("unroll") for (int r = 0; r < 16; ++r) { P0[r] = -INFINITY; P1[r] = -INFINITY; } } \
        else if (jb_ >= 0) { const int kb_ = 64 * jb_ + 4 * hi; _Pragma("unroll") for (int r = 0; r < 16; ++r) { const int kv_ = kb_ + (r & 3) + 8 * (r >> 2); if (kv_ > qrel) P0[r] = -INFINITY; if (kv_ + 32 > qrel) P1[r] = -INFINITY; } } } while (0)
    LOADK(0); LOADV(0); STOREK(0); STOREV(0); LOADK(1); STOREK(SLOTB); LOADK(2); STOREK(2 * SLOTB);
    __syncthreads();
    f32x16 pA0, pA1, pB0, pB1;
    bool resc = false;
    { const lds_cptr kb = kp0;
#pragma unroll
      for (int d0 = 0; d0 < 2; ++d0) { const bf16x8 b0 = *(const LAS bf16x8*)(kb + d0 * 2048), b1 = *(const LAS bf16x8*)(kb + d0 * 2048 + 512);
        if (d0 == 0) { pA0 = __builtin_amdgcn_mfma_f32_32x32x16_bf16(b0, qr[0], negm, 0, 0, 0); pA1 = __builtin_amdgcn_mfma_f32_32x32x16_bf16(b1, qr[0], negm, 0, 0, 0); }
        else { pA0 = __builtin_amdgcn_mfma_f32_32x32x16_bf16(b0, qr[1], pA0, 0, 0, 0); pA1 = __builtin_amdgcn_mfma_f32_32x32x16_bf16(b1, qr[1], pA1, 0, 0, 0); } }
#pragma unroll
      for (int r = 0; r < 16; ++r) { pA0[r] = -INFINITY; if (crow(r, hi) < 16) pA1[r] = -INFINITY; }
      const float rm = att::rowmax(pA0, pA1);
      mhat += rm;
#pragma unroll
      for (int r = 0; r < 16; ++r) { pA0[r] -= rm; pA1[r] -= rm; }
#pragma unroll
      for (int r = 0; r < 16; ++r) negm[r] = -mhat;
      asm volatile("" : "+v"(negm));
#pragma unroll
      for (int r = 0; r < 16; ++r) { pA0[r] = __builtin_amdgcn_exp2f(pA0[r]); pA1[r] = __builtin_amdgcn_exp2f(pA1[r]); } }
    __syncthreads();
    if (3 < NT) { LOADK(3); STOREK(0); }
    LOADV(1); STOREV(SLOTB);
    int sl_prev = 0, sl_cur = SLOTB, sl_next = 2 * SLOTB;
    bf16x8 kf[4];
    KLOAD2(0, kp0 + sl_cur); KLOAD2(1, kp0 + sl_cur);
    __syncthreads();
    s16x4 vlo[8], vhi[8]; u32x4 pw0, pw1, pw2, pw3;
#define PKW(P, B) cvtpk_s(P[B], P[B + 1])
#define PAF(k) __builtin_bit_cast(bf16x8, pw##k)
#define VFR(i) (bf16x8){vlo[i][0], vlo[i][1], vlo[i][2], vlo[i][3], vhi[i][0], vhi[i][1], vhi[i][2], vhi[i][3]}
#define PIN(x) asm volatile("" : "+v"(x))
#define MX3(a, b, c) __builtin_fmaxf(__builtin_fmaxf((a), (b)), (c))
#define GAPA(MF, A0, A1, A2, A3, W0, W1, PW) do { MF; W0; W1; PIN(PW); SBAR(); } while (0)
#define OSUM(k) o2 = __builtin_amdgcn_mfma_f32_32x32x16_bf16(PAF(k), ones, o2, 0, 0, 0)
#define EX(v) __builtin_amdgcn_exp2f(v)
#define GAPB(MF, X, B) do { MF; X[B] = EX(X[B]); X[B + 1] = EX(X[B + 1]); X[B + 2] = EX(X[B + 2]); X[B + 3] = EX(X[B + 3]); PIN(X); SBAR(); } while (0)
#define VRD(i) do { vlo[i] = vtr(vp_ + (((i) >> 2) * 4096 + ((i) & 3) * 1024)); vhi[i] = vtr(vp_ + (((i) >> 2) * 4096 + ((i) & 3) * 1024 + 512)); } while (0)
#define KRD(G, j) do { if (G) { KLOAD2(j, kp0 + sl_next); SBAR(); } } while (0)
#define NOMF ((void)0)
#define STEP(C0, C1, P0, P1, t, MASKED, LK, LV, SK, SV) do { SBAR(); \
        if ((t) + 3 < NT) LOADKR(LK, (t) + 3); if ((t) + 1 < NT) LOADVR(LV, (t) + 1); \
        const lds_cptr vp_ = vp0 + sl_prev; \
        VRD(0); SBAR(); \
        GAPA(C0 = __builtin_amdgcn_mfma_f32_32x32x16_bf16(kf[0], qr[0], negm, 0, 0, 0), P0[2], P0[3], P0[4], P0[5],     pw0[0] = PKW(P0, 0), pw0[1] = PKW(P0, 2), pw0); \
        VRD(4); SBAR(); GAPA(C1 = __builtin_amdgcn_mfma_f32_32x32x16_bf16(kf[1], qr[0], negm, 0, 0, 0), P0[6], P0[7], P0[8], P0[9],     pw0[2] = PKW(P0, 4), pw0[3] = PKW(P0, 6), pw0); \
        VRD(1); SBAR(); GAPA(C0 = __builtin_amdgcn_mfma_f32_32x32x16_bf16(kf[2], qr[1], C0, 0, 0, 0),   P0[10], P0[11], P0[12], P0[13], pw1[0] = PKW(P0, 8), pw1[1] = PKW(P0, 10), pw1); \
        VRD(5); SBAR(); GAPA(C1 = __builtin_amdgcn_mfma_f32_32x32x16_bf16(kf[3], qr[1], C1, 0, 0, 0),   P0[14], P0[15], P1[0], P1[1],   pw1[2] = PKW(P0, 12), pw1[3] = PKW(P0, 14), pw1); \
        VRD(2); SBAR(); GAPA(OSUM(0), P1[2], P1[3], P1[4], P1[5],     pw2[0] = PKW(P1, 0), pw2[1] = PKW(P1, 2), pw2); \
        VRD(6); SBAR(); GAPA(OSUM(1), P1[6], P1[7], P1[8], P1[9],     pw2[2] = PKW(P1, 4), pw2[3] = PKW(P1, 6), pw2); \
        VRD(3); SBAR(); GAPA(OSUM(2), P1[10], P1[11], P1[12], P1[13], pw3[0] = PKW(P1, 8), pw3[1] = PKW(P1, 10), pw3); \
        VRD(7); SBAR(); GAPA(NOMF, P1[14], P1[15], 0.f, 0.f,       pw3[2] = PKW(P1, 12), pw3[3] = PKW(P1, 14), pw3); \
        OSUM(3); \
        if (MASKED) CMASKT(C0, C1, t); \
        { float a = MX3(C0[0], C0[1], C1[0]), b = MX3(C0[2], C0[3], C1[1]); a = MX3(a, C1[2], C1[3]); \
          _Pragma("unroll") for (int r = 4; r < 16; r += 4) { a = MX3(a, C0[r], C0[r + 1]); b = MX3(b, C0[r + 2], C0[r + 3]); a = MX3(a, C1[r], C1[r + 1]); b = MX3(b, C1[r + 2], C1[r + 3]); } \
          float rm = __builtin_fmaxf(a, b); { auto rr = __builtin_amdgcn_permlane32_swap(__float_as_uint(rm), __float_as_uint(rm), false, false); rm = __builtin_fmaxf(__uint_as_float(rr[0]), __uint_as_float(rr[1])); } \
          resc = false; \
          if (__builtin_expect(__any(rm > THRL), 0)) { const float dl = __builtin_fmaxf(rm, 0.f); mhat += dl; \
            _Pragma("unroll") for (int r = 0; r < 16; ++r) { C0[r] -= dl; C1[r] -= dl; } \
            _Pragma("unroll") for (int r = 0; r < 16; ++r) negm[r] = -mhat; asm volatile("" : "+v"(negm)); \
            const float f = __builtin_amdgcn_exp2f(-dl); if (hi == 0) wsf[r32] = f; resc = true; } } \
        SBAR(); \
        GAPB(o[0] = __builtin_amdgcn_mfma_f32_32x32x16_bf16(PAF(0), VFR(0), o[0], 0, 0, 0), C0, 0); \
        GAPB(o[1] = __builtin_amdgcn_mfma_f32_32x32x16_bf16(PAF(0), VFR(4), o[1], 0, 0, 0), C0, 4); \
        KRD((t) + 1 < NT, 0); GAPB(o[0] = __builtin_amdgcn_mfma_f32_32x32x16_bf16(PAF(1), VFR(1), o[0], 0, 0, 0), C0, 8); \
        KRD((t) + 1 < NT, 1); GAPB(o[1] = __builtin_amdgcn_mfma_f32_32x32x16_bf16(PAF(1), VFR(5), o[1], 0, 0, 0), C0, 12); \
        GAPB(o[0] = __builtin_amdgcn_mfma_f32_32x32x16_bf16(PAF(2), VFR(2), o[0], 0, 0, 0), C1, 0); \
        GAPB(o[1] = __builtin_amdgcn_mfma_f32_32x32x16_bf16(PAF(2), VFR(6), o[1], 0, 0, 0), C1, 4); \
        GAPB(o[0] = __builtin_amdgcn_mfma_f32_32x32x16_bf16(PAF(3), VFR(3), o[0], 0, 0, 0), C1, 8); \
        GAPB(o[1] = __builtin_amdgcn_mfma_f32_32x32x16_bf16(PAF(3), VFR(7), o[1], 0, 0, 0), C1, 12); \
        if ((t) >= 2) { if ((t) + 2 < NT) STOREKR(SK, sl_prev); STOREVR(SV, sl_cur); } \
    } while (0)
#define RESC() do { if (resc) { asm volatile("s_waitcnt lgkmcnt(0)" ::: "memory"); \
        _Pragma("unroll") for (int r = 0; r < 16; ++r) { const float fr_ = wsf[crow(r, hi)]; o[0][r] *= fr_; o[1][r] *= fr_; o2[r] *= fr_; } } } while (0)
#define ROT() do { sl_prev = sl_cur; sl_cur = sl_next; sl_next = (sl_next == 2 * SLOTB) ? 0 : sl_next + SLOTB; } while (0)
#define ENDSTEP() do { __syncthreads(); RESC(); ROT(); } while (0)
    int t = 1;
    STEP(pB0, pB1, pA0, pA1, t, true, skA, svA, skB, svB); ENDSTEP(); ++t;
    if (t + 1 < NT) { STEP(pA0, pA1, pB0, pB1, t, true, skB, svB, skA, svA); ENDSTEP(); ++t; }
#pragma unroll 1
    for (; t + 3 < NT; t += 2) {
        STEP(pB0, pB1, pA0, pA1, t, false, skA, svA, skB, svB);     ENDSTEP();
        STEP(pA0, pA1, pB0, pB1, t + 1, false, skB, svB, skA, svA); ENDSTEP();
    }
#pragma unroll 1
    for (; t + 1 < NT; t += 2) {
        STEP(pB0, pB1, pA0, pA1, t, true, skA, svA, skB, svB);      ENDSTEP();
        STEP(pA0, pA1, pB0, pB1, t + 1, true, skB, svB, skA, svA);  ENDSTEP();
    }
    STEP(pB0, pB1, pA0, pA1, NT - 1, true, skA, svA, skB, svB); __syncthreads(); RESC();
    {
      pw0 = (u32x4){PKW(pB0, 0), PKW(pB0, 2), PKW(pB0, 4), PKW(pB0, 6)}; pw1 = (u32x4){PKW(pB0, 8), PKW(pB0, 10), PKW(pB0, 12), PKW(pB0, 14)};
      pw2 = (u32x4){PKW(pB1, 0), PKW(pB1, 2), PKW(pB1, 4), PKW(pB1, 6)}; pw3 = (u32x4){PKW(pB1, 8), PKW(pB1, 10), PKW(pB1, 12), PKW(pB1, 14)};
      OSUM(0); OSUM(1); OSUM(2); OSUM(3);
      SBAR();
      att::pv(o, (int)(unsigned)(uintptr_t)(lds + T_V) + ((lane >> 4) & 1) * 32 + (lane & 3) * 8 + (4 * hi + ((lane & 15) >> 2)) * 64 + sl_cur, PAF(0), PAF(1), PAF(2), PAF(3)); }
    asm volatile("s_nop 7\n\ts_nop 7" : "+v"(o2));
#pragma unroll
    for (int r = 0; r < 16; ++r) { const float l0_ = __shfl(o2[r], 0), l1_ = __shfl(o2[r], 32); const float rl = __builtin_amdgcn_rcpf(hi ? l1_ : l0_); o[0][r] *= rl; o[1][r] *= rl; }
    __syncthreads();
#undef PT
#undef LOADK
#undef LOADV
#undef STOREK
#undef STOREV
#undef LOADKR
#undef LOADVR
#undef STOREKR
#undef STOREVR
#undef KLOAD2
#undef CMASKT
#undef PKW
#undef PAF
#undef VFR
#undef PIN
#undef MX3
#undef GAPA
#undef OSUM
#undef EX
#undef GAPB
#undef VRD
#undef KRD
#undef NOMF
#undef STEP
#undef RESC
#undef ROT
#undef ENDSTEP
}
#undef SBAR
}

namespace hg {
typedef short bf16x8 __attribute__((ext_vector_type(8)));
typedef short s16x4 __attribute__((ext_vector_type(4)));
typedef float f32x16 __attribute__((ext_vector_type(16)));
constexpr int NCK = LSEQ / 64, NITEM = 8 * NCK;
constexpr int RS = 272;
__device__ __forceinline__ bf16x8 trfrag(unsigned addr) {
    s16x4 lo, hi;
    asm volatile("ds_read_b64_tr_b16 %0,%2\n\tds_read_b64_tr_b16 %1,%2 offset:512\n\ts_waitcnt lgkmcnt(0)" : "=&v"(lo), "=&v"(hi) : "v"(addr) : "memory");
    return (bf16x8){lo[0], lo[1], lo[2], lo[3], hi[0], hi[1], hi[2], hi[3]};
}
constexpr int A_SEG = 0, A_KH = 2048, A_VH = A_KH + 16384, A_ST = A_VH + 16384;
constexpr int C_SEG = 0, C_QS = 4096, C_QA = C_QS + 64 * RS, C_KA = C_QA + 64 * RS, C_VH = C_KA + 64 * RS, C_S = C_VH + 16384, C_OUT = C_QS, C_END = C_S + 128 * RS;
static_assert(C_END <= 131072 && 64 * 128 * 4 <= 2 * 64 * RS, "hg3 LDS map");
}
__device__ __forceinline__ void hg1_item(const Frame& F, int item) {
    using namespace hg;
    const int bh = item / NCK, ck = item % NCK, b = bh >> 2, h = bh & 3;
    const size_t m0 = (size_t)b * LSEQ + 64 * ck;
    const int tid = F.tid, seg = tid >> 7, c = tid & 127, wid = F.wave, lane = F.lane, r32 = lane & 31, hi = lane >> 5;
    const float* LF = WSP(float, WS_HLF) + m0 * 512 + 128 * h; const bf16* KK = WSP(bf16, WS_HK) + m0 * 512 + 128 * h; const bf16* VV = WSP(bf16, WS_HV) + m0 * 512 + 128 * h;
    LAS float* segtot = (LAS float*)(F.lds + A_SEG);
#pragma unroll
    for (int i = 0; i < 2; ++i) { const int p = tid + 512 * i, row = p >> 4, j = p & 15;
        *(LAS u32x4*)(F.lds + A_VH + (j >> 2) * 4096 + row * 64 + (j & 3) * 16) = *(const u32x4*)(VV + (size_t)row * 512 + j * 8); }
    float g[16]; bf16 kraw[16];
#pragma unroll
    for (int i = 0; i < 16; ++i) { g[i] = LF[(size_t)(16 * seg + i) * 512 + c]; kraw[i] = KK[(size_t)(16 * seg + i) * 512 + c]; }
    float run = 0.f;
#pragma unroll
    for (int i = 0; i < 16; ++i) { run += g[i]; g[i] = run; }
    segtot[seg * 128 + c] = run;
    __syncthreads();
    float off = 0.f, tot = 0.f;
#pragma unroll
    for (int q = 0; q < 4; ++q) { const float v = segtot[q * 128 + c]; tot += v; if (q < seg) off += v; }
#pragma unroll
    for (int i = 0; i < 16; ++i) { const int s_ = 16 * seg + i; const float e = __expf(tot - (g[i] + off));
        *(LAS bf16*)(F.lds + A_KH + (c >> 5) * 4096 + s_ * 64 + (c & 31) * 2) = (bf16)f2bf(bf2f(kraw[i]) * e); }
    if (seg == 0) st_wt(WSP(float, WS_DEC), WSP(float, WS_DEC) + (size_t)item * 128 + c, __expf(tot));
    __syncthreads();
    const unsigned tb = (unsigned)(uintptr_t)F.lds + ((lane >> 4) & 1) * 32 + (lane & 3) * 8 + (4 * hi + ((lane & 15) >> 2)) * 64;
    const int vblk = wid >> 1;
    bf16x8 af[4];
#pragma unroll
    for (int ks = 0; ks < 4; ++ks) af[ks] = trfrag(tb + A_VH + vblk * 4096 + ks * 1024);
    LAS bf16* stg = (LAS bf16*)(F.lds + A_ST);
#pragma unroll
    for (int cc = 0; cc < 2; ++cc) { const int cblk = (wid & 1) * 2 + cc; f32x16 acc = f32x16{};
#pragma unroll
        for (int ks = 0; ks < 4; ++ks) acc = __builtin_amdgcn_mfma_f32_32x32x16_bf16(af[ks], trfrag(tb + A_KH + cblk * 4096 + ks * 1024), acc, 0, 0, 0);
#pragma unroll
        for (int r = 0; r < 16; ++r) stg[(32 * vblk + att::crow(r, hi)) * 128 + 32 * cblk + r32] = (bf16)f2bf(acc[r]); }
    __syncthreads();
    bf16* UT = WSP(bf16, WS_UT) + (size_t)item * 16384;
#pragma unroll
    for (int i = 0; i < 4; ++i) { const int p = tid + 512 * i; st_wt(WSP(bf16, WS_UT), UT + p * 8, *(const LAS u32x4*)(F.lds + A_ST + p * 16)); }
    asm volatile("s_waitcnt vmcnt(0)" ::: "memory");
    __syncthreads();
}
__device__ __forceinline__ void hg2_item(const Frame& F, int item) {
    using namespace hg;
    const bf16* UT = WSP(bf16, WS_UT); bf16* ST = WSP(bf16, WS_ST); const float* DEC = WSP(float, WS_DEC);
    const int gid = item * 512 + F.tid;
    const int bh = gid >> 14, idx = gid & 16383, c = idx & 127;
    float S = 0.f;
    const size_t base = (size_t)bh * NCK * 16384 + idx; const float* dp = DEC + (size_t)bh * NCK * 128 + c;
#pragma unroll 1
    for (int j0 = 0; j0 < NCK; j0 += 65) {
        bf16 u[65]; float d[65];
#pragma unroll
        for (int j = 0; j < 65; ++j) { u[j] = UT[base + (size_t)(j0 + j) * 16384]; d[j] = dp[(j0 + j) * 128]; }
#pragma unroll
        for (int j = 0; j < 65; ++j) { st_wt(ST, ST + base + (size_t)(j0 + j) * 16384, (unsigned short)f2bf(S)); S = d[j] * S + bf2f(u[j]); }
    }
    asm volatile("s_waitcnt vmcnt(0)" ::: "memory");
    __syncthreads();
}
__device__ __forceinline__ void hand_post(const Frame& F, unsigned* c) { if (F.tid == 0) (void)__hip_atomic_fetch_add(c, 1u, __ATOMIC_RELAXED, __HIP_MEMORY_SCOPE_AGENT); }
__device__ __forceinline__ void hand_wait(const Frame& F, unsigned* c, unsigned target) {
    if (F.tid == 0) { unsigned sp = 0u; unsigned* tmo = WSP(unsigned, WS_CTL) + CW_BAR + XB_TMO;
        while (__hip_atomic_load(c, __ATOMIC_RELAXED, __HIP_MEMORY_SCOPE_AGENT) < target) { __builtin_amdgcn_s_sleep(2);
            if ((++sp & 255u) == 0u) { if (xb_ld(tmo)) break; if (sp > (1u << 22)) { atomicAdd(tmo, 1u); break; } } }
        __builtin_amdgcn_fence(__ATOMIC_ACQUIRE, "agent");
        asm volatile("s_waitcnt vmcnt(0)" ::: "memory"); }
    __syncthreads();
}
__device__ __forceinline__ void hg3_item(const Frame& F, int layer, int item, bool prod = false  ) {
    using namespace hg;
    const int bh = item / NCK, ck = item % NCK, b = bh >> 2, h = bh & 3;
    const size_t m0 = (size_t)b * LSEQ + 64 * ck;
    const int tid = F.tid, seg = tid >> 7, c = tid & 127, wid = F.wave, lane = F.lane, r32 = lane & 31, hi = lane >> 5;
    const float* LF = WSP(float, WS_HLF) + m0 * 512 + 128 * h; const bf16* KK = WSP(bf16, WS_HK) + m0 * 512 + 128 * h; const bf16* VV = WSP(bf16, WS_HV) + m0 * 512 + 128 * h;
    const bf16* QQ = WSP(bf16, WS_HQ) + m0 * 512 + 128 * h; const bf16* SG = WSP(bf16, WS_ST) + (size_t)item * 16384;
    LAS float* segtot = (LAS float*)(F.lds + C_SEG);
#pragma unroll
    for (int i = 0; i < 2; ++i) { const int p = tid + 512 * i, row = p >> 4, j = p & 15;
        *(LAS u32x4*)(F.lds + C_VH + (j >> 2) * 4096 + row * 64 + (j & 3) * 16) = *(const u32x4*)(VV + (size_t)row * 512 + j * 8); }
#pragma unroll
    for (int i = 0; i < 4; ++i) { const int p = tid + 512 * i, v = p >> 4, j = p & 15;
        *(LAS u32x4*)(F.lds + C_S + v * RS + j * 16) = *(const u32x4*)(SG + p * 8); }
    float g[16]; bf16 qraw[16], kraw[16];
#pragma unroll
    for (int i = 0; i < 16; ++i) { const size_t o_ = (size_t)(16 * seg + i) * 512 + c; g[i] = LF[o_]; qraw[i] = QQ[o_]; kraw[i] = KK[o_]; }
    const bf16* gp_ = WSP(bf16, WS_HG) + (m0 + (tid >> 3)) * 512 + 128 * h + (tid & 7) * 16;
    const u32x4 ga = *(const u32x4*)gp_, gb = *(const u32x4*)(gp_ + 8);
    float run = 0.f;
#pragma unroll
    for (int i = 0; i < 16; ++i) { run += g[i]; g[i] = run; }
    segtot[seg * 128 + c] = run;
    __syncthreads();
    const float t0_ = segtot[c], t1_ = segtot[128 + c], t2_ = segtot[256 + c];
    const float off = (seg > 0 ? t0_ : 0.f) + (seg > 1 ? t1_ : 0.f) + (seg > 2 ? t2_ : 0.f), R = t0_ + t1_;
#pragma unroll
    for (int i = 0; i < 16; ++i) { const int t = 16 * seg + i; const float G = g[i] + off;
        const float q = bf2f(qraw[i]), kk = bf2f(kraw[i]);
        *(LAS bf16*)(F.lds + C_QS + t * RS + c * 2) = (bf16)f2bf(q * __expf(G));
        *(LAS bf16*)(F.lds + C_QA + t * RS + c * 2) = (bf16)f2bf(q * __expf(G - R));
        *(LAS bf16*)(F.lds + C_KA + t * RS + c * 2) = (bf16)f2bf(kk * __expf(R - G)); }
    __syncthreads();
    const int tbk = wid >> 2, vb = wid & 3;
    f32x16 o = f32x16{};
    { const LAS unsigned char* qa = F.lds + C_QS + (32 * tbk + r32) * RS + hi * 16; const LAS unsigned char* sa = F.lds + C_S + (32 * vb + r32) * RS + hi * 16;
#pragma unroll
      for (int kk = 0; kk < 8; ++kk) o = __builtin_amdgcn_mfma_f32_32x32x16_bf16(*(const LAS bf16x8*)(qa + kk * 32), *(const LAS bf16x8*)(sa + kk * 32), o, 0, 0, 0); }
    const unsigned tb = (unsigned)(uintptr_t)F.lds + ((lane >> 4) & 1) * 32 + (lane & 3) * 8 + (4 * hi + ((lane & 15) >> 2)) * 64;
#pragma unroll
    for (int sb = 0; sb < 2; ++sb) {
        if (sb <= tbk) {
            f32x16 p = f32x16{};
            const LAS unsigned char* ka = F.lds + C_KA + (32 * sb + r32) * RS + hi * 16; const LAS unsigned char* qq = F.lds + C_QA + (32 * tbk + r32) * RS + hi * 16;
#pragma unroll
            for (int kk = 0; kk < 8; ++kk) p = __builtin_amdgcn_mfma_f32_32x32x16_bf16(*(const LAS bf16x8*)(ka + kk * 32), *(const LAS bf16x8*)(qq + kk * 32), p, 0, 0, 0);
            if (sb == tbk) {
#pragma unroll
                for (int r = 0; r < 16; ++r) if (att::crow(r, hi) > r32) p[r] = 0.f; }
            const u32x4 pw0 = (u32x4){att::cvtpk_s(p[0], p[1]), att::cvtpk_s(p[2], p[3]), att::cvtpk_s(p[4], p[5]), att::cvtpk_s(p[6], p[7])};
            const u32x4 pw1 = (u32x4){att::cvtpk_s(p[8], p[9]), att::cvtpk_s(p[10], p[11]), att::cvtpk_s(p[12], p[13]), att::cvtpk_s(p[14], p[15])};
            o = __builtin_amdgcn_mfma_f32_32x32x16_bf16(__builtin_bit_cast(bf16x8, pw0), trfrag(tb + C_VH + vb * 4096 + (2 * sb) * 1024), o, 0, 0, 0);
            o = __builtin_amdgcn_mfma_f32_32x32x16_bf16(__builtin_bit_cast(bf16x8, pw1), trfrag(tb + C_VH + vb * 4096 + (2 * sb + 1) * 1024), o, 0, 0, 0);
        }
    }
    __syncthreads();
    LAS float* ost = (LAS float*)(F.lds + C_OUT);
#pragma unroll
    for (int r = 0; r < 16; ++r) ost[(32 * tbk + att::crow(r, hi)) * 128 + 32 * vb + r32] = o[r];
    __syncthreads();
    { const int row = tid >> 3, s8 = tid & 7; float x[16];
#pragma unroll
      for (int q = 0; q < 4; ++q) { const f32x4 w = *(const LAS f32x4*)(ost + row * 128 + s8 * 16 + 4 * q); x[4 * q] = w.x; x[4 * q + 1] = w.y; x[4 * q + 2] = w.z; x[4 * q + 3] = w.w; }
      float ss = 0.f;
#pragma unroll
      for (int e = 0; e < 16; ++e) ss += x[e] * x[e];
      ss += __shfl_xor(ss, 1); ss += __shfl_xor(ss, 2); ss += __shfl_xor(ss, 4);
      const float rn = rsqrtf(ss * (1.f / 128.f) + EPS);
      const float* gn = F.in[5] + layer * 128 + s8 * 16;
      const float gt[16] = {bflo(ga.x), bfhi(ga.x), bflo(ga.y), bfhi(ga.y), bflo(ga.z), bfhi(ga.z), bflo(ga.w), bfhi(ga.w), bflo(gb.x), bfhi(gb.x), bflo(gb.y), bfhi(gb.y), bflo(gb.z), bfhi(gb.z), bflo(gb.w), bfhi(gb.w)};
      float y0[8], y1[8];
#pragma unroll
      for (int e = 0; e < 8; ++e) { y0[e] = x[e] * rn * gn[e] * gt[e]; y1[e] = x[8 + e] * rn * gn[8 + e] * gt[8 + e]; }
      bf16* mp = WSP(bf16, WS_MIX) + (m0 + row) * DM + 128 * h + s8 * 16;
      if (prod) { st_wt(WSP(bf16, WS_MIX), mp, pack8(y0)); st_wt(WSP(bf16, WS_MIX), mp + 8, pack8(y1)); asm volatile("s_waitcnt vmcnt(0)" ::: "memory"); }
      else { *(u32x4*)mp = pack8(y0); *(u32x4*)(mp + 8) = pack8(y1); } }
    __syncthreads();
}

__device__ __forceinline__ void attn_queue(const Frame& F, int layer) {
    using namespace att;
    const int lane0 = F.lane;
    unsigned* QC = WSP(unsigned, WS_CTL) + CW_QATT + 64 * layer;
    volatile LAS int* sItem = (volatile LAS int*)(F.lds + L_ITEM);
    const float* lv = F.in[6] + layer * 128;
    const float lam_init = 0.8f - 0.6f * expf(-0.3f * (float)layer);
    float lam; { float a = lane0 < 32 ? lv[lane0] * lv[32 + lane0] : 0.f, c = lane0 < 32 ? lv[64 + lane0] * lv[96 + lane0] : 0.f; a = wave_sum(a); c = wave_sum(c); lam = expf(a) - expf(c) + lam_init; }
    constexpr int NH1 = hg::NITEM, NATT = 768, NH2 = 256, NSERV = 64;
    unsigned* HC = WSP(unsigned, WS_CTL) + CW_HG + 64 * layer; unsigned* QS = QC + 32;
#define QCLAIM(q, dst) do { if (F.tid == 0) *sItem = (int)__hip_atomic_fetch_add(q, 1u, __ATOMIC_RELAXED, __HIP_MEMORY_SCOPE_AGENT); __syncthreads(); dst = *sItem; __syncthreads(); } while (0)
    if (F.blk < NSERV) {
        int s_; QCLAIM(QS, s_);
        unsigned seen1 = 0u, seen2 = 0u;
#pragma unroll 1
        while (s_ < NH1 / 8) {
#pragma unroll 1
            for (int k = 0; k < 8; ++k) { hg1_item(F, 8 * s_ + k); hand_post(F, HC + (8 * s_ + k) / hg::NCK); }
            QCLAIM(QS, s_); }
#pragma unroll 1
        while (s_ < NH1 / 8 + NH2) { const int i2 = s_ - NH1 / 8, bh2 = i2 >> 5;
            if (!((seen1 >> bh2) & 1u)) { hand_wait(F, HC + bh2, (unsigned)hg::NCK); seen1 |= 1u << bh2; }
            hg2_item(F, i2); hand_post(F, HC + 16 + bh2); QCLAIM(QS, s_); }
#pragma unroll 1
        while (s_ < NH1 / 8 + NH2 + NH1 / 4) {
#pragma unroll 1
            for (int k = 0; k < 4; ++k) { const int i3 = 4 * (s_ - NH1 / 8 - NH2) + k, bh3 = i3 / hg::NCK;
                if (!((seen2 >> bh3) & 1u)) { hand_wait(F, HC + 16 + bh3, 32u); seen2 |= 1u << bh3; }
                const bool prod3 = bh3 >= 4 && (i3 - bh3 * hg::NCK) >= hg::NCK - 4;
                hg3_item(F, layer, i3, prod3); if (prod3) hand_post(F, HC + 32); }
            QCLAIM(QS, s_); }
        const int c0 = NH1 / 8 + NH2 + NH1 / 4;
        { const int a0 = layer == 0 ? 9500 : 12000, nA = NW13 - a0, nT = nA + (layer == 0 ? 0 : 3000); LAS float* scr = (LAS float*)(F.lds + F.wave * 16384);
#pragma unroll 1
          while (s_ < c0 + (nT + 15) / 16) {
#pragma unroll 1
              for (int k = 0; k < 2; ++k) { const int idx = 16 * (s_ - c0) + 8 * k + F.wave;
                  if (idx < nA) cvt_w13_item(F, layer, a0 + idx, scr, F.lane); else if (idx < nT) cvt_w2_item(F, layer, idx - nA, scr, F.lane); }
              __syncthreads();
              QCLAIM(QS, s_); }
          const int c1 = c0 + (nT + 15) / 16;
#pragma unroll 1
          while (s_ < c1 + 4) { hand_wait(F, HC + 32, 28u); gemm2_unit(F, layer, G2_PANELS, s_ - c1); __syncthreads(); QCLAIM(QS, s_); } }
    }
    int qit; QCLAIM(QC, qit);
    for (;;) {
        if (qit >= NATT) break;
        const int it = qit;
        Frame Fi = F; asm volatile("" : "+v"(Fi.lane), "+v"(Fi.tid)); asm volatile("" : "+s"(Fi.ws), "+s"(Fi.wave));
        const int wid = Fi.wave, lane = Fi.lane; GAS bf16* MIX = (GAS bf16*)(Fi.ws + WS_MIX);
#define F Fi
        const int lvl = it / 24, r = it % 24, qb = 31 - lvl, bh = r & 7, b = bh >> 2, h = bh & 3;
        const size_t rb = (size_t)b * LSEQ;
        const int ch = lane & 7;
        if (r < 8) {
            const size_t row0 = rb + 128 + 256 * qb; const bool prodA = b == 1 && qb == 31;
            f32x16 o[2];
            attn_map<false>(F.lds, WSG(bf16, WS_FQ) + (row0 + wid * 32 + (lane & 31)) * 256 + 64 * h, WSG(bf16, WS_FK) + rb * 256 + 64 * h, WSG(bf16, WS_FV) + rb * 256 + 64 * h,
                            WSG(bf16, WS_KXF) + (size_t)bh * LSEQ * 8, 4 * qb + 5, wid, lane, o);
            stage_o(F.lds + L_OA, wid, lane, o);
            const LAS bf16* stg = (const LAS bf16*)(F.lds + L_OA) + wid * 2048; const float* gn = F.in[9] + layer * 64 + ch * 8;
#pragma unroll
            for (int i = 0; i < 4; ++i) { const int row = i * 8 + (lane >> 3); const u32x4 w = *(const LAS u32x4*)(stg + row * 64 + ch * 8);
                float x[8] = {bflo(w.x), bfhi(w.x), bflo(w.y), bfhi(w.y), bflo(w.z), bfhi(w.z), bflo(w.w), bfhi(w.w)};
                float ss = 0.f;
#pragma unroll
                for (int e = 0; e < 8; ++e) ss += x[e] * x[e];
                ss += __shfl_xor(ss, 1); ss += __shfl_xor(ss, 2); ss += __shfl_xor(ss, 4);
                const float rn = rsqrtf(ss * (1.f / 64.f) + EPS);
#pragma unroll
                for (int e = 0; e < 8; ++e) x[e] *= rn * gn[e];
                if (prodA) st_wt((const void*)MIX, (const void*)(MIX + (row0 + wid * 32 + row) * DM + 768 + 64 * h + ch * 8), pack8(x)); else *(GAS u32x4*)(MIX + (row0 + wid * 32 + row) * DM + 768 + 64 * h + ch * 8) = pack8(x); }
            if (prodA) { asm volatile("s_waitcnt vmcnt(0)" ::: "memory"); __syncthreads(); hand_post(F, HC + 32); }
        } else {
            const int qd = 2 * qb + (r < 16 ? 1 : 0); const size_t row0 = rb + 128 + 128 * qd; const bool prodB = b == 1 && qd >= 62;
            f32x16 o[2];
            att2::diff_unit(F.lds, WSG(bf16, WS_DQ) + (row0 + (wid & 3) * 32 + (lane & 31)) * 256 + 32 * (2 * h + (wid >> 2)), WSG(bf16, WS_DK) + rb * 256 + 64 * h, WSG(bf16, WS_DV) + rb * 256 + 64 * h,
                            2 * qd + 4, wid, lane, o);
            stage_o(F.lds + (wid < 4 ? att2::T_OA : att2::T_OB), wid & 3, lane, o);
            __syncthreads();
            const LAS bf16* sa = (const LAS bf16*)(F.lds + att2::T_OA); const LAS bf16* sb = (const LAS bf16*)(F.lds + att2::T_OB); const float* gn = F.in[7] + layer * 64 + ch * 8;
#pragma unroll
            for (int i = 0; i < 2; ++i) { const int row = wid * 16 + i * 8 + (lane >> 3); const u32x4 wa = *(const LAS u32x4*)(sa + row * 64 + ch * 8), wb = *(const LAS u32x4*)(sb + row * 64 + ch * 8);
                float x[8] = {bflo(wa.x) - lam * bflo(wb.x), bfhi(wa.x) - lam * bfhi(wb.x), bflo(wa.y) - lam * bflo(wb.y), bfhi(wa.y) - lam * bfhi(wb.y),
                              bflo(wa.z) - lam * bflo(wb.z), bfhi(wa.z) - lam * bfhi(wb.z), bflo(wa.w) - lam * bflo(wb.w), bfhi(wa.w) - lam * bfhi(wb.w)};
                float ss = 0.f;
#pragma unroll
                for (int e = 0; e < 8; ++e) ss += x[e] * x[e];
                ss += __shfl_xor(ss, 1); ss += __shfl_xor(ss, 2); ss += __shfl_xor(ss, 4);
                const float rn = rsqrtf(ss * (1.f / 64.f) + EPS) * (1.f - lam_init);
#pragma unroll
                for (int e = 0; e < 8; ++e) x[e] *= rn * gn[e];
                if (prodB) st_wt((const void*)MIX, (const void*)(MIX + (row0 + row) * DM + 512 + 64 * h + ch * 8), pack8(x)); else *(GAS u32x4*)(MIX + (row0 + row) * DM + 512 + 64 * h + ch * 8) = pack8(x); }
            if (prodB) asm volatile("s_waitcnt vmcnt(0)" ::: "memory");
            __syncthreads();
            if (prodB) hand_post(F, HC + 32);
        }
#undef F
        QCLAIM(QC, qit);
    }
#undef QCLAIM
}

__global__ void __launch_bounds__(512, 2) mega(Args args) {
    extern __shared__ __attribute__((aligned(16))) unsigned char lds[];
    Frame F;
    F.lds = (LAS unsigned char*)lds; F.ws = args.ws; F.out = args.out; F.in = args.in;
    F.tid = threadIdx.x; F.lane = F.tid & 63; F.wave = __builtin_amdgcn_readfirstlane(F.tid >> 6); F.G = gridDim.x; F.blk = blockIdx.x;
    volatile LAS unsigned* MISC = (volatile LAS unsigned*)(F.lds + MISC_OFF);
    if (F.tid < 32) MISC[F.tid] = 0u;
    __syncthreads();
    unsigned* ctl = (unsigned*)(args.ws + WS_CTL);
    XcdBarrier bar; bar.bar = ctl + CW_BAR; bar.x = 0; bar.st = nullptr;
    if (MK_ONE_LAUNCH) bar = xcd_barrier_post(ctl + CW_BAR, MISC + 8);
    const int lo = args.ph_lo, hi = args.ph_hi;
#define IN(k) (lo <= (k) && (k) < hi)
#define SEAM(k) do { if (MK_ONE_LAUNCH && IN((k) + 1)) xcd_barrier(bar); } while (0)

    if (IN(0)) { prologue_tables(F); convert_static_weights(F); __syncthreads(); norm_phase<0>(F, 0); SEAM(0); }
#define LAYER_BODY(layer) do { \
        const int pb = 1 + 9 * (layer); \
        if (IN(pb + 0)) { if (F.blk == F.G - 1) fd_scan(F); GEMM1(F, layer); if ((layer) == 0) tail_convert(F, 0, 0, 0, 9500, 910, true); else tail_convert(F, 0, 1, 3000, 12000, 910, true); SEAM(pb + 0); } \
          \
        if (IN(pb + 3)) { attn_naive(F, layer, F.blk, F.G, 2); attn_queue(F, layer); SEAM(pb + 3); } \
        if (IN(pb + 4)) { GEMM2(F, layer); SEAM(pb + 4); }        \
        if (IN(pb + 5)) { norm2_route(F, layer); SEAM(pb + 5); } \
        if (IN(pb + 6)) { MOEUP(F, layer); tail_convert(F, 1, layer, (layer) == 0 ? 0 : 3000, NW2, ((const LAS int*)(F.lds + 131072))[NEXP] * 4); SEAM(pb + 6); } \
        if (IN(pb + 7)) { MOEDOWN(F, layer); if ((layer) == 0) tail_convert(F, 0, 1, 0, 3000, ((const LAS int*)(F.lds + 131072))[NEXP] * 4); SEAM(pb + 7); } \
        if (IN(pb + 8)) { if (layer == 0) norm_phase<1>(F, 1); else norm_phase<2>(F, 0); SEAM(pb + 8); } \
    } while (0)
    LAYER_BODY(0);
    LAYER_BODY(1);
#undef LAYER_BODY
#undef IN
#undef SEAM
}

extern "C" void kernel_launch(void* const* d_in, const int* in_sizes, int n_in, void* d_out, int out_size, void* d_ws, size_t ws_size, hipStream_t stream) {
    static int grid = 0;
    if (grid == 0) {
        if (n_in != 20 || out_size != BATCH * SEQ * DM || ws_size < WS_END) { fprintf(stderr, "kernel_launch: unexpected problem (n_in %d out %d ws %zu)\n", n_in, out_size, ws_size); grid = -1; return; }
        int dev = 0, cus = 0;
        if (hipGetDevice(&dev) != hipSuccess || hipDeviceGetAttribute(&cus, hipDeviceAttributeMultiprocessorCount, dev) != hipSuccess) { grid = -1; return; }
        if (hipFuncSetAttribute((const void*)mega, hipFuncAttributeMaxDynamicSharedMemorySize, LDS_BYTES) != hipSuccess) { fprintf(stderr, "kernel_launch: hipFuncSetAttribute failed\n"); grid = -1; return; }
        int per_cu = 0;
        if (hipOccupancyMaxActiveBlocksPerMultiprocessor(&per_cu, (const void*)mega, 512, LDS_BYTES) != hipSuccess || per_cu < 1) { fprintf(stderr, "kernel_launch: occupancy query says %d\n", per_cu); }
        (void)hipGetLastError();
        grid = cus;
    }
    if (grid < 0) return;
    (void)hipMemsetAsync((char*)d_ws + WS_CTL, 0, CTL_ZERO_BYTES, stream);
    Args a{};
    for (int i = 0; i < 20; ++i) a.in[i] = (const float*)d_in[i];
    a.out = (float*)d_out; a.ws = (unsigned char*)d_ws;
#if MK_ONE_LAUNCH
    a.ph_lo = 0; a.ph_hi = NPH;
    hipLaunchKernelGGL(mega, dim3(grid), dim3(512), LDS_BYTES, stream, a);
#else
    for (int p = 0; p < NPH; ++p) { a.ph_lo = p; a.ph_hi = p + 1; hipLaunchKernelGGL(mega, dim3(grid), dim3(512), LDS_BYTES, stream, a); }
#endif
}
```

```cpp
#include <hip/hip_runtime.h>
#include <cstdio>
#include <cstdint>

#define GAS __attribute__((address_space(1)))
#define LAS __attribute__((address_space(3)))
typedef unsigned short bf16;
typedef float f32x4 __attribute__((ext_vector_type(4)));
typedef float f32x2 __attribute__((ext_vector_type(2)));
typedef unsigned u32x4 __attribute__((ext_vector_type(4)));
typedef unsigned u32x2 __attribute__((ext_vector_type(2)));

__device__ __forceinline__ __amdgpu_buffer_rsrc_t wt_rsrc(const void* base) { return __builtin_amdgcn_make_buffer_rsrc((void*)base, (short)0, 0x7FFFFFFF, 0x00020000); }
__device__ __forceinline__ void st_wt(const void* base, const void* p, u32x4 v) { __builtin_amdgcn_raw_buffer_store_b128(v, wt_rsrc(base), (int)((const char*)p - (const char*)base), 0, 16); }
__device__ __forceinline__ void st_wt(const void* base, const void* p, float v) { __builtin_amdgcn_raw_buffer_store_b32(__builtin_bit_cast(unsigned, v), wt_rsrc(base), (int)((const char*)p - (const char*)base), 0, 16); }
__device__ __forceinline__ void st_wt(const void* base, const void* p, unsigned short v) { __builtin_amdgcn_raw_buffer_store_b16(v, wt_rsrc(base), (int)((const char*)p - (const char*)base), 0, 16); }

#ifndef MK_NAIVE_GEMM
#define MK_NAIVE_GEMM 0
#endif
#if MK_NAIVE_GEMM
#define GEMM1 gemm1_naive
#define GEMM2 gemm2_naive
#define MOEUP moe_up_naive
#define MOEDOWN moe_down_naive
#else
#define GEMM1 gemm1_mfma
#define GEMM2 gemm2_mfma
#define MOEUP moe_up_mfma
#define MOEDOWN moe_down_mfma
#endif
#ifndef MK_FORCE_TRACK
#define MK_FORCE_TRACK 0
#endif
#ifndef MK_NAIVE_ATTN
#define MK_NAIVE_ATTN 0
#endif
#if MK_NAIVE_ATTN
#define ATTN(F, layer) attn_naive(F, layer, F.blk - 2, F.G - 2, LSEQ / 64)
#else
#define ATTN(F, layer) do { attn_naive(F, layer, F.blk - 2, F.G - 2, 2); attn_queue(F, layer); } while (0)
#endif
#ifndef MK_ONE_LAUNCH
#define MK_ONE_LAUNCH 1
#endif

constexpr int BATCH = 2, SEQ = 8192, DM = 1024, LSEQ = 8320, PADR = 112, M = BATCH * LSEQ;
constexpr int INW = 3588, NEXP = 32, DE = 512, MAXSLOT = 41472;
constexpr float EPS = 1e-6f, LOG2E = 1.4426950408889634f, TINYF = 1e-30f;
constexpr int NPH = 19;

constexpr size_t MiB = 1u << 20;
constexpr size_t WS_CTL = 0, CTL_ZERO_BYTES = 1 * MiB;
constexpr size_t WS_COS = 1 * MiB, WS_SIN = 2 * MiB, WS_LBV = 3 * MiB;
constexpr size_t WS_FLS = 4 * MiB, WS_FD2 = 4 * MiB + 512 * 1024;
constexpr size_t WS_TOKE = 5 * MiB, WS_TOKG = WS_TOKE + 160 * 1024, WS_TOKR = WS_TOKG + 160 * 1024, WS_TOKS = WS_TOKR + 160 * 1024, WS_SGATE = WS_TOKS + 160 * 1024;
constexpr size_t WS_H = 6 * MiB;
constexpr size_t WS_XN = 71 * MiB;
constexpr size_t WS_MIX = WS_XN;
constexpr size_t WS_R = 104 * MiB;
constexpr size_t SZ512 = (size_t)M * 512 * 2, SZ256 = (size_t)M * 256 * 2;
constexpr size_t WS_HQ = WS_R, WS_HLF = WS_HQ + SZ512, WS_HK = WS_HLF + 2 * SZ512, WS_HV = WS_HK + SZ512, WS_HG = WS_HV + SZ512;
constexpr size_t WS_DQ = WS_HG + SZ512, WS_DK = WS_DQ + SZ256, WS_DV = WS_DK + SZ256, WS_FQ = WS_DV + SZ256, WS_FK = WS_FQ + SZ256, WS_FV = WS_FK + SZ256;
constexpr size_t WS_PROJ_END = WS_FV + SZ256;
constexpr size_t WS_ORAW = 251 * MiB;
constexpr size_t WS_XG = WS_R, WS_HB = WS_XG + (size_t)MAXSLOT * 1024 * 2, WS_Y = WS_HB + (size_t)MAXSLOT * 512 * 2, WS_MOE_END = WS_Y + (size_t)MAXSLOT * 1024 * 2;
constexpr size_t WS_REND = 316 * MiB;
constexpr size_t WS_WIN = 316 * MiB;
constexpr size_t WS_WOUT = 330 * MiB;
constexpr size_t WS_W13 = 334 * MiB;
constexpr size_t WS_W2 = 398 * MiB;
constexpr size_t WS_KXF = 462 * MiB, WS_KXD = 463 * MiB + 512 * 1024;
constexpr size_t WS_DEC = 464 * MiB;
constexpr size_t WS_UT = WS_ORAW, WS_ST = WS_ORAW + (size_t)1040 * 16384 * 2;
constexpr size_t WS_WRT = 465 * MiB;
constexpr size_t WS_WF = 465 * MiB + 512 * 1024;
constexpr size_t WS_LIST = 466 * MiB, WS_GLIST = 469 * MiB;
constexpr size_t WS_END = 472 * MiB;
static_assert(WS_PROJ_END <= WS_ORAW && WS_ORAW + (size_t)M * 512 * 4 <= WS_REND && WS_MOE_END <= WS_REND, "ws map");
static_assert(WS_SGATE + MAXSLOT * 4 <= WS_H, "ws map small");

constexpr int CW_TMO = 0, CW_BAR = 4096, CW_CNT = 8192, CW_QATT = 8448, CW_HG = 8704;

constexpr int LDS_BYTES = 147456;
constexpr int MISC_OFF = 131072 + 320;

__device__ __forceinline__ unsigned f2bf(float f) { unsigned u = __builtin_bit_cast(unsigned, f); return (u + 0x7fffu + ((u >> 16) & 1u)) >> 16; }
__device__ __forceinline__ unsigned pk2(float lo, float hi) { return f2bf(lo) | (f2bf(hi) << 16); }
__device__ __forceinline__ float bf2f(unsigned h) { return __builtin_bit_cast(float, h << 16); }
__device__ __forceinline__ float bflo(unsigned w) { return __builtin_bit_cast(float, w << 16); }
__device__ __forceinline__ float bfhi(unsigned w) { return __builtin_bit_cast(float, w & 0xffff0000u); }
__device__ __forceinline__ float wave_sum(float v) {
#pragma unroll
    for (int o = 1; o < 64; o <<= 1) v += __shfl_xor(v, o);
    return v;
}
__device__ __forceinline__ float sigmoidf_(float x) { return 1.f / (1.f + __expf(-x)); }
__device__ __forceinline__ float siluf_(float x) { return x / (1.f + __expf(-x)); }

#define XB_TMO      128
#define XB_XCNT(j)  (256  + 64 * (j))
#define XB_XSUB(j)  (1280 + 64 * (j))
#define XB_XGEN(j)  (2304 + 64 * (j))
#define XB_TOP      3328
#define XB_TOPGEN   3392
#define XCD_BAR_WORDS 3456
#define XB_SPIN_CAP (1u << 20)

__device__ __forceinline__ unsigned xb_ld(unsigned* p)              { return __hip_atomic_load(p, __ATOMIC_RELAXED, __HIP_MEMORY_SCOPE_AGENT); }
__device__ __forceinline__ unsigned xb_add(unsigned* p, unsigned v) { return __hip_atomic_fetch_add(p, v, __ATOMIC_RELAXED, __HIP_MEMORY_SCOPE_AGENT); }
__device__ __forceinline__ unsigned xb_xcc_id() { return (unsigned)__builtin_amdgcn_s_getreg((3 << 11) | 20) & 0xFu; }
#define XB_SPIN(cond, bar) do { unsigned _sp = 0; while (cond) { __builtin_amdgcn_s_sleep(1); \
    if ((++_sp & 255u) == 0u) { if (xb_ld(&(bar)[XB_TMO])) break; if (_sp > XB_SPIN_CAP) { atomicAdd(&(bar)[XB_TMO], 1u); break; } } } } while (0)

struct XcdBarrier {
    unsigned* bar; unsigned x;
    volatile LAS unsigned* st;
};
__device__ __forceinline__ XcdBarrier xcd_barrier_post(unsigned* bar, volatile LAS unsigned* st) {
    XcdBarrier b; b.bar = bar; b.x = xb_xcc_id(); b.st = st;
    if (threadIdx.x == 0) (void)xb_add(&bar[XB_XCNT(b.x)], 1u);
    return b;
}
__device__ __forceinline__ void xcd_barrier_complete(unsigned* bar, unsigned x, unsigned& nloc, unsigned& nx) {
    const unsigned G = gridDim.x * gridDim.y * gridDim.z;
    unsigned sum, cnt, mine, sp = 0u;
    for (;;) {
        sum = 0u; cnt = 0u; mine = 0u;
#pragma unroll
        for (unsigned j = 0; j < 16; ++j) { const unsigned c = xb_ld(&bar[XB_XCNT(j)]); sum += c; cnt += (c > 0u) ? 1u : 0u; mine = (j == x) ? c : mine; }
        if (sum == G) break;
        __builtin_amdgcn_s_sleep(1);
        if ((++sp & 255u) == 0u) { if (xb_ld(&bar[XB_TMO])) break; if (sp > XB_SPIN_CAP) { atomicAdd(&bar[XB_TMO], 1u); break; } }
    }
    nloc = mine > 0u ? mine : 1u; nx = cnt > 0u ? cnt : 1u;
}
__device__ __forceinline__ void xcd_barrier(const XcdBarrier& b) {
    asm volatile("s_waitcnt vmcnt(0)" ::: "memory");
    __syncthreads();
    if (threadIdx.x == 0) {
        unsigned* bar = b.bar;
        __builtin_amdgcn_s_waitcnt(0);
        unsigned nloc = b.st[0], nx = b.st[1];
        if (nloc == 0u) { xcd_barrier_complete(bar, b.x, nloc, nx); b.st[0] = nloc; b.st[1] = nx; }
        const unsigned old = xb_add(&bar[XB_XSUB(b.x)], 1u);
        const unsigned gen = old / nloc;
        if (old + 1u == (gen + 1u) * nloc) {
            __builtin_amdgcn_fence(__ATOMIC_RELEASE, "agent");
            asm volatile("s_waitcnt vmcnt(0)" ::: "memory");
            const unsigned og = xb_add(&bar[XB_TOP], 1u);
            const unsigned tg = og / nx;
            if (og + 1u == (tg + 1u) * nx) xb_add(&bar[XB_TOPGEN], 1u);
            else XB_SPIN(xb_ld(&bar[XB_TOPGEN]) == tg, bar);
            __builtin_amdgcn_fence(__ATOMIC_ACQUIRE, "agent");
            xb_add(&bar[XB_XGEN(b.x)], 1u);
            asm volatile("s_waitcnt vmcnt(0)" ::: "memory");
        } else {
            XB_SPIN(xb_ld(&bar[XB_XGEN(b.x)]) == gen, bar);
            __builtin_amdgcn_fence(__ATOMIC_ACQUIRE, "agent");
            asm volatile("s_waitcnt vmcnt(0)" ::: "memory");
        }
    }
    __syncthreads();
}

struct Args { const float* in[20]; float* out; unsigned char* ws; int ph_lo, ph_hi; };
struct Frame {
    LAS unsigned char* lds;
    unsigned char* ws;
    float* out;
    int tid, lane, wave, G, blk;
    const float* const* in;
};
#define WSP(T, off) ((T*)(F.ws + (off)))
#define WSG(T, off) ((const GAS T*)(F.ws + (off)))

namespace pg8 {
#define PG8_LAS __attribute__((address_space(3)))
typedef unsigned short bf16_t;
typedef short bf16x8 __attribute__((ext_vector_type(8)));
typedef float f32x4 __attribute__((ext_vector_type(4)));
typedef unsigned u32x4 __attribute__((ext_vector_type(4)));
constexpr int BM = 256, BK = 64, HALF = 128, HTB = HALF * BK * 2  , STAGE_BYTES = 8 * HTB, NXCD = 8, WGM = 8;

__host__ __device__ __forceinline__ int lds_byte(int r, int c) { const int st = (r >> 4) * 2 + (c >> 5), rr = r & 15, cc = c & 31, ob = rr * 64 + cc * 2; return st * 1024 + (ob ^ (((ob >> 9) & 1) << 5)); }
__host__ __device__ __forceinline__ void stage_rc(int b, int& R, int& C) { const int st = b / 1024, sb = b % 1024, swz = sb ^ (((sb >> 9) & 1) << 5); R = (st >> 1) * 16 + swz / 64; C = (st & 1) * 32 + (swz % 64) / 2; }
__host__ __device__ __forceinline__ int perm32(int rho) { const int n = rho >> 4, i = rho & 15; return 8 * (i >> 2) + 4 * n + (i & 3); }

struct Unit { int pm, pn; };
struct Gemm { const bf16_t* A; const bf16_t* Bt; int M, N, K; };

struct StaticOrder {
    static constexpr bool GATHER = false;
    __device__ __forceinline__ unsigned goff(const Unit&, int, int) const { return 0u; }
    int nM, nN, nwg, G, c;
    __host__ __device__ void init(int M, int N, int G_, int c_) { nM = M / BM; nN = N / BM; nwg = nM * nN; G = G_; c = c_; }
    __host__ __device__ bool next(int i, Unit& u) const {
        const long L = (long)i * G + c; if (L >= nwg) return false;
        int wgid = (int)L; { const int q = nwg / NXCD, r = nwg % NXCD, xcd = wgid % NXCD, off = wgid / NXCD; wgid = (xcd < r ? xcd * (q + 1) : r * (q + 1) + (xcd - r) * q) + off; }
        const int nig = WGM * nN, gid = wgid / nig, fm = gid * WGM, gsz = (nM - fm) < WGM ? (nM - fm) : WGM;
        u.pm = fm + ((wgid % nig) % gsz); u.pn = (wgid % nig) / gsz; return true;
    }
    __device__ __forceinline__ void a_ready(const Unit&) const {}
    __device__ __forceinline__ void done(const Unit&) const {}
};
__device__ __forceinline__ unsigned cvt_pk_bf16(float lo, float hi) { unsigned r; asm volatile("v_cvt_pk_bf16_f32 %0, %1, %2" : "=v"(r) : "v"(lo), "v"(hi)); return r; }
template <class Epi, class Sched, bool ALIGN_EPI = false, bool SP2 = false>
__device__ __forceinline__ void gemm_phase(PG8_LAS unsigned char* lds, const Gemm g, const Sched& S, const Epi& E) {
    const int tid = threadIdx.x, wid = __builtin_amdgcn_readfirstlane(tid >> 6), lane = tid & 63, wr = wid >> 2, wc = wid & 3, fr = lane & 15, fq = lane >> 4;
    const int K = g.K, nt = K / BK;
    constexpr bool GATHER = Sched::GATHER;
    static_assert(!GATHER || SP2, "the gathered A operand is wired into the SP2 loop only");
    unsigned voffA[2], voffB[2]; int gR[2]; unsigned gC2[2];
#pragma unroll
    for (int i = 0; i < 2; ++i) { int R, C; stage_rc(tid * 16 + i * 8192, R, C); const int Rb = Epi::PERM ? ((R & ~31) + perm32(R & 31)) : R;
        voffA[i] = (unsigned)(R * K + C) * 2u; voffB[i] = (unsigned)(Rb * K + C) * 2u; gR[i] = R; gC2[i] = (unsigned)C * 2u; }
    unsigned gCur0[2] = {0u, 0u}, gCur1[2] = {0u, 0u}, gNxt0[2] = {0u, 0u}, gNxt1[2] = {0u, 0u};
#define PG8_GOFF(u, g0, g1) do { _Pragma("unroll") for (int _i = 0; _i < 2; ++_i) { g0[_i] = S.goff(u, gR[_i], K) + gC2[_i]; g1[_i] = S.goff(u, HALF + gR[_i], K) + gC2[_i]; } } while (0)
    const size_t kstep = (size_t)(BK * 2);
    const size_t hstep = (size_t)HALF * K * 2;
    const size_t tstep = 2 * hstep;
    const unsigned ldsw = (unsigned)wid * 1024u;
    const int aoff = lds_byte(wr * 64 + fr, fq * 8), boff = lds_byte(wc * 32 + fr, fq * 8);
#define PG8_SA(b, h) (((b) * 2 + (h)) * HTB)
#define PG8_SB(b, h) ((4 + (b) * 2 + (h)) * HTB)
#define PG8_STAGE(bufoff, gbase, voff) do { _Pragma("unroll") for (int _i = 0; _i < 2; ++_i) \
        __builtin_amdgcn_global_load_lds((const unsigned*)((const char*)(gbase) + (voff)[_i]), (PG8_LAS unsigned*)(lds + (bufoff) + ldsw + _i * 8192), 16, 0, 0); } while (0)
#define PG8_LDA(dst, b, h) do { _Pragma("unroll") for (int m = 0; m < 4; ++m) _Pragma("unroll") for (int k = 0; k < 2; ++k) dst[m][k] = *(const PG8_LAS bf16x8*)(lds + PG8_SA(b, h) + aoff + m * 2048 + k * 1024); } while (0)
#define PG8_LDB(dst, b, h) do { _Pragma("unroll") for (int n = 0; n < 2; ++n) _Pragma("unroll") for (int k = 0; k < 2; ++k) dst[n][k] = *(const PG8_LAS bf16x8*)(lds + PG8_SB(b, h) + boff + n * 2048 + k * 1024); } while (0)
#define PG8_MMA(ai, bj, At, Bt) do { __builtin_amdgcn_s_setprio(1); _Pragma("unroll") for (int m = 0; m < 4; ++m) _Pragma("unroll") for (int n = 0; n < 2; ++n) _Pragma("unroll") for (int k = 0; k < 2; ++k) \
        acc[ai][bj][m][n] = __builtin_amdgcn_mfma_f32_16x16x32_bf16(Bt[n][k], At[m][k], acc[ai][bj][m][n], 0, 0, 0); __builtin_amdgcn_s_setprio(0); } while (0)
#define PG8_WAIT_V(n) asm volatile("s_waitcnt vmcnt(" #n ")" ::: "memory")
#define PG8_WAIT_L(n) asm volatile("s_waitcnt lgkmcnt(" #n ")" ::: "memory")
#define PG8_BAR __builtin_amdgcn_s_barrier()
#define PG8_SCHED __builtin_amdgcn_sched_barrier(0)
    Unit cur, nxt; int ui = 0;
    if (!S.next(0, cur)) return;
    f32x4 acc[2][2][4][2];
#pragma unroll
    for (int a = 0; a < 2; ++a)
#pragma unroll
        for (int b = 0; b < 2; ++b)
#pragma unroll
            for (int m = 0; m < 4; ++m)
#pragma unroll
                for (int n = 0; n < 2; ++n) acc[a][b][m][n] = (f32x4){0.f, 0.f, 0.f, 0.f};
    bf16x8 At[4][2], B0[2][2], B1[2][2];
    const char* cA = (const char*)g.A + (GATHER ? (size_t)0 : (size_t)cur.pm * tstep); const char* cB = (const char*)g.Bt + (size_t)cur.pn * tstep;
    const size_t hsA = GATHER ? (size_t)0 : hstep;
    if constexpr (GATHER) PG8_GOFF(cur, gCur0, gCur1);
    S.a_ready(cur);
    if constexpr (SP2) {
        PG8_STAGE(PG8_SB(0, 0), cB, voffB); PG8_STAGE(PG8_SB(0, 1), cB + hstep, voffB); PG8_STAGE(PG8_SA(0, 0), cA, (GATHER ? gCur0 : voffA)); PG8_STAGE(PG8_SA(0, 1), cA + hsA, (GATHER ? gCur1 : voffA));
        if (wr == 1) PG8_BAR;
        PG8_WAIT_V(2); PG8_BAR;
        PG8_STAGE(PG8_SB(1, 0), cB + kstep, voffB); PG8_STAGE(PG8_SA(1, 0), cA + kstep, (GATHER ? gCur0 : voffA)); PG8_STAGE(PG8_SB(1, 1), cB + hstep + kstep, voffB);
        PG8_WAIT_V(6); PG8_BAR;
    } else {
        PG8_STAGE(PG8_SB(0, 0), cB, voffB); PG8_STAGE(PG8_SA(0, 0), cA, voffA); PG8_STAGE(PG8_SB(0, 1), cB + hstep, voffB); PG8_STAGE(PG8_SA(0, 1), cA + hstep, voffA);
        if (wr == 1) PG8_BAR;
        PG8_WAIT_V(4); PG8_BAR;
        PG8_STAGE(PG8_SB(1, 0), cB + kstep, voffB); PG8_STAGE(PG8_SA(1, 0), cA + kstep, voffA); PG8_STAGE(PG8_SB(1, 1), cB + hstep + kstep, voffB);
        PG8_WAIT_V(6); PG8_BAR;
    }
    for (;;) {
        const bool has_next = S.next(ui + 1, nxt);
        const char* nA = (has_next && !GATHER) ? (const char*)g.A + (size_t)nxt.pm * tstep : cA; const char* nB = has_next ? (const char*)g.Bt + (size_t)nxt.pn * tstep : cB;
        if constexpr (GATHER) { if (has_next) PG8_GOFF(nxt, gNxt0, gNxt1); else { gNxt0[0] = gCur0[0]; gNxt0[1] = gCur0[1]; gNxt1[0] = gCur1[0]; gNxt1[1] = gCur1[1]; } }
        for (int t = 0; t < nt; t += 2) {
            const bool last = (t == nt - 2);
            unsigned gS0[2], gS1[2];
            gS0[0] = last ? gNxt0[0] : gCur0[0]; gS0[1] = last ? gNxt0[1] : gCur0[1]; gS1[0] = last ? gNxt1[0] : gCur1[0]; gS1[1] = last ? gNxt1[1] : gCur1[1];
            const char* a1 = cA + (size_t)(t + 1) * kstep;
            const char* a2 = last ? nA : cA + (size_t)(t + 2) * kstep; const char* b2 = last ? nB : cB + (size_t)(t + 2) * kstep;
            const char* a3 = a2 + kstep; const char* b3 = b2 + kstep;
            if (last && has_next) S.a_ready(nxt);
            if constexpr (SP2) {
            PG8_LDB(B0, 0, 0); PG8_LDB(B1, 0, 1); PG8_SCHED; PG8_LDA(At, 0, 0); PG8_STAGE(PG8_SA(1, 1), a1 + hsA, (GATHER ? gCur1 : voffA));
            PG8_WAIT_V(8); PG8_WAIT_L(0); PG8_BAR; PG8_MMA(0, 0, At, B0); PG8_MMA(0, 1, At, B1); PG8_BAR; PG8_SCHED;
            PG8_LDA(At, 0, 1); PG8_STAGE(PG8_SB(0, 0), b2, voffB); PG8_STAGE(PG8_SB(0, 1), b2 + hstep, voffB); PG8_STAGE(PG8_SA(0, 0), a2, (GATHER ? gS0 : voffA));
            PG8_WAIT_V(8); PG8_WAIT_L(0); PG8_BAR; PG8_MMA(1, 0, At, B0); PG8_MMA(1, 1, At, B1); PG8_BAR; PG8_SCHED;
            PG8_LDB(B0, 1, 0); PG8_LDB(B1, 1, 1); PG8_SCHED; PG8_LDA(At, 1, 0); PG8_STAGE(PG8_SA(0, 1), a2 + hsA, (GATHER ? gS1 : voffA));
            PG8_WAIT_V(8); PG8_WAIT_L(0); PG8_BAR; PG8_MMA(0, 0, At, B0); PG8_MMA(0, 1, At, B1); PG8_BAR; PG8_SCHED;
            PG8_LDA(At, 1, 1); PG8_STAGE(PG8_SB(1, 0), b3, voffB); PG8_STAGE(PG8_SB(1, 1), b3 + hstep, voffB); PG8_STAGE(PG8_SA(1, 0), a3, (GATHER ? gS0 : voffA));
            PG8_WAIT_V(8); PG8_WAIT_L(0); PG8_BAR; PG8_MMA(1, 0, At, B0); PG8_MMA(1, 1, At, B1); PG8_BAR; PG8_SCHED;
            } else {
            PG8_LDB(B0, 0, 0); PG8_SCHED; PG8_LDA(At, 0, 0); PG8_STAGE(PG8_SA(1, 1), a1 + hstep, voffA);
            PG8_WAIT_L(8); PG8_BAR; PG8_WAIT_L(0); PG8_MMA(0, 0, At, B0); PG8_BAR; PG8_SCHED;
            PG8_LDB(B1, 0, 1); PG8_STAGE(PG8_SB(0, 0), b2, voffB);
            PG8_BAR; PG8_WAIT_L(0); PG8_MMA(0, 1, At, B1); PG8_BAR;
            PG8_LDA(At, 0, 1); PG8_STAGE(PG8_SA(0, 0), a2, voffA);
            PG8_BAR; PG8_WAIT_L(0); PG8_MMA(1, 0, At, B0); PG8_BAR; PG8_SCHED;
            PG8_STAGE(PG8_SB(0, 1), b2 + hstep, voffB);
            PG8_WAIT_V(6); PG8_BAR; PG8_MMA(1, 1, At, B1); PG8_BAR;
            PG8_LDB(B0, 1, 0); PG8_SCHED; PG8_LDA(At, 1, 0); PG8_STAGE(PG8_SA(0, 1), a2 + hstep, voffA);
            PG8_WAIT_L(8); PG8_BAR; PG8_WAIT_L(0); PG8_MMA(0, 0, At, B0); PG8_BAR; PG8_SCHED;
            PG8_LDB(B1, 1, 1); PG8_STAGE(PG8_SB(1, 0), b3, voffB);
            PG8_BAR; PG8_WAIT_L(0); PG8_MMA(0, 1, At, B1); PG8_BAR;
            PG8_LDA(At, 1, 1); PG8_STAGE(PG8_SA(1, 0), a3, voffA);
            PG8_BAR; PG8_WAIT_L(0); PG8_MMA(1, 0, At, B0); PG8_BAR; PG8_SCHED;
            PG8_STAGE(PG8_SB(1, 1), b3 + hstep, voffB);
            PG8_WAIT_V(6); PG8_BAR; PG8_MMA(1, 1, At, B1); PG8_BAR;
            }
        }
        if constexpr (ALIGN_EPI) { if (wr == 0) PG8_BAR; }
        if constexpr (!Epi::AFTER_DRAIN) { E(acc, cur, wr, wc, fr, fq); S.done(cur); }
        if (!has_next) break;
#pragma unroll
        for (int a = 0; a < 2; ++a)
#pragma unroll
            for (int b = 0; b < 2; ++b)
#pragma unroll
                for (int m = 0; m < 4; ++m)
#pragma unroll
                    for (int n = 0; n < 2; ++n) acc[a][b][m][n] = (f32x4){0.f, 0.f, 0.f, 0.f};
        cur = nxt; cA = nA; cB = nB; ++ui;
        if constexpr (GATHER) { gCur0[0] = gNxt0[0]; gCur0[1] = gNxt0[1]; gCur1[0] = gNxt1[0]; gCur1[1] = gNxt1[1]; }
        if constexpr (ALIGN_EPI) { if (wr == 1) PG8_BAR; }
    }
    PG8_WAIT_V(0);
    if constexpr (!ALIGN_EPI) { if (wr == 0) PG8_BAR; }
    PG8_BAR;
    if constexpr (Epi::AFTER_DRAIN) { E.fused(acc, cur, wr, wc, fr, fq, lds, wid, lane); S.done(cur); }
#undef PG8_GOFF
#undef PG8_SA
#undef PG8_SB
#undef PG8_STAGE
#undef PG8_LDA
#undef PG8_LDB
#undef PG8_MMA
#undef PG8_WAIT_V
#undef PG8_WAIT_L
#undef PG8_BAR
#undef PG8_SCHED
}
}

__device__ __forceinline__ void prologue_tables(const Frame& F) {
    const int gt = F.blk * 512 + F.tid, NT = F.G * 512;
    float* COS = WSP(float, WS_COS); float* SIN = WSP(float, WS_SIN); float* LBV = WSP(float, WS_LBV);
    for (int i = gt; i < LSEQ * 16; i += NT) {
        const int t = i >> 4, j = i & 15;
        const float inv = powf(10000.f, -(float)(2 * j) / 32.f);
        const float ang = (float)(t - PADR) * inv;
        const double a = (double)ang; const double n = rint(a * 0.15915494309189535); const float r = (float)(a - n * 6.283185307179586);
        COS[i] = cosf(r); SIN[i] = sinf(r);
    }
    { u32x4* KXD = WSP(u32x4, WS_KXD); for (int i = gt; i < LSEQ; i += NT) KXD[i] = (u32x4){i < PADR ? 0x7F00u : 0u, 0u, 0u, 0u}; }
    { bf16* WRT = WSP(bf16, WS_WRT); float* WF = WSP(float, WS_WF);
      for (int i = gt; i < 2 * 48 * 1024; i += NT) { const int l = i / (48 * 1024), r = i % (48 * 1024), col = r >> 10, k = r & 1023;
          float w = 0.f; if (col < 4) w = F.in[12][((size_t)l * DM + k) * 4 + col]; else if (col < 36) w = F.in[14][((size_t)l * DM + k) * 32 + (col - 4)];
          const unsigned hb = f2bf(w), lb2 = f2bf(w - bf2f(hb));
          WRT[(size_t)(l * 2 + 0) * 48 * 1024 + r] = (bf16)hb; WRT[(size_t)(l * 2 + 1) * 48 * 1024 + r] = (bf16)lb2; }
      for (int i = gt; i < 2 * 1024 * 4; i += NT) { const int l = i >> 12, r = i & 4095, k = r >> 2, q = r & 3; WF[i] = F.in[3][((size_t)l * DM + k) * INW + 3584 + q]; } }
    const float* lbp = F.in[4];
    for (int i = gt; i < 1024; i += NT) { const int l = i >> 9, c = i & 511; LBV[i] = l == 0 ? 0.f : sigmoidf_(lbp[512 + c] - lbp[c]); }
}

__device__ __forceinline__ void moe_tile_bases(const Frame& F, int layer, LAS int* tb);
template <int MODE> __device__ __forceinline__ void norm_phase(const Frame& F, int layer) {
    const int gw = F.blk * 8 + F.wave, NGW = F.G * 8, lane = F.lane;
    float* H = WSP(float, WS_H); bf16* XN = WSP(bf16, WS_XN); const bf16* Y = WSP(bf16, WS_Y); const int* TOKE = WSP(int, WS_TOKE); const int* TOKR = WSP(int, WS_TOKR); float* FLS = WSP(float, WS_FLS);
    LAS int* tbs = (LAS int*)(F.lds + 131072);
    const float* gain = (MODE == 2) ? F.in[19] : F.in[2] + layer * DM;
    const float* fb = F.in[8] + layer * 4;
    LAS f32x4* sWF = (LAS f32x4*)F.lds;
    if (MODE != 2) { const float* win = F.in[3] + (size_t)layer * DM * INW + 3584;
        for (int i = F.tid; i < 1024; i += 512) sWF[i] = *(const f32x4*)(win + (size_t)i * INW); __syncthreads(); }
#define NP_LOAD(mm, vv) do { const int b_ = (mm) / LSEQ, t_ = (mm) % LSEQ; \
        if (MODE == 0) { _Pragma("unroll") for (int j = 0; j < 4; ++j) { const int col = 4 * lane + 256 * j; \
                if (t_ < PADR) vv[j] = (f32x4){0.f, 0.f, 0.f, 0.f}; \
                else if (t_ < 128) vv[j] = *(const f32x4*)(F.in[1] + (size_t)(t_ - PADR) * DM + col); \
                else vv[j] = *(const f32x4*)(F.in[0] + ((size_t)b_ * SEQ + (t_ - 128)) * DM + col); } } \
        else { const int s0 = 256 * tbs[TOKE[2 * (mm)]] + TOKR[2 * (mm)], s1 = 256 * tbs[TOKE[2 * (mm) + 1]] + TOKR[2 * (mm) + 1]; \
            _Pragma("unroll") for (int j = 0; j < 4; ++j) { const int col = 4 * lane + 256 * j; \
                const f32x4 hv = *(const f32x4*)(H + (size_t)(mm) * DM + col); \
                const u32x2 y0 = *(const u32x2*)(Y + (size_t)s0 * DM + col), y1 = *(const u32x2*)(Y + (size_t)s1 * DM + col); \
                vv[j].x = hv.x + bflo(y0.x) + bflo(y1.x); vv[j].y = hv.y + bfhi(y0.x) + bfhi(y1.x); \
                vv[j].z = hv.z + bflo(y0.y) + bflo(y1.y); vv[j].w = hv.w + bfhi(y0.y) + bfhi(y1.y); } } } while (0)
    f32x4 v[4], vn[4];
#pragma unroll
    for (int j = 0; j < 4; ++j) { v[j] = (f32x4){0.f, 0.f, 0.f, 0.f}; vn[j] = v[j]; }
    if (gw < M) NP_LOAD(gw, v);
#pragma unroll 1
    for (int m = gw; m < M; m += NGW) {
        const int b = m / LSEQ, t = m % LSEQ;
        if (m + NGW < M) NP_LOAD(m + NGW, vn);
        float ss = 0.f;
#pragma unroll
        for (int j = 0; j < 4; ++j) ss += (v[j].x * v[j].x + v[j].y * v[j].y) + (v[j].z * v[j].z + v[j].w * v[j].w);
        ss = wave_sum(ss);
        const float r = rsqrtf(ss * (1.f / DM) + EPS);
        if (MODE != 2) {
            float fa[4] = {0.f, 0.f, 0.f, 0.f};
#pragma unroll
            for (int j = 0; j < 4; ++j) {
                const int col = 4 * lane + 256 * j;
                if (MODE != 0) *(f32x4*)(H + (size_t)m * DM + col) = v[j];
                const f32x4 g = *(const f32x4*)(gain + col);
                const f32x4 u = v[j] * r * g;
                u32x2 o; o.x = pk2(u.x, u.y); o.y = pk2(u.z, u.w);
                *(u32x2*)(XN + (size_t)m * DM + col) = o;
#pragma unroll
                for (int q = 0; q < 4; ++q) {
                    const f32x4 w = sWF[col + q];
                    const float uq = u[q];
                    fa[0] += uq * w.x; fa[1] += uq * w.y; fa[2] += uq * w.z; fa[3] += uq * w.w;
                }
            }
#pragma unroll
            for (int q = 0; q < 4; ++q) fa[q] = wave_sum(fa[q]);
            if (lane < 4) {
                const float z = (lane == 0 ? fa[0] : lane == 1 ? fa[1] : lane == 2 ? fa[2] : fa[3]) + fb[lane];
                FLS[(size_t)m * 4 + lane] = fminf(z, 0.f) - log1pf(__expf(-fabsf(z)));
            }
        } else {
            if (t >= 128) {
                float* orow = F.out + ((size_t)b * SEQ + (t - 128)) * DM;
#pragma unroll
                for (int j = 0; j < 4; ++j) {
                    const int col = 4 * lane + 256 * j;
                    const f32x4 g = *(const f32x4*)(gain + col);
                    __builtin_nontemporal_store(v[j] * r * g, (f32x4*)(orow + col));
                }
            }
        }
#pragma unroll
        for (int j = 0; j < 4; ++j) v[j] = vn[j];
    }
#undef NP_LOAD
    if (MODE != 2) __syncthreads();
}

__device__ __forceinline__ void fd_scan(const Frame& F) {
    const float* FLS = WSP(float, WS_FLS); float* FD2 = WSP(float, WS_FD2); u32x4* KXF = WSP(u32x4, WS_KXF);
    const int bh = F.wave, b = bh >> 2, h = bh & 3, lane = F.lane;
    float carry = 0.f;
#pragma unroll 1
    for (int t0 = 0; t0 < LSEQ; t0 += 512) {
        const int tb = t0 + lane * 8;
        float v[8];
#pragma unroll
        for (int j = 0; j < 8; ++j) v[j] = (tb + j < LSEQ) ? FLS[((size_t)b * LSEQ + tb + j) * 4 + h] : 0.f;
#pragma unroll
        for (int j = 1; j < 8; ++j) v[j] += v[j - 1];
        float tot = v[7], inc = tot;
#pragma unroll
        for (int o = 1; o < 64; o <<= 1) { const float u = __shfl_up(inc, o); if (lane >= o) inc += u; }
        const float base = carry + inc - tot;
#pragma unroll
        for (int j = 0; j < 8; ++j) if (tb + j < LSEQ) { const float d2 = (base + v[j]) * LOG2E; FD2[(size_t)bh * LSEQ + tb + j] = d2;
            const unsigned hb = f2bf(d2), lb = f2bf(d2 - bf2f(hb)); KXF[(size_t)bh * LSEQ + tb + j] = (u32x4){(tb + j) < PADR ? 0x7F00u : (hb | (lb << 16)), 0u, 0u, 0u}; }
        carry += __shfl(inc, 63);
    }
}

template <bool DUAL, class Epi>
__device__ __forceinline__ void ngemm_tile(const Frame& F, const bf16* A, int lda, const float* B, const float* B2, int ldb, int K, int n0, const Epi& epi) {
    LAS float* As = (LAS float*)F.lds;
    LAS float* Bs = As + 16 * 132;
    LAS float* Bs2 = Bs + 16 * 64;
    const int tid = F.tid, tx = tid & 15, ty = tid >> 4;
    float acc[4][4], acc2[4][4];
#pragma unroll
    for (int i = 0; i < 4; ++i)
#pragma unroll
        for (int j = 0; j < 4; ++j) { acc[i][j] = 0.f; acc2[i][j] = 0.f; }
    const int ar = tid >> 2, akq = (tid & 3) * 4, bkr = tid >> 5, bcc = (tid & 31) * 2;
    for (int k0 = 0; k0 < K; k0 += 16) {
        const u32x2 raw = *(const u32x2*)(A + (size_t)ar * lda + k0 + akq);
        const f32x2 bv = *(const f32x2*)(B + (size_t)(k0 + bkr) * ldb + n0 + bcc);
        f32x2 bv2 = (f32x2){0.f, 0.f};
        if (DUAL) bv2 = *(const f32x2*)(B2 + (size_t)(k0 + bkr) * ldb + n0 + bcc);
        As[(akq + 0) * 132 + ar] = bflo(raw.x); As[(akq + 1) * 132 + ar] = bfhi(raw.x); As[(akq + 2) * 132 + ar] = bflo(raw.y); As[(akq + 3) * 132 + ar] = bfhi(raw.y);
        Bs[bkr * 64 + bcc] = bv.x; Bs[bkr * 64 + bcc + 1] = bv.y;
        if (DUAL) { Bs2[bkr * 64 + bcc] = bv2.x; Bs2[bkr * 64 + bcc + 1] = bv2.y; }
        __syncthreads();
#pragma unroll
        for (int k = 0; k < 16; ++k) {
            const f32x4 a = *(const LAS f32x4*)(As + k * 132 + ty * 4);
            float bb[4], bb2[4];
#pragma unroll
            for (int j = 0; j < 4; ++j) { bb[j] = Bs[k * 64 + tx + 16 * j]; if (DUAL) bb2[j] = Bs2[k * 64 + tx + 16 * j]; }
#pragma unroll
            for (int i = 0; i < 4; ++i)
#pragma unroll
                for (int j = 0; j < 4; ++j) { acc[i][j] += a[i] * bb[j]; if (DUAL) acc2[i][j] += a[i] * bb2[j]; }
        }
        __syncthreads();
    }
#pragma unroll
    for (int i = 0; i < 4; ++i) epi(ty * 4 + i, n0 + tx, acc[i], acc2[i]);
}

struct EpiInproj {
    unsigned char* ws; int layer; int m0;
    __device__ __forceinline__ void operator()(int r, int c0, const float (&v)[4], const float (&)[4]) const {
        const int m = m0 + r, t = m % LSEQ; const bool valid = t >= PADR;
        const int reg = c0 >> 8;
        if (reg < 2) { bf16* O = (bf16*)(ws + WS_HQ);
#pragma unroll
            for (int j = 0; j < 4; ++j) O[(size_t)m * 512 + c0 + 16 * j] = (bf16)f2bf(siluf_(v[j]) * 0.08838834764831845f);
        } else if (reg < 4) { float* LF = (float*)(ws + WS_HLF); bf16* KK = (bf16*)(ws + WS_HK); const float* LBV = (const float*)(ws + WS_LBV) + layer * 512;
#pragma unroll
            for (int j = 0; j < 4; ++j) { const int cc = c0 - 512 + 16 * j; const float lb = LBV[cc], sg = sigmoidf_(v[j]);
                const float f = lb + (1.f - lb) * sg; float lf = __logf(fmaxf(f, TINYF)), kk = (1.f - lb) * (1.f - sg);
                if (!valid) { lf = 0.f; kk = 0.f; }
                LF[(size_t)m * 512 + cc] = lf; KK[(size_t)m * 512 + cc] = (bf16)f2bf(kk); }
        } else if (reg < 6) { bf16* O = (bf16*)(ws + WS_HV);
#pragma unroll
            for (int j = 0; j < 4; ++j) O[(size_t)m * 512 + c0 - 1024 + 16 * j] = (bf16)f2bf(v[j]);
        } else if (reg < 8) { bf16* O = (bf16*)(ws + WS_HG);
#pragma unroll
            for (int j = 0; j < 4; ++j) O[(size_t)m * 512 + c0 - 1536 + 16 * j] = (bf16)f2bf(siluf_(v[j]));
        } else if (reg < 10) {
            bf16* O = (bf16*)(ws + (reg == 8 ? WS_DQ : WS_DK)); const int cc = c0 - reg * 256;
            const float sc = reg == 8 ? 0.17677669529663687f * LOG2E : 1.f;
            const int i = cc & 15;
            const float cs = ((const float*)(ws + WS_COS))[t * 16 + i], sn = ((const float*)(ws + WS_SIN))[t * 16 + i];
#pragma unroll
            for (int p = 0; p < 2; ++p) { const float x1 = v[2 * p], x2 = v[2 * p + 1];
                O[(size_t)m * 256 + cc + 32 * p] = (bf16)f2bf((x1 * cs - x2 * sn) * sc);
                O[(size_t)m * 256 + cc + 32 * p + 16] = (bf16)f2bf((x2 * cs + x1 * sn) * sc); }
        } else { const size_t off = reg == 10 ? WS_DV : reg == 11 ? WS_FQ : reg == 12 ? WS_FK : WS_FV; bf16* O = (bf16*)(ws + off);
            const float sc = reg == 11 ? 0.125f * LOG2E : 1.f; const int cc = c0 - reg * 256;
#pragma unroll
            for (int j = 0; j < 4; ++j) O[(size_t)m * 256 + cc + 16 * j] = (bf16)f2bf(v[j] * sc);
        }
    }
};
__device__ __forceinline__ void gemm1_naive(const Frame& F, int layer) {
    const bf16* XN = WSP(bf16, WS_XN); const float* W = F.in[3] + (size_t)layer * DM * INW;
    constexpr int NT = (M / 128) * 56;
    for (int tile = F.blk; tile < NT; tile += F.G) {
        const int rt = tile / 56, ct = tile % 56;
        EpiInproj E{F.ws, layer, rt * 128};
        ngemm_tile<false>(F, XN + (size_t)rt * 128 * DM, DM, W, nullptr, INW, DM, ct * 64, E);
    }
}

__device__ __forceinline__ void hgrn_naive(const Frame& F, int layer, int which) {
    const bf16* HQ = WSP(bf16, WS_HQ); const float* HLF = WSP(float, WS_HLF); const bf16* HK = WSP(bf16, WS_HK); const bf16* HV = WSP(bf16, WS_HV); float* ORAW = WSP(float, WS_ORAW);
    const int grp = F.tid >> 7, v = F.tid & 127, bh = which * 4 + grp, b = bh >> 2, h = bh & 3;
    LAS float* sm = (LAS float*)F.lds;
    float S[128];
#pragma unroll
    for (int k = 0; k < 128; ++k) S[k] = 0.f;
    const size_t base = (size_t)b * LSEQ * 512 + 128 * h + v;
    float nq = bf2f(HQ[base]), nf = __expf(HLF[base]), nk = bf2f(HK[base]), nv = bf2f(HV[base]);
    for (int t = 0; t < LSEQ; ++t) {
        LAS float* bufp = sm + (t & 1) * 1536 + grp * 384;
        bufp[v] = nq; bufp[128 + v] = nf; bufp[256 + v] = nk; const float vt = nv;
        __syncthreads();
        if (t + 1 < LSEQ) { const size_t o = base + (size_t)(t + 1) * 512; nq = bf2f(HQ[o]); nf = __expf(HLF[o]); nk = bf2f(HK[o]); nv = bf2f(HV[o]); }
        float o = 0.f;
#pragma unroll
        for (int k4 = 0; k4 < 32; ++k4) {
            const f32x4 q4 = *(const LAS f32x4*)(bufp + 4 * k4), f4 = *(const LAS f32x4*)(bufp + 128 + 4 * k4), kk4 = *(const LAS f32x4*)(bufp + 256 + 4 * k4);
#pragma unroll
            for (int e = 0; e < 4; ++e) { const int k = 4 * k4 + e; S[k] = f4[e] * S[k] + kk4[e] * vt; o += q4[e] * S[k]; }
        }
        ORAW[base + (size_t)t * 512] = o;
    }
}

template <int DQK>
__device__ __forceinline__ void attn_lane(const float (&q)[DQK], const bf16* Kp, int kpitch, const bf16* Vp, int vpitch, const float* FDrow, float fdq, int t, int smax, float (&o)[64]) {
    float acc[64]; float mx = -INFINITY, l = 0.f;
#pragma unroll
    for (int d = 0; d < 64; ++d) acc[d] = 0.f;
    for (int s = PADR; s <= smax; ++s) {
        const u32x4* kp = (const u32x4*)(Kp + (size_t)s * kpitch);
        float sc = FDrow ? fdq - FDrow[s] : 0.f;
#pragma unroll
        for (int c = 0; c < DQK / 8; ++c) { const u32x4 w = kp[c];
            sc += q[8 * c + 0] * bflo(w.x) + q[8 * c + 1] * bfhi(w.x) + q[8 * c + 2] * bflo(w.y) + q[8 * c + 3] * bfhi(w.y)
                + q[8 * c + 4] * bflo(w.z) + q[8 * c + 5] * bfhi(w.z) + q[8 * c + 6] * bflo(w.w) + q[8 * c + 7] * bfhi(w.w); }
        if (s <= t) {
            if (sc > mx) { const float al = exp2f(mx - sc); l *= al;
#pragma unroll
                for (int d = 0; d < 64; ++d) acc[d] *= al;
                mx = sc; }
            const float p = exp2f(sc - mx); l += p;
            const u32x4* vp = (const u32x4*)(Vp + (size_t)s * vpitch);
#pragma unroll
            for (int c = 0; c < 8; ++c) { const u32x4 w = vp[c];
                acc[8 * c + 0] += p * bflo(w.x); acc[8 * c + 1] += p * bfhi(w.x); acc[8 * c + 2] += p * bflo(w.y); acc[8 * c + 3] += p * bfhi(w.y);
                acc[8 * c + 4] += p * bflo(w.z); acc[8 * c + 5] += p * bfhi(w.z); acc[8 * c + 6] += p * bflo(w.w); acc[8 * c + 7] += p * bfhi(w.w); }
        }
    }
    const float il = l > 0.f ? 1.f / l : 0.f;
#pragma unroll
    for (int d = 0; d < 64; ++d) o[d] = acc[d] * il;
}
__device__ __forceinline__ void attn_naive(const Frame& F, int layer, int vblk, int nblk, int nqb  ) {
    const int lane = F.lane;
    bf16* MIX = WSP(bf16, WS_MIX);
    const float* lv = F.in[6] + layer * 128;
    float lam; { float a = lane < 32 ? lv[lane] * lv[32 + lane] : 0.f, c = lane < 32 ? lv[64 + lane] * lv[96 + lane] : 0.f; a = wave_sum(a); c = wave_sum(c);
        const float lam_init = 0.8f - 0.6f * expf(-0.3f * (float)layer); lam = expf(a) - expf(c) + lam_init; }
    const float lam_init = 0.8f - 0.6f * expf(-0.3f * (float)layer);
    const int NQB = nqb, NTASK = 2 * 8 * NQB;
    for (int task = vblk * 8 + F.wave; task < NTASK; task += nblk * 8) {
        const int qb = NQB - 1 - task / 16, r = task % 16, type = r >> 3, bh = r & 7, b = bh >> 2, h = bh & 3;
        const int t = qb * 64 + lane, smax = qb * 64 + 63; const size_t m = (size_t)b * LSEQ + t; const size_t rb = (size_t)b * LSEQ;
        float o[64];
        if (type == 0) {
            const bf16* FQ = WSP(bf16, WS_FQ); const float* FD = WSP(float, WS_FD2) + (size_t)bh * LSEQ;
            float q[64];
#pragma unroll
            for (int c = 0; c < 8; ++c) { const u32x4 w = *(const u32x4*)(FQ + m * 256 + 64 * h + 8 * c);
                q[8 * c] = bflo(w.x); q[8 * c + 1] = bfhi(w.x); q[8 * c + 2] = bflo(w.y); q[8 * c + 3] = bfhi(w.y); q[8 * c + 4] = bflo(w.z); q[8 * c + 5] = bfhi(w.z); q[8 * c + 6] = bflo(w.w); q[8 * c + 7] = bfhi(w.w); }
            attn_lane<64>(q, WSP(bf16, WS_FK) + rb * 256 + 64 * h, 256, WSP(bf16, WS_FV) + rb * 256 + 64 * h, 256, FD, FD[t], t, smax, o);
            float ss = 0.f;
#pragma unroll
            for (int d = 0; d < 64; ++d) ss += o[d] * o[d];
            const float rn = rsqrtf(ss * (1.f / 64.f) + EPS); const float* gn = F.in[9] + layer * 64;
#pragma unroll
            for (int d = 0; d < 64; d += 2) *(unsigned*)(MIX + m * DM + 768 + 64 * h + d) = t >= PADR ? pk2(o[d] * rn * gn[d], o[d + 1] * rn * gn[d + 1]) : 0u;
        } else {
            const bf16* DQ = WSP(bf16, WS_DQ);
            float o0[64];
#pragma unroll
            for (int comp = 0; comp < 2; ++comp) {
                float q[32];
#pragma unroll
                for (int c = 0; c < 4; ++c) { const u32x4 w = *(const u32x4*)(DQ + m * 256 + 32 * (2 * h + comp) + 8 * c);
                    q[8 * c] = bflo(w.x); q[8 * c + 1] = bfhi(w.x); q[8 * c + 2] = bflo(w.y); q[8 * c + 3] = bfhi(w.y); q[8 * c + 4] = bflo(w.z); q[8 * c + 5] = bfhi(w.z); q[8 * c + 6] = bflo(w.w); q[8 * c + 7] = bfhi(w.w); }
                if (comp == 0) attn_lane<32>(q, WSP(bf16, WS_DK) + rb * 256 + 32 * (2 * h + comp), 256, WSP(bf16, WS_DV) + rb * 256 + 64 * h, 256, nullptr, 0.f, t, smax, o0);
                else attn_lane<32>(q, WSP(bf16, WS_DK) + rb * 256 + 32 * (2 * h + comp), 256, WSP(bf16, WS_DV) + rb * 256 + 64 * h, 256, nullptr, 0.f, t, smax, o);
            }
            float ss = 0.f;
#pragma unroll
            for (int d = 0; d < 64; ++d) { o[d] = o0[d] - lam * o[d]; ss += o[d] * o[d]; }
            const float rn = rsqrtf(ss * (1.f / 64.f) + EPS) * (1.f - lam_init); const float* gn = F.in[7] + layer * 64;
#pragma unroll
            for (int d = 0; d < 64; d += 2) *(unsigned*)(MIX + m * DM + 512 + 64 * h + d) = t >= PADR ? pk2(o[d] * rn * gn[d], o[d + 1] * rn * gn[d + 1]) : 0u;
        }
    }
}

__device__ __forceinline__ void hgrn_post(const Frame& F, int layer) {
    const float* ORAW = WSP(float, WS_ORAW); const bf16* HG = WSP(bf16, WS_HG); bf16* MIX = WSP(bf16, WS_MIX); const float* gn = F.in[5] + layer * 128;
    const int gw = F.blk * 8 + F.wave, NGW = F.G * 8, lane = F.lane;
    for (int it = gw; it < M * 4; it += NGW) {
        const int m = it >> 2, h = it & 3;
        const f32x2 o = *(const f32x2*)(ORAW + (size_t)m * 512 + 128 * h + 2 * lane);
        const float ss = wave_sum(o.x * o.x + o.y * o.y), rn = rsqrtf(ss * (1.f / 128.f) + EPS);
        const unsigned g = *(const unsigned*)(HG + (size_t)m * 512 + 128 * h + 2 * lane);
        *(unsigned*)(MIX + (size_t)m * DM + 128 * h + 2 * lane) = pk2(o.x * rn * gn[2 * lane] * bflo(g), o.y * rn * gn[2 * lane + 1] * bfhi(g));
    }
}

struct EpiResid { float* H; int m0;
    __device__ __forceinline__ void operator()(int r, int c0, const float (&v)[4], const float (&)[4]) const {
#pragma unroll
        for (int j = 0; j < 4; ++j) H[(size_t)(m0 + r) * DM + c0 + 16 * j] += v[j]; } };
__device__ __forceinline__ void gemm2_naive(const Frame& F, int layer) {
    const bf16* MIX = WSP(bf16, WS_MIX); const float* W = F.in[10] + (size_t)layer * DM * DM;
    constexpr int NT = (M / 128) * 16;
    for (int tile = F.blk; tile < NT; tile += F.G) {
        const int rt = tile / 16, ct = tile % 16;
        EpiResid E{WSP(float, WS_H), rt * 128};
        ngemm_tile<false>(F, MIX + (size_t)rt * 128 * DM, DM, W, nullptr, DM, DM, ct * 64, E);
    }
}

__device__ __forceinline__ void norm2_route_generic(const Frame& F, int layer) {
    typedef short bf16x8_t __attribute__((ext_vector_type(8)));
    const float* H = WSP(float, WS_H); bf16* XN = WSP(bf16, WS_XN);
    int* TOKE = WSP(int, WS_TOKE); int* TOKR = WSP(int, WS_TOKR);
    unsigned* CNT = WSP(unsigned, WS_CTL) + CW_CNT + 64 * layer;
    const float* gain = F.in[11] + layer * DM; const float* bg = F.in[13] + layer * 4; const float* br = F.in[15] + layer * 32;
    const bf16* WThi = WSP(bf16, WS_WRT) + (size_t)(layer * 2) * 48 * 1024; const bf16* WTlo = WThi + 48 * 1024;
    const int RPB = (M + F.G - 1) / F.G, r0 = F.blk * RPB, r1 = (r0 + RPB < M) ? r0 + RPB : M, nrow = r1 - r0, lane = F.lane;
    LAS int* sE = (LAS int*)F.lds;
    LAS int* sRank = sE + 2048; LAS int* sBase = sRank + 2048;
    LAS float* sR = (LAS float*)(sBase + 64);
    LAS float* sL = sR + 1024;
    LAS float* sG = sL + 96 * 48;
    for (int m = r0 + F.wave; m < r1; m += 8) {
        float ss = 0.f;
#pragma unroll
        for (int j = 0; j < 4; ++j) { const f32x4 x = *(const f32x4*)(H + (size_t)m * DM + 4 * lane + 256 * j); ss += (x.x * x.x + x.y * x.y) + (x.z * x.z + x.w * x.w); }
        ss = wave_sum(ss);
        if (lane == 0) sR[m - r0] = rsqrtf(ss * (1.f / DM) + EPS);
    }
    __syncthreads();
    for (int tile = F.wave; tile * 16 < nrow; tile += 8) {
        const int lr = tile * 16 + (lane & 15), kg = lane >> 4; const bool rvalid = lr < nrow; const int row = r0 + (rvalid ? lr : nrow - 1);
        const float rr = sR[row - r0];
        f32x4 acc[3] = {(f32x4){0.f, 0.f, 0.f, 0.f}, (f32x4){0.f, 0.f, 0.f, 0.f}, (f32x4){0.f, 0.f, 0.f, 0.f}};
#pragma unroll 4
        for (int ks = 0; ks < 32; ++ks) {
            const int k0 = 32 * ks + 8 * kg;
            const f32x4 xa = *(const f32x4*)(H + (size_t)row * DM + k0), xb = *(const f32x4*)(H + (size_t)row * DM + k0 + 4);
            const f32x4 ga = *(const f32x4*)(gain + k0), gb = *(const f32x4*)(gain + k0 + 4);
            const f32x4 ua = xa * rr * ga, ub = xb * rr * gb;
            u32x4 hi4; hi4.x = pk2(ua.x, ua.y); hi4.y = pk2(ua.z, ua.w); hi4.z = pk2(ub.x, ub.y); hi4.w = pk2(ub.z, ub.w);
            u32x4 lo4; lo4.x = pk2(ua.x - bflo(hi4.x), ua.y - bfhi(hi4.x)); lo4.y = pk2(ua.z - bflo(hi4.y), ua.w - bfhi(hi4.y));
            lo4.z = pk2(ub.x - bflo(hi4.z), ub.y - bfhi(hi4.z)); lo4.w = pk2(ub.z - bflo(hi4.w), ub.w - bfhi(hi4.w));
            if (rvalid) *(u32x4*)(XN + (size_t)row * DM + k0) = hi4;
            const bf16x8_t ah = __builtin_bit_cast(bf16x8_t, hi4), al = __builtin_bit_cast(bf16x8_t, lo4);
#pragma unroll
            for (int ct = 0; ct < 3; ++ct) {
                const bf16x8_t wh = *(const bf16x8_t*)(WThi + (size_t)(16 * ct + (lane & 15)) * 1024 + k0), wl = *(const bf16x8_t*)(WTlo + (size_t)(16 * ct + (lane & 15)) * 1024 + k0);
                acc[ct] = __builtin_amdgcn_mfma_f32_16x16x32_bf16(ah, wh, acc[ct], 0, 0, 0);
                acc[ct] = __builtin_amdgcn_mfma_f32_16x16x32_bf16(ah, wl, acc[ct], 0, 0, 0);
                acc[ct] = __builtin_amdgcn_mfma_f32_16x16x32_bf16(al, wh, acc[ct], 0, 0, 0);
            }
        }
#pragma unroll
        for (int ct = 0; ct < 3; ++ct)
#pragma unroll
            for (int q = 0; q < 4; ++q) sL[(tile * 16 + 4 * kg + q) * 48 + 16 * ct + (lane & 15)] = acc[ct][q];
    }
    __syncthreads();
    if (F.tid < nrow) {
        const int li = F.tid, m = r0 + li; const LAS float* lg = sL + li * 48;
        const float g0 = lg[0] + bg[0], g1 = lg[1] + bg[1], g2 = lg[2] + bg[2], g3 = lg[3] + bg[3];
        int gs = 0; float gm = g0; if (g1 > gm) { gm = g1; gs = 1; } if (g2 > gm) { gm = g2; gs = 2; } if (g3 > gm) { gm = g3; gs = 3; }
        const float pg = 1.f / (expf(g0 - gm) + expf(g1 - gm) + expf(g2 - gm) + expf(g3 - gm));
        float e[8];
#pragma unroll
        for (int q = 0; q < 8; ++q) e[q] = lg[4 + gs * 8 + q] + br[gs * 8 + q];
        int i0 = 0; float m0 = e[0];
#pragma unroll
        for (int q = 1; q < 8; ++q) if (e[q] > m0) { m0 = e[q]; i0 = q; }
        int i1 = -1; float m1 = -INFINITY;
#pragma unroll
        for (int q = 0; q < 8; ++q) if (q != i0 && e[q] > m1) { m1 = e[q]; i1 = q; }
        if (i1 < 0) i1 = (i0 + 1) & 7;
        const float p1 = expf(m1 - m0), den = 1.f / (1.f + p1);
        TOKE[2 * m] = gs * 8 + i0; TOKE[2 * m + 1] = gs * 8 + i1;
        sE[2 * li] = gs * 8 + i0; sE[2 * li + 1] = gs * 8 + i1; sG[2 * li] = pg * den; sG[2 * li + 1] = pg * p1 * den;
    }
    __syncthreads();
    const int na = 2 * nrow;
    for (int i = F.tid; i < na; i += 512) { const int e = sE[i]; int r = 0; for (int j = 0; j < i; ++j) r += (sE[j] == e) ? 1 : 0; sRank[i] = r; }
    if (F.tid < NEXP) { int c = 0; for (int i = 0; i < na; ++i) c += (sE[i] == F.tid) ? 1 : 0;
        sBase[F.tid] = c ? (int)__hip_atomic_fetch_add(CNT + F.tid, (unsigned)c, __ATOMIC_RELAXED, __HIP_MEMORY_SCOPE_AGENT) : 0; }
    __syncthreads();
    int* LIST = WSP(int, WS_LIST); float* GLIST = WSP(float, WS_GLIST);
    for (int i = F.tid; i < na; i += 512) { const int e = sE[i], rank = sBase[e] + sRank[i]; TOKR[2 * r0 + i] = rank;
        LIST[(size_t)e * M + rank] = r0 + (i >> 1); GLIST[(size_t)e * M + rank] = sG[i]; }
    __syncthreads();
}

__device__ __forceinline__ void norm2_route(const Frame& F, int layer) {
    if (F.G * 65 != M) { norm2_route_generic(F, layer); return; }
    typedef short bf16x8_t __attribute__((ext_vector_type(8)));
    const float* H = WSP(float, WS_H); bf16* XN = WSP(bf16, WS_XN);
    int* TOKE = WSP(int, WS_TOKE); int* TOKR = WSP(int, WS_TOKR);
    unsigned* CNT = WSP(unsigned, WS_CTL) + CW_CNT + 64 * layer;
    const float* gain = F.in[11] + layer * DM; const float* bg = F.in[13] + layer * 4; const float* br = F.in[15] + layer * 32;
    const float* wgf = F.in[12] + (size_t)layer * DM * 4; const float* wrf = F.in[14] + (size_t)layer * DM * 32;
    const bf16* WThi = WSP(bf16, WS_WRT) + (size_t)(layer * 2) * 48 * 1024; const bf16* WTlo = WThi + 48 * 1024;
    const int lane = F.lane, wave = F.wave, nrow = 65;
#define GROW(li) ((li) < 64 ? 64 * F.blk + (li) : 64 * F.G + F.blk)
    LAS int* sE = (LAS int*)F.lds; LAS int* sRank = sE + 2048; LAS int* sBase = sRank + 2048;
    LAS float* sR = (LAS float*)(sBase + 64);
    LAS float* sL = sR + 1024;
    LAS float* sG = sL + 96 * 48;
    LAS float* slab = sG + 1024;
    LAS float* xl = slab + 4 * 64 * 48;
    const int kq = wave & 3, rh = wave >> 2, l15 = lane & 15, kg = lane >> 4;
    f32x4 xa[2][8], xb[2][8];
#pragma unroll
    for (int t = 0; t < 2; ++t)
#pragma unroll
        for (int ks = 0; ks < 8; ++ks) { const size_t row = (size_t)64 * F.blk + 32 * rh + 16 * t + l15; const int k0 = 256 * kq + 32 * ks + 8 * kg;
            xa[t][ks] = *(const f32x4*)(H + row * DM + k0); xb[t][ks] = *(const f32x4*)(H + row * DM + k0 + 4); }
    const size_t mx = GROW(64); const int kx = 128 * wave + 2 * lane;
    const f32x2 xv = *(const f32x2*)(H + mx * DM + kx);
#pragma unroll
    for (int t = 0; t < 2; ++t) { float ss = 0.f;
#pragma unroll
        for (int ks = 0; ks < 8; ++ks) ss += ((xa[t][ks].x * xa[t][ks].x + xa[t][ks].y * xa[t][ks].y) + (xa[t][ks].z * xa[t][ks].z + xa[t][ks].w * xa[t][ks].w))
                                           + ((xb[t][ks].x * xb[t][ks].x + xb[t][ks].y * xb[t][ks].y) + (xb[t][ks].z * xb[t][ks].z + xb[t][ks].w * xb[t][ks].w));
        ss += __shfl_xor(ss, 16); ss += __shfl_xor(ss, 32);
        if (lane < 16) sR[kq * 64 + 32 * rh + 16 * t + l15] = ss; }
    { const float sx = wave_sum(xv.x * xv.x + xv.y * xv.y); if (lane == 0) sR[256 + wave] = sx; }
    if (F.tid < 36) sR[512 + F.tid] = F.tid < 4 ? bg[F.tid] : br[F.tid - 4];
    float xu0, xu1;
    {
        const int k = kx; const f32x2 gv = *(const f32x2*)(gain + k);
        const float u0 = xv.x * gv.x, u1 = xv.y * gv.y; xu0 = u0; xu1 = u1;
        { const f32x4 a0 = *(const f32x4*)(wgf + (size_t)k * 4), a1 = *(const f32x4*)(wgf + (size_t)(k + 1) * 4);
          const float p0 = wave_sum(u0 * a0.x + u1 * a1.x), p1 = wave_sum(u0 * a0.y + u1 * a1.y), p2 = wave_sum(u0 * a0.z + u1 * a1.z), p3 = wave_sum(u0 * a0.w + u1 * a1.w);
          if (lane == 0) { xl[wave * 36 + 0] = p0; xl[wave * 36 + 1] = p1; xl[wave * 36 + 2] = p2; xl[wave * 36 + 3] = p3; } }
#pragma unroll
        for (int e4 = 0; e4 < 8; ++e4) { const f32x4 b0 = *(const f32x4*)(wrf + (size_t)k * 32 + 4 * e4), b1 = *(const f32x4*)(wrf + (size_t)(k + 1) * 32 + 4 * e4);
            const float p0 = wave_sum(u0 * b0.x + u1 * b1.x), p1 = wave_sum(u0 * b0.y + u1 * b1.y), p2 = wave_sum(u0 * b0.z + u1 * b1.z), p3 = wave_sum(u0 * b0.w + u1 * b1.w);
            if (lane == 0) { xl[wave * 36 + 4 + 4 * e4] = p0; xl[wave * 36 + 5 + 4 * e4] = p1; xl[wave * 36 + 6 + 4 * e4] = p2; xl[wave * 36 + 7 + 4 * e4] = p3; }
            __builtin_amdgcn_sched_barrier(0); }
    }
    __syncthreads();
    {
        float rr[2];
#pragma unroll
        for (int t = 0; t < 2; ++t) { const int li = 32 * rh + 16 * t + l15; rr[t] = rsqrtf(((sR[li] + sR[64 + li]) + (sR[128 + li] + sR[192 + li])) * (1.f / DM) + EPS); }
        f32x4 acc[2][3];
#pragma unroll
        for (int t = 0; t < 2; ++t)
#pragma unroll
            for (int ct = 0; ct < 3; ++ct) acc[t][ct] = (f32x4){0.f, 0.f, 0.f, 0.f};
#pragma unroll
        for (int ks = 0; ks < 8; ++ks) {
            const int k0 = 256 * kq + 32 * ks + 8 * kg;
            const f32x4 ga = *(const f32x4*)(gain + k0), gb = *(const f32x4*)(gain + k0 + 4);
            bf16x8_t wh[3], wl[3];
#pragma unroll
            for (int ct = 0; ct < 3; ++ct) { wh[ct] = *(const bf16x8_t*)(WThi + (size_t)(16 * ct + l15) * 1024 + k0); wl[ct] = *(const bf16x8_t*)(WTlo + (size_t)(16 * ct + l15) * 1024 + k0); }
#pragma unroll
            for (int t = 0; t < 2; ++t) { const size_t row = (size_t)64 * F.blk + 32 * rh + 16 * t + l15;
                const f32x4 ua = xa[t][ks] * rr[t] * ga, ub = xb[t][ks] * rr[t] * gb;
                u32x4 hi4; hi4.x = pk2(ua.x, ua.y); hi4.y = pk2(ua.z, ua.w); hi4.z = pk2(ub.x, ub.y); hi4.w = pk2(ub.z, ub.w);
                u32x4 lo4; lo4.x = pk2(ua.x - bflo(hi4.x), ua.y - bfhi(hi4.x)); lo4.y = pk2(ua.z - bflo(hi4.y), ua.w - bfhi(hi4.y));
                lo4.z = pk2(ub.x - bflo(hi4.z), ub.y - bfhi(hi4.z)); lo4.w = pk2(ub.z - bflo(hi4.w), ub.w - bfhi(hi4.w));
                *(u32x4*)(XN + row * DM + k0) = hi4;
                const bf16x8_t ah = __builtin_bit_cast(bf16x8_t, hi4), al = __builtin_bit_cast(bf16x8_t, lo4);
#pragma unroll
                for (int ct = 0; ct < 3; ++ct) {
                    acc[t][ct] = __builtin_amdgcn_mfma_f32_16x16x32_bf16(ah, wh[ct], acc[t][ct], 0, 0, 0);
                    acc[t][ct] = __builtin_amdgcn_mfma_f32_16x16x32_bf16(ah, wl[ct], acc[t][ct], 0, 0, 0);
                    acc[t][ct] = __builtin_amdgcn_mfma_f32_16x16x32_bf16(al, wh[ct], acc[t][ct], 0, 0, 0);
                } }
            __builtin_amdgcn_sched_barrier(0);
        }
#pragma unroll
        for (int t = 0; t < 2; ++t)
#pragma unroll
            for (int ct = 0; ct < 3; ++ct)
#pragma unroll
                for (int q = 0; q < 4; ++q) slab[(kq * 64 + 32 * rh + 16 * t + 4 * kg + q) * 48 + 16 * ct + l15] = acc[t][ct][q];
    }
    {
        float sx = 0.f;
#pragma unroll
        for (int w = 0; w < 8; ++w) sx += sR[256 + w];
        const float rr = rsqrtf(sx * (1.f / DM) + EPS);
        *(unsigned*)(XN + mx * DM + kx) = pk2(xu0 * rr, xu1 * rr);
    }
    __syncthreads();
    for (int idx = F.tid; idx < 65 * 36; idx += 512) { const int li = idx / 36, q = idx % 36;
        const float bias_q = sR[512 + q];
        float v_;
        if (li < 64) v_ = (slab[li * 48 + q] + slab[(64 + li) * 48 + q]) + (slab[(128 + li) * 48 + q] + slab[(192 + li) * 48 + q]);
        else { v_ = 0.f; float sx = 0.f;
#pragma unroll
            for (int w = 0; w < 8; ++w) { v_ += xl[w * 36 + q]; sx += sR[256 + w]; }
            v_ *= rsqrtf(sx * (1.f / DM) + EPS); }
        sL[li * 48 + q] = v_ + bias_q; }
    __syncthreads();
    if (F.tid < nrow) {
        const int li = F.tid; const size_t m = GROW(li); const LAS float* lg = sL + li * 48;
        const float g0 = lg[0], g1 = lg[1], g2 = lg[2], g3 = lg[3];
        int gs = 0; float gm = g0; if (g1 > gm) { gm = g1; gs = 1; } if (g2 > gm) { gm = g2; gs = 2; } if (g3 > gm) { gm = g3; gs = 3; }
        const float pg = 1.f / (expf(g0 - gm) + expf(g1 - gm) + expf(g2 - gm) + expf(g3 - gm));
        float e[8];
#pragma unroll
        for (int q = 0; q < 8; ++q) e[q] = lg[4 + gs * 8 + q];
        int i0 = 0; float m0 = e[0];
#pragma unroll
        for (int q = 1; q < 8; ++q) if (e[q] > m0) { m0 = e[q]; i0 = q; }
        int i1 = -1; float m1 = -INFINITY;
#pragma unroll
        for (int q = 0; q < 8; ++q) if (q != i0 && e[q] > m1) { m1 = e[q]; i1 = q; }
        if (i1 < 0) i1 = (i0 + 1) & 7;
        const float p1 = expf(m1 - m0), den = 1.f / (1.f + p1);
        TOKE[2 * m] = gs * 8 + i0; TOKE[2 * m + 1] = gs * 8 + i1;
        sE[2 * li] = gs * 8 + i0; sE[2 * li + 1] = gs * 8 + i1; sG[2 * li] = pg * den; sG[2 * li + 1] = pg * p1 * den;
    }
    __syncthreads();
    const int na = 2 * nrow;
    for (int i = F.tid; i < na; i += 512) { const int e = sE[i]; int r = 0; for (int j = 0; j < i; ++j) r += (sE[j] == e) ? 1 : 0; sRank[i] = r; }
    if (F.tid < NEXP) { int c = 0; for (int i = 0; i < na; ++i) c += (sE[i] == F.tid) ? 1 : 0;
        sBase[F.tid] = c ? (int)__hip_atomic_fetch_add(CNT + F.tid, (unsigned)c, __ATOMIC_RELAXED, __HIP_MEMORY_SCOPE_AGENT) : 0; }
    __syncthreads();
    int* LIST = WSP(int, WS_LIST); float* GLIST = WSP(float, WS_GLIST);
    for (int i = F.tid; i < na; i += 512) { const int e = sE[i], rank = sBase[e] + sRank[i]; const int m = GROW(i >> 1); TOKR[2 * m + (i & 1)] = rank;
        LIST[(size_t)e * M + rank] = m; GLIST[(size_t)e * M + rank] = sG[i]; }
    __syncthreads();
#undef GROW
}

__device__ __forceinline__ void moe_tile_bases(const Frame& F, int layer, LAS int* tb) {
    unsigned* CNT = WSP(unsigned, WS_CTL) + CW_CNT + 64 * layer;
    if (F.tid < NEXP) tb[40 + F.tid] = (int)__hip_atomic_load(CNT + F.tid, __ATOMIC_RELAXED, __HIP_MEMORY_SCOPE_AGENT);
    __syncthreads();
    if (F.tid == 0) { int acc = 0;
#pragma unroll
        for (int e = 0; e < NEXP; ++e) { tb[e] = acc; acc += (tb[40 + e] + 255) >> 8; } tb[NEXP] = acc; }
    __syncthreads();
    if (F.tid < 168) { int e = 0;
#pragma unroll
        for (int q = 1; q < NEXP; ++q) if (tb[q] <= F.tid) e = q;
        tb[256 + F.tid] = e; }
    __syncthreads();
}
__device__ __forceinline__ void moe_gather(const Frame& F, int layer) {
    LAS int* tb = (LAS int*)(F.lds + 131072);
    moe_tile_bases(F, layer, tb);
    const bf16* XN = WSP(bf16, WS_XN); bf16* XG = WSP(bf16, WS_XG); const int* TOKE = WSP(int, WS_TOKE); const float* TOKG = WSP(float, WS_TOKG); const int* TOKR = WSP(int, WS_TOKR);
    int* TOKS = WSP(int, WS_TOKS); float* SG = WSP(float, WS_SGATE);
    const int gw = F.blk * 8 + F.wave, NGW = F.G * 8, lane = F.lane;
    for (int it = gw; it < 2 * M; it += NGW) {
        const int m = it >> 1; const int e = TOKE[it]; const int slot = 256 * tb[e] + TOKR[it];
        const u32x4* src = (const u32x4*)(XN + (size_t)m * DM); u32x4* dst = (u32x4*)(XG + (size_t)slot * DM);
        dst[lane] = src[lane]; dst[64 + lane] = src[64 + lane];
        if (lane == 0) { TOKS[it] = slot; SG[slot] = TOKG[it]; }
    }
    __syncthreads();
}
struct EpiMoeUp { bf16* HB; int s0;
    __device__ __forceinline__ void operator()(int r, int c0, const float (&a)[4], const float (&b)[4]) const {
#pragma unroll
        for (int j = 0; j < 4; ++j) HB[(size_t)(s0 + r) * DE + c0 + 16 * j] = (bf16)f2bf(siluf_(a[j]) * b[j]); } };
struct EpiMoeDown { bf16* Y; const float* SG; int s0;
    __device__ __forceinline__ void operator()(int r, int c0, const float (&a)[4], const float (&)[4]) const {
        const float g = SG[s0 + r];
#pragma unroll
        for (int j = 0; j < 4; ++j) Y[(size_t)(s0 + r) * DM + c0 + 16 * j] = (bf16)f2bf(a[j] * g); } };
__device__ __forceinline__ int tile_expert(const LAS int* tb, int t256) { int e = 0;
#pragma unroll 1
    for (int q = 1; q < NEXP; ++q) if (tb[q] <= t256) e = q;
    return e; }
__device__ __forceinline__ void moe_up_naive(const Frame& F, int layer) {
    LAS int* tb = (LAS int*)(F.lds + 131072);
    moe_tile_bases(F, layer, tb);
    const int ntile = tb[NEXP] * 2 * 8;
    for (int tile = F.blk; tile < ntile; tile += F.G) {
        const int rt = tile / 8, ct = tile % 8, e = tile_expert(tb, rt >> 1);
        EpiMoeUp E{WSP(bf16, WS_HB), rt * 128};
        const size_t wo = ((size_t)layer * NEXP + e) * DM * DE;
        ngemm_tile<true>(F, WSP(bf16, WS_XG) + (size_t)rt * 128 * DM, DM, F.in[16] + wo, F.in[17] + wo, DE, DM, ct * 64, E);
    }
    __syncthreads();
}
__device__ __forceinline__ void moe_down_naive(const Frame& F, int layer) {
    LAS int* tb = (LAS int*)(F.lds + 131072);
    moe_tile_bases(F, layer, tb);
    const int ntile = tb[NEXP] * 2 * 16;
    for (int tile = F.blk; tile < ntile; tile += F.G) {
        const int rt = tile / 16, ct = tile % 16, e = tile_expert(tb, rt >> 1);
        EpiMoeDown E{WSP(bf16, WS_Y), WSP(float, WS_SGATE), rt * 128};
        const size_t wo = ((size_t)layer * NEXP + e) * DE * DM;
        ngemm_tile<false>(F, WSP(bf16, WS_HB) + (size_t)rt * 128 * DE, DE, F.in[18] + wo, nullptr, DM, DE, ct * 64, E);
    }
    __syncthreads();
}


__device__ __forceinline__ float fast_sigmoid(float x) { return __builtin_amdgcn_rcpf(1.f + __expf(-x)); }
__device__ __forceinline__ u32x4 pack8(const float (&y)[8]) { u32x4 w; w.x = pg8::cvt_pk_bf16(y[0], y[1]); w.y = pg8::cvt_pk_bf16(y[2], y[3]); w.z = pg8::cvt_pk_bf16(y[4], y[5]); w.w = pg8::cvt_pk_bf16(y[6], y[7]); return w; }
#define ACC8(x, ai, bj, m) float x[8]; { const pg8::f32x4 _a = acc[ai][bj][m][0], _b = acc[ai][bj][m][1]; x[0] = _a[0]; x[1] = _a[1]; x[2] = _a[2]; x[3] = _a[3]; x[4] = _b[0]; x[5] = _b[1]; x[6] = _b[2]; x[7] = _b[3]; }

struct EpiInprojM {
    static constexpr bool PERM = true, AFTER_DRAIN = false;
    unsigned char* ws; int layer;
    __device__ __forceinline__ void operator()(const pg8::f32x4 (&acc)[2][2][4][2], const pg8::Unit& u, int wr, int wc, int fr, int fq) const {
        const int pn = u.pn, row0 = u.pm * 256 + wr * 64 + fr, c8 = wc * 32 + 8 * fq;
        if (pn < 2 || (pn >= 4 && pn < 8)) {
            bf16* O = (bf16*)(ws + (pn < 2 ? WS_HQ : pn < 6 ? WS_HV : WS_HG)) + (pn & 1) * 256 + c8;
            const bool act = pn < 2 || pn >= 6; const float sc = pn < 2 ? 0.08838834764831845f : 1.f;
#pragma unroll
            for (int ai = 0; ai < 2; ++ai)
#pragma unroll
                for (int m = 0; m < 4; ++m) { const size_t ro = (size_t)(row0 + ai * 128 + m * 16) * 512;
#pragma unroll
                    for (int bj = 0; bj < 2; ++bj) { ACC8(x, ai, bj, m);
                        if (act) {
#pragma unroll
                            for (int e = 0; e < 8; ++e) x[e] = x[e] * fast_sigmoid(x[e]) * sc; }
                        *(u32x4*)(O + ro + bj * 128) = pack8(x); } }
        } else if (pn < 4) {
            float* LF = (float*)(ws + WS_HLF) + (pn & 1) * 256 + c8; bf16* KK = (bf16*)(ws + WS_HK) + (pn & 1) * 256 + c8;
            const float* LBV = (const float*)(ws + WS_LBV) + layer * 512 + (pn & 1) * 256 + c8;
            float lb[2][8];
#pragma unroll
            for (int bj = 0; bj < 2; ++bj) { const f32x4 a = *(const f32x4*)(LBV + bj * 128), b = *(const f32x4*)(LBV + bj * 128 + 4);
                lb[bj][0] = a.x; lb[bj][1] = a.y; lb[bj][2] = a.z; lb[bj][3] = a.w; lb[bj][4] = b.x; lb[bj][5] = b.y; lb[bj][6] = b.z; lb[bj][7] = b.w; }
#pragma unroll
            for (int ai = 0; ai < 2; ++ai)
#pragma unroll
                for (int m = 0; m < 4; ++m) { const int row = row0 + ai * 128 + m * 16; const size_t ro = (size_t)row * 512; const bool valid = (row % LSEQ) >= PADR;
#pragma unroll
                    for (int bj = 0; bj < 2; ++bj) { ACC8(x, ai, bj, m); float lf[8], kk[8];
#pragma unroll
                        for (int e = 0; e < 8; ++e) { const float sg = fast_sigmoid(x[e]), l = lb[bj][e]; const float f = l + (1.f - l) * sg;
                            lf[e] = valid ? __logf(fmaxf(f, TINYF)) : 0.f; kk[e] = valid ? (1.f - l) * (1.f - sg) : 0.f; }
                        *(f32x4*)(LF + ro + bj * 128) = (f32x4){lf[0], lf[1], lf[2], lf[3]}; *(f32x4*)(LF + ro + bj * 128 + 4) = (f32x4){lf[4], lf[5], lf[6], lf[7]};
                        *(u32x4*)(KK + ro + bj * 128) = pack8(kk); } }
        } else if (pn < 10) {
            bf16* O = (bf16*)(ws + (pn == 8 ? WS_DQ : WS_DK)) + 32 * (2 * wc + (fq >> 1)) + 8 * (fq & 1);
            const float sc = pn == 8 ? 0.17677669529663687f * LOG2E : 1.f;
            const float* COS = (const float*)(ws + WS_COS) + 8 * (fq & 1); const float* SIN = (const float*)(ws + WS_SIN) + 8 * (fq & 1);
#pragma unroll
            for (int ai = 0; ai < 2; ++ai)
#pragma unroll
                for (int m = 0; m < 4; ++m) { const int row = row0 + ai * 128 + m * 16, t = row % LSEQ; const size_t ro = (size_t)row * 256;
                    const f32x4 c0 = *(const f32x4*)(COS + t * 16), c1 = *(const f32x4*)(COS + t * 16 + 4), s0 = *(const f32x4*)(SIN + t * 16), s1 = *(const f32x4*)(SIN + t * 16 + 4);
                    const float cs[8] = {c0.x, c0.y, c0.z, c0.w, c1.x, c1.y, c1.z, c1.w}, sn[8] = {s0.x, s0.y, s0.z, s0.w, s1.x, s1.y, s1.z, s1.w};
                    ACC8(x1, ai, 0, m); ACC8(x2, ai, 1, m); float o1[8], o2[8];
#pragma unroll
                    for (int e = 0; e < 8; ++e) { o1[e] = (x1[e] * cs[e] - x2[e] * sn[e]) * sc; o2[e] = (x2[e] * cs[e] + x1[e] * sn[e]) * sc; }
                    *(u32x4*)(O + ro) = pack8(o1); *(u32x4*)(O + ro + 16) = pack8(o2); }
        } else {
            bf16* O = (bf16*)(ws + (pn == 10 ? WS_DV : pn == 11 ? WS_FQ : pn == 12 ? WS_FK : WS_FV)) + c8;
            const float sc = pn == 11 ? 0.125f * LOG2E : 1.f;
#pragma unroll
            for (int ai = 0; ai < 2; ++ai)
#pragma unroll
                for (int m = 0; m < 4; ++m) { const size_t ro = (size_t)(row0 + ai * 128 + m * 16) * 256;
#pragma unroll
                    for (int bj = 0; bj < 2; ++bj) { ACC8(x, ai, bj, m);
#pragma unroll
                        for (int e = 0; e < 8; ++e) x[e] *= sc;
                        *(u32x4*)(O + ro + bj * 128) = pack8(x); } }
        }
    }
};
struct EpiResidM {
    static constexpr bool PERM = true, AFTER_DRAIN = false;
    float* H; const float* x; const float* meta;
    __device__ __forceinline__ void operator()(const pg8::f32x4 (&acc)[2][2][4][2], const pg8::Unit& u, int wr, int wc, int fr, int fq) const {
        const int row0 = u.pm * 256 + wr * 64 + fr, col0 = u.pn * 256 + wc * 32 + 8 * fq;
#pragma unroll
        for (int ai = 0; ai < 2; ++ai)
#pragma unroll
            for (int m = 0; m < 4; ++m) { const int row = row0 + ai * 128 + m * 16; float* rp = H + (size_t)row * DM + col0;
                const float* bp = rp;
                if (x) { const int b = row / LSEQ, t = row % LSEQ; bp = t < PADR ? nullptr : t < 128 ? meta + (size_t)(t - PADR) * DM + col0 : x + ((size_t)b * SEQ + (t - 128)) * DM + col0; }
#pragma unroll
                for (int bj = 0; bj < 2; ++bj) { f32x4 a = (f32x4){0.f, 0.f, 0.f, 0.f}, b = a;
                    if (bp) { a = *(const f32x4*)(bp + bj * 128); b = *(const f32x4*)(bp + bj * 128 + 4); }
                    a += acc[ai][bj][m][0]; b += acc[ai][bj][m][1];
                    *(f32x4*)(rp + bj * 128) = a; *(f32x4*)(rp + bj * 128 + 4) = b; } }
    }
};
struct EpiMoeUpM {
    static constexpr bool PERM = true, AFTER_DRAIN = false;
    bf16* HB;
    __device__ __forceinline__ void operator()(const pg8::f32x4 (&acc)[2][2][4][2], const pg8::Unit& u, int wr, int wc, int fr, int fq) const {
        const int row0 = u.pm * 256 + wr * 64 + fr, col0 = (u.pn & 3) * 128 + wc * 32 + 8 * fq;
#pragma unroll
        for (int ai = 0; ai < 2; ++ai)
#pragma unroll
            for (int m = 0; m < 4; ++m) { ACC8(a, ai, 0, m); ACC8(b, ai, 1, m); float h[8];
#pragma unroll
                for (int e = 0; e < 8; ++e) h[e] = a[e] * fast_sigmoid(a[e]) * b[e];
                *(u32x4*)(HB + (size_t)(row0 + ai * 128 + m * 16) * DE + col0) = pack8(h); }
    }
};
struct EpiMoeDownM {
    static constexpr bool PERM = true, AFTER_DRAIN = false;
    bf16* Y; const float* GLIST; const LAS int* tb;
    __device__ __forceinline__ void operator()(const pg8::f32x4 (&acc)[2][2][4][2], const pg8::Unit& u, int wr, int wc, int fr, int fq) const {
        const int row0 = u.pm * 256 + wr * 64 + fr, col0 = (u.pn & 3) * 256 + wc * 32 + 8 * fq, e = u.pn >> 2, rk0 = 256 * (u.pm - tb[e]) + wr * 64 + fr, cnt = tb[40 + e];
#pragma unroll
        for (int ai = 0; ai < 2; ++ai)
#pragma unroll
            for (int m = 0; m < 4; ++m) { const int row = row0 + ai * 128 + m * 16, rk = rk0 + ai * 128 + m * 16; const float g = rk < cnt ? GLIST[(size_t)e * M + rk] : 0.f;
#pragma unroll
                for (int bj = 0; bj < 2; ++bj) { ACC8(x, ai, bj, m);
#pragma unroll
                    for (int e_ = 0; e_ < 8; ++e_) x[e_] *= g;
                    *(u32x4*)(Y + (size_t)row * DM + col0 + bj * 128) = pack8(x); } }
    }
};
template <bool GATHER_> struct MoeOrder {
    static constexpr bool GATHER = GATHER_;
    int nwg, G, c; const LAS int* tb; const int* LIST;
    __device__ __forceinline__ bool next(int i, pg8::Unit& u) const {
        const int L = i * G + c; if (L >= nwg) return false;
        const int q = nwg / 8, r = nwg % 8, xcd = L % 8, off = L / 8;
        const int id = (xcd < r ? xcd * (q + 1) : r * (q + 1) + (xcd - r) * q) + off;
        const int rt = id >> 2, e = tb[256 + rt];
        u.pm = rt; u.pn = e * 4 + (id & 3); return true;
    }
    __device__ __forceinline__ unsigned goff(const pg8::Unit& u, int row, int K) const {
        const int e = u.pn >> 2, rank = 256 * (u.pm - tb[e]) + row; const int tok = rank < tb[40 + e] ? LIST[(size_t)e * M + rank] : 0;
        return (unsigned)tok * (unsigned)K * 2u; }
    __device__ __forceinline__ void a_ready(const pg8::Unit&) const {}
    __device__ __forceinline__ void done(const pg8::Unit&) const {}
};

__device__ __forceinline__ void cvt_item(const float* W, int ld, int k0, int srccol  , bf16* WT, int K, int dr0, LAS float* scr, int lane) {
    float tv[32];
#pragma unroll
    for (int i = 0; i < 32; ++i) tv[i] = __builtin_nontemporal_load(W + (size_t)(k0 + 2 * i + (lane >> 5)) * ld + srccol);
#pragma unroll
    for (int i = 0; i < 32; ++i) scr[(2 * i + (lane >> 5)) * 33 + (lane & 31)] = tv[i];
    asm volatile("s_waitcnt lgkmcnt(0)" ::: "memory");
    const int c = lane & 7;
#pragma unroll
    for (int j = 0; j < 4; ++j) { const int n = (lane >> 3) + 8 * j; const LAS float* p = scr + (8 * c) * 33 + n;
        u32x4 o; o.x = pg8::cvt_pk_bf16(p[0 * 33], p[1 * 33]); o.y = pg8::cvt_pk_bf16(p[2 * 33], p[3 * 33]); o.z = pg8::cvt_pk_bf16(p[4 * 33], p[5 * 33]); o.w = pg8::cvt_pk_bf16(p[6 * 33], p[7 * 33]);
        *(u32x4*)(WT + (size_t)(dr0 + n) * K + k0 + 8 * c) = o; }
    asm volatile("s_waitcnt lgkmcnt(0)" ::: "memory");
}
__device__ __forceinline__ void convert_static_weights(const Frame& F) {
    LAS float* scr = (LAS float*)(F.lds + F.wave * 16384);
    const int gw = F.blk * 8 + F.wave, NGW = F.G * 8, lane = F.lane;
    constexpr int NA = 2 * 16 * 112, NB = 2 * 16 * 32;
    for (int it = gw; it < NA + NB; it += NGW) {
        if (it < NA) { const int l = it / (16 * 112), r = it % (16 * 112), kb = r / 112, nb = r % 112;
            const int n = nb * 32 + (lane & 31); int sc = n;
            if (n >= 2048 && n < 2560) { const int p = n & 255, hp = p & 127; sc = (n & ~255) + 32 * (hp >> 4) + (p >> 7) * 16 + (hp & 15); }
            cvt_item(F.in[3] + (size_t)l * DM * INW, INW, kb * 64, sc, WSP(bf16, WS_WIN) + (size_t)l * 3584 * DM, DM, nb * 32, scr, lane);
        } else { const int r0 = it - NA, l = r0 / (16 * 32), r = r0 % (16 * 32), kb = r / 32, nb = r % 32;
            cvt_item(F.in[10] + (size_t)l * DM * DM, DM, kb * 64, nb * 32 + (lane & 31), WSP(bf16, WS_WOUT) + (size_t)l * DM * DM, DM, nb * 32, scr, lane);
        }
    }
}
__device__ __forceinline__ void cvt_w13_item(const Frame& F, int layer, int it, LAS float* scr, int lane) {
    const int e = it / (16 * 32), r = it % (16 * 32), kb = r / 32, nb = r % 32;
    const int tile = nb >> 3, rr = (nb & 7) * 32;
    const float* src = (rr < 128 ? F.in[16] : F.in[17]) + ((size_t)layer * NEXP + e) * DM * DE;
    cvt_item(src, DE, kb * 64, 128 * tile + (rr & 127) + (lane & 31), WSP(bf16, WS_W13) + (size_t)e * DM * DM, DM, nb * 32, scr, lane);
}
__device__ __forceinline__ void cvt_w2_item(const Frame& F, int layer, int it, LAS float* scr, int lane) {
    const int le = layer * NEXP + it / (8 * 32), r = it % (8 * 32), kb = r / 32, nb = r % 32;
    cvt_item(F.in[18] + (size_t)le * DE * DM, DM, kb * 64, nb * 32 + (lane & 31), WSP(bf16, WS_W2) + (size_t)le * DM * DE, DE, nb * 32, scr, lane);
}
constexpr int NW13 = 32 * 16 * 32, NW2 = 32 * 8 * 32;
__device__ __forceinline__ void tail_convert(const Frame& F, int kind, int layer, int i0, int i1, int nwg, bool skip_last = false) {
    const int r = nwg % F.G; int prank = F.blk, np = F.G;
    if (r != 0 && F.G - r >= 32) { if (F.blk < r) return; prank = F.blk - r; np = F.G - r;
        if (skip_last) { if (F.blk == F.G - 1) return; --np; } }
    LAS float* scr = (LAS float*)(F.lds + F.wave * 16384);
#pragma unroll 1
    for (int it = i0 + prank * 8 + F.wave; it < i1; it += np * 8) { if (kind == 0) cvt_w13_item(F, layer, it, scr, F.lane); else cvt_w2_item(F, layer, it, scr, F.lane); }
}
__device__ __forceinline__ void gemm1_mfma(const Frame& F, int layer) {
    pg8::Gemm g{(const pg8::bf16_t*)WSP(bf16, WS_XN), (const pg8::bf16_t*)(WSP(bf16, WS_WIN) + (size_t)layer * 3584 * DM), M, 3584, DM};
    pg8::StaticOrder S; S.init(M, 3584, F.G, F.blk);
    EpiInprojM E{F.ws, layer};
    pg8::gemm_phase<EpiInprojM, pg8::StaticOrder, true, true>(F.lds, g, S, E);
}
constexpr int G2_PANELS = 64;
struct OneUnitOrder {
    static constexpr bool GATHER = false;
    int pm, pn;
    __device__ __forceinline__ unsigned goff(const pg8::Unit&, int, int) const { return 0u; }
    __device__ __forceinline__ bool next(int i, pg8::Unit& u) const { if (i != 0) return false; u.pm = pm; u.pn = pn; return true; }
    __device__ __forceinline__ void a_ready(const pg8::Unit&) const {}
    __device__ __forceinline__ void done(const pg8::Unit&) const {}
};
__device__ __forceinline__ void gemm2_unit(const Frame& F, int layer, int pm, int pn);
__device__ __forceinline__ void gemm2_mfma(const Frame& F, int layer) {
    pg8::Gemm g{(const pg8::bf16_t*)WSP(bf16, WS_MIX), (const pg8::bf16_t*)(WSP(bf16, WS_WOUT) + (size_t)layer * DM * DM), M, DM, DM};
    pg8::StaticOrder S; S.init(G2_PANELS * 256, DM, F.G, F.blk);
    EpiResidM E{WSP(float, WS_H), layer == 0 ? F.in[0] : nullptr, F.in[1]};
    pg8::gemm_phase<EpiResidM, pg8::StaticOrder, true, true>(F.lds, g, S, E);
}
__device__ __forceinline__ void gemm2_unit(const Frame& F, int layer, int pm, int pn) {
    pg8::Gemm g{(const pg8::bf16_t*)WSP(bf16, WS_MIX), (const pg8::bf16_t*)(WSP(bf16, WS_WOUT) + (size_t)layer * DM * DM), M, DM, DM};
    OneUnitOrder S{pm, pn};
    EpiResidM E{WSP(float, WS_H), layer == 0 ? F.in[0] : nullptr, F.in[1]};
    pg8::gemm_phase<EpiResidM, OneUnitOrder, true, true>(F.lds, g, S, E);
}
__device__ __forceinline__ void moe_up_mfma(const Frame& F, int layer) {
    LAS int* tb = (LAS int*)(F.lds + 131072);
    moe_tile_bases(F, layer, tb);
    pg8::Gemm g{(const pg8::bf16_t*)WSP(bf16, WS_XN), (const pg8::bf16_t*)WSP(bf16, WS_W13), MAXSLOT, NEXP * 1024, DM};
    MoeOrder<true> S{tb[NEXP] * 4, F.G, F.blk, tb, WSP(int, WS_LIST)};
    EpiMoeUpM E{WSP(bf16, WS_HB)};
    pg8::gemm_phase<EpiMoeUpM, MoeOrder<true>, true, true>(F.lds, g, S, E);
}
__device__ __forceinline__ void moe_down_mfma(const Frame& F, int layer) {
    LAS int* tb = (LAS int*)(F.lds + 131072);
    pg8::Gemm g{(const pg8::bf16_t*)WSP(bf16, WS_HB), (const pg8::bf16_t*)(WSP(bf16, WS_W2) + (size_t)layer * NEXP * DM * DE), MAXSLOT, NEXP * 1024, DE};
    MoeOrder<false> S{tb[NEXP] * 4, F.G, F.blk, tb, nullptr};
    EpiMoeDownM E{WSP(bf16, WS_Y), WSP(float, WS_GLIST), tb};
    pg8::gemm_phase<EpiMoeDownM, MoeOrder<false>, true, true>(F.lds, g, S, E);
}

namespace att {
typedef short bf16x8 __attribute__((ext_vector_type(8)));
typedef short s16x4 __attribute__((ext_vector_type(4)));
typedef float f32x16 __attribute__((ext_vector_type(16)));
constexpr int KSLOT = 10240, VSLOT = 8192;
constexpr int L_K = 0, L_V = 2 * KSLOT, L_WS = L_V + 2 * VSLOT, L_OA = L_WS + 2048, L_OB = L_OA + 32768, L_ITEM = L_OB + 32768;
constexpr float THR = 8.f;
__device__ __forceinline__ int crow(int r, int hi) { return (r & 3) + 8 * (r >> 2) + 4 * hi; }
__device__ __forceinline__ float max3f(float a, float b, float c) { float r; asm("v_max3_f32 %0, %1, %2, %3" : "=v"(r) : "v"(a), "v"(b), "v"(c)); return r; }
typedef float f32x2_t __attribute__((ext_vector_type(2))); typedef __bf16 bf16x2_t __attribute__((ext_vector_type(2)));
__device__ __forceinline__ unsigned cvtpk_s(float lo, float hi) { f32x2_t v = {lo, hi}; bf16x2_t b = __builtin_convertvector(v, bf16x2_t); return __builtin_bit_cast(unsigned, b); }
__device__ __forceinline__ void cmask(f32x16& p0, f32x16& p1, int jb, int qrel, int hi) {
    const float NEG = -INFINITY; const int kb = 64 * jb + 4 * hi;
#pragma unroll
    for (int r = 0; r < 16; ++r) { const int kv = kb + (r & 3) + 8 * (r >> 2); if (kv > qrel) p0[r] = NEG; if (kv + 32 > qrel) p1[r] = NEG; }
}
template <int NS> __device__ __forceinline__ void qkt(f32x16& p0, f32x16& p1, const LAS char* kb, const bf16x8* qr, const f32x16& negm) {
#pragma unroll
    for (int d0 = 0; d0 < NS; ++d0) {
        const bf16x8 b0 = *(const LAS bf16x8*)(kb + d0 * 2048), b1 = *(const LAS bf16x8*)(kb + d0 * 2048 + 512);
        if (d0 == 0) { p0 = __builtin_amdgcn_mfma_f32_32x32x16_bf16(b0, qr[0], negm, 0, 0, 0); p1 = __builtin_amdgcn_mfma_f32_32x32x16_bf16(b1, qr[0], negm, 0, 0, 0); }
        else { p0 = __builtin_amdgcn_mfma_f32_32x32x16_bf16(b0, qr[d0], p0, 0, 0, 0); p1 = __builtin_amdgcn_mfma_f32_32x32x16_bf16(b1, qr[d0], p1, 0, 0, 0); }
    }
}
__device__ __forceinline__ float rowmax(const f32x16& p0, const f32x16& p1) {
#define MX3_(a, b, c) __builtin_fmaxf(__builtin_fmaxf((a), (b)), (c))
    float a = MX3_(p0[0], p0[1], p1[0]), b = MX3_(p0[2], p0[3], p1[1]); a = MX3_(a, p1[2], p1[3]);
#pragma unroll
    for (int r = 4; r < 16; r += 4) { a = MX3_(a, p0[r], p0[r + 1]); b = MX3_(b, p0[r + 2], p0[r + 3]); a = MX3_(a, p1[r], p1[r + 1]); b = MX3_(b, p1[r + 2], p1[r + 3]); }
#undef MX3_
    const float m = __builtin_fmaxf(a, b);
    auto rr = __builtin_amdgcn_permlane32_swap(__float_as_uint(m), __float_as_uint(m), false, false);
    return __builtin_fmaxf(__uint_as_float(rr[0]), __uint_as_float(rr[1]));
}
__device__ __forceinline__ void pv(f32x16* o, int vb, bf16x8 pa0, bf16x8 pa1, bf16x8 pa2, bf16x8 pa3) {
#pragma unroll
    for (int d0 = 0; d0 < 2; ++d0) { s16x4 lo[4], hi[4];
#pragma unroll
        for (int ks = 0; ks < 4; ++ks) {
            asm volatile("ds_read_b64_tr_b16 %0,%1 offset:%c2" : "=&v"(lo[ks]) : "v"(vb), "i"(d0 * 4096 + ks * 1024) : "memory");
            asm volatile("ds_read_b64_tr_b16 %0,%1 offset:%c2" : "=&v"(hi[ks]) : "v"(vb), "i"(d0 * 4096 + ks * 1024 + 512) : "memory"); }
        asm volatile("s_waitcnt lgkmcnt(0)" ::: "memory"); __builtin_amdgcn_sched_barrier(0);
#define PK(k) (bf16x8){lo[k][0], lo[k][1], lo[k][2], lo[k][3], hi[k][0], hi[k][1], hi[k][2], hi[k][3]}
        o[d0] = __builtin_amdgcn_mfma_f32_32x32x16_bf16(pa0, PK(0), o[d0], 0, 0, 0);
        o[d0] = __builtin_amdgcn_mfma_f32_32x32x16_bf16(pa1, PK(1), o[d0], 0, 0, 0);
        o[d0] = __builtin_amdgcn_mfma_f32_32x32x16_bf16(pa2, PK(2), o[d0], 0, 0, 0);
        o[d0] = __builtin_amdgcn_mfma_f32_32x32x16_bf16(pa3, PK(3), o[d0], 0, 0, 0);
#undef PK
    }
}
template <bool DIFF>
__device__ __forceinline__ void attn_map(LAS unsigned char* lds, const GAS bf16* Qrow, const GAS bf16* Kb, const GAS bf16* Vb, const GAS bf16* KX, int NT, int wid, int lane, f32x16 (&o)[2]) {
    constexpr int NQK = DIFF ? 2 : 4, NS = NQK + 1, BAND = DIFF ? 2 : 4;
    const int r32 = lane & 31, hi = lane >> 5, wrow = DIFF ? (wid & 3) : wid, cmap = DIFF ? (wid >> 2) : 0;
    bf16x8 qr[NS];
#pragma unroll
    for (int d0 = 0; d0 < NQK; ++d0) qr[d0] = *(const GAS bf16x8*)(Qrow + d0 * 16 + hi * 8);
    { const short m1 = hi == 0 ? (short)0xBF80 : (short)0; qr[NQK] = (bf16x8){m1, m1, 0, 0, 0, 0, 0, 0}; }
    float mhat = 0.f, l = 0.f; o[0] = f32x16{}; o[1] = f32x16{}; f32x16 negm = f32x16{};
    const int qrel = wrow * 32 + r32, tlast = NT - BAND + (wrow >> 1);
    LAS float* wsf = (LAS float*)(lds + L_WS) + wid * 64;
    const int vb0 = (int)(unsigned)(uintptr_t)(lds + L_V) + ((lane >> 4) & 1) * 32 + (lane & 3) * 8 + (4 * hi + ((lane & 15) >> 2)) * 64;
    const int kdoff = cmap * 4096 + hi * 1024 + r32 * 16;
    u32x4 sk = (u32x4){0u, 0u, 0u, 0u}, sx = sk, sv = sk;
#define LOADT(t) do { const size_t key0_ = (size_t)64 * ((t) + 1); \
        sk = *(const GAS u32x4*)(Kb + (key0_ + lane) * 256 + wid * 8); \
        if (wid == 7) sx = *(const GAS u32x4*)(KX + (key0_ + lane) * 8); \
        sv = *(const GAS u32x4*)(Vb + (key0_ + 16 * (wid & 3) + (lane >> 2)) * 256 + (wid >> 2) * 32 + (lane & 3) * 8); } while (0)
#define STORET(buf) do { LAS unsigned char* kd_ = lds + L_K + (buf) * KSLOT; \
        *(LAS u32x4*)(kd_ + wid * 1024 + lane * 16) = sk; \
        if (wid == 7) *(LAS u32x4*)(kd_ + 8 * 1024 + lane * 16) = sx; \
        *(LAS u32x4*)(lds + L_V + (buf) * VSLOT + wid * 1024 + lane * 16) = sv; } while (0)
    if (wid == 6) { *(LAS u32x4*)(lds + L_K + 9 * 1024 + lane * 16) = (u32x4){0u, 0u, 0u, 0u}; *(LAS u32x4*)(lds + L_K + KSLOT + 9 * 1024 + lane * 16) = (u32x4){0u, 0u, 0u, 0u}; }
    LOADT(NT - 1); STORET(0);
    __syncthreads();
#pragma unroll 1
    for (int i_ = 0; i_ < NT; ++i_) {
        const int t = NT - 1 - i_;
        if (t > 0) LOADT(t - 1);
        const int buf = i_ & 1;
        if (t <= tlast) {
        f32x16 p0, p1;
        { const LAS char* kb = (const LAS char*)(lds + L_K + buf * KSLOT);
#pragma unroll
          for (int d0 = 0; d0 < NS; ++d0) { const LAS char* kp = d0 < NQK ? kb + kdoff + d0 * 2048 : kb + 8 * 1024 + hi * 1024 + r32 * 16;
            const bf16x8 b0 = *(const LAS bf16x8*)kp, b1 = *(const LAS bf16x8*)(kp + 512);
            if (d0 == 0) { p0 = __builtin_amdgcn_mfma_f32_32x32x16_bf16(b0, qr[0], negm, 0, 0, 0); p1 = __builtin_amdgcn_mfma_f32_32x32x16_bf16(b1, qr[0], negm, 0, 0, 0); }
            else { p0 = __builtin_amdgcn_mfma_f32_32x32x16_bf16(b0, qr[d0], p0, 0, 0, 0); p1 = __builtin_amdgcn_mfma_f32_32x32x16_bf16(b1, qr[d0], p1, 0, 0, 0); } } }
        if (t >= NT - BAND) cmask(p0, p1, t - (NT - BAND), qrel, hi);
        const float rm = rowmax(p0, p1);
        const bool first = (t == tlast);
        if (first || __any(rm > THR)) {
            const float dl = first ? rm : fmaxf(rm, 0.f);
            mhat += dl;
#pragma unroll
            for (int r = 0; r < 16; ++r) { p0[r] -= dl; p1[r] -= dl; }
#pragma unroll
            for (int r = 0; r < 16; ++r) negm[r] = -mhat;
            if (!first) {
                const float f = __builtin_amdgcn_exp2f(-dl); l *= f;
                if (hi == 0) wsf[r32] = f;
                asm volatile("s_waitcnt lgkmcnt(0)" ::: "memory");
#pragma unroll
                for (int r = 0; r < 16; ++r) { const float fr = wsf[crow(r, hi)]; o[0][r] *= fr; o[1][r] *= fr; }
            }
        }
        float sacc = 0.f;
#pragma unroll
        for (int r = 0; r < 16; ++r) { p0[r] = __builtin_amdgcn_exp2f(p0[r]); p1[r] = __builtin_amdgcn_exp2f(p1[r]); sacc += p0[r] + p1[r]; }
        l += sacc;
        u32x4 pw0, pw1, pw2, pw3;
        pw0 = (u32x4){cvtpk_s(p0[0], p0[1]), cvtpk_s(p0[2], p0[3]), cvtpk_s(p0[4], p0[5]), cvtpk_s(p0[6], p0[7])};
        pw1 = (u32x4){cvtpk_s(p0[8], p0[9]), cvtpk_s(p0[10], p0[11]), cvtpk_s(p0[12], p0[13]), cvtpk_s(p0[14], p0[15])};
        pw2 = (u32x4){cvtpk_s(p1[0], p1[1]), cvtpk_s(p1[2], p1[3]), cvtpk_s(p1[4], p1[5]), cvtpk_s(p1[6], p1[7])};
        pw3 = (u32x4){cvtpk_s(p1[8], p1[9]), cvtpk_s(p1[10], p1[11]), cvtpk_s(p1[12], p1[13]), cvtpk_s(p1[14], p1[15])};
        pv(o, vb0 + buf * VSLOT, __builtin_bit_cast(bf16x8, pw0), __builtin_bit_cast(bf16x8, pw1), __builtin_bit_cast(bf16x8, pw2), __builtin_bit_cast(bf16x8, pw3));
        }
        if (t > 0) STORET((i_ + 1) & 1);
        __syncthreads();
    }
#undef LOADT
#undef STORET
    { auto rr = __builtin_amdgcn_permlane32_swap(__float_as_uint(l), __float_as_uint(l), false, false); l = __uint_as_float(rr[0]) + __uint_as_float(rr[1]); }
    if (hi == 0) wsf[32 + r32] = l;
    asm volatile("s_waitcnt lgkmcnt(0)" ::: "memory");
#pragma unroll
    for (int r = 0; r < 16; ++r) { const float rl = __builtin_amdgcn_rcpf(wsf[32 + crow(r, hi)]); o[0][r] *= rl; o[1][r] *= rl; }
}
__device__ __forceinline__ void stage_o(LAS unsigned char* stg_base, int blk32, int lane, const f32x16 (&o)[2]) {
    LAS bf16* stg = (LAS bf16*)stg_base + blk32 * 2048; const int r32 = lane & 31, hi = lane >> 5;
#pragma unroll
    for (int r = 0; r < 16; ++r) { const int orow = crow(r, hi);
#pragma unroll
        for (int d0 = 0; d0 < 2; ++d0) stg[orow * 64 + d0 * 32 + r32] = (bf16)f2bf(o[d0][r]); }
    asm volatile("s_waitcnt lgkmcnt(0)" ::: "memory");
}
}


namespace att2 {
using att::bf16x8; using att::s16x4; using att::f32x16; using att::crow; using att::cvtpk_s;
typedef short v4i16_t __attribute__((ext_vector_type(4)));
typedef const LAS char* lds_cptr;
constexpr int SLOTB = 8192, T_K = 0, T_V = 3 * SLOTB, T_WS = 6 * SLOTB, T_OA = T_WS + 2048, T_OB = T_OA + 32768, T_END = T_OB + 32768;
static_assert(T_END <= 131072, "att2 LDS map");
constexpr float THRL = 8.f;
__device__ __forceinline__ s16x4 vtr(lds_cptr p) { return __builtin_bit_cast(s16x4, __builtin_amdgcn_ds_read_tr16_b64_v4i16((LAS v4i16_t*)p)); }
#define SBAR() __builtin_amdgcn_sched_barrier(0)
template <bool TRACK>
__device__ __forceinline__ bool diff_unit(LAS unsigned char* lds, const GAS bf16* Qrow, const GAS bf16* Kb, const GAS bf16* Vb, int NT, int wid, int lane, f32x16 (&o)[2]) {
    const int r32 = lane & 31, hi = lane >> 5, wrow = wid & 3, cmap = wid >> 2;
    bf16x8 qr[2];
#pragma unroll
    for (int d0 = 0; d0 < 2; ++d0) qr[d0] = *(const GAS bf16x8*)(Qrow + d0 * 16 + hi * 8);
    float mhat = 0.f; o[0] = f32x16{}; o[1] = f32x16{}; f32x16 negm = f32x16{}; asm volatile("" : "+v"(negm));
    f32x16 o2 = f32x16{};
    const bf16x8 ones = (r32 == 0) ? (bf16x8){(short)0x3F80, (short)0x3F80, (short)0x3F80, (short)0x3F80, (short)0x3F80, (short)0x3F80, (short)0x3F80, (short)0x3F80} : (bf16x8){0, 0, 0, 0, 0, 0, 0, 0};
    const int qrel = wrow * 32 + r32;
    LAS float* wsf = (LAS float*)(lds + T_WS) + wid * 64;
    const lds_cptr kp0 = (lds_cptr)(lds + T_K) + cmap * 4096 + hi * 1024 + r32 * 16;
    const lds_cptr vp0 = (lds_cptr)(lds + T_V) + ((lane >> 4) & 1) * 32 + (lane & 3) * 8 + (4 * hi + ((lane & 15) >> 2)) * 64;
    u32x4 sk = (u32x4){0u, 0u, 0u, 0u}, sv = sk, skA = sk, svA = sk, skB = sk, svB = sk;
#define PT(t) ((t) < 2 ? 1 - (t) : (t))
#define LOADKR(R, t) do { const size_t key0_ = (size_t)64 * PT(t); R = *(const GAS u32x4*)(Kb + (key0_ + lane) * 256 + wid * 8); } while (0)
#define LOADK(t) LOADKR(sk, t)
#define LOADVR(R, t) do { const size_t key0_ = (size_t)64 * PT(t); R = *(const GAS u32x4*)(Vb + (key0_ + 16 * (wid & 3) + (lane >> 2)) * 256 + (wid >> 2) * 32 + (lane & 3) * 8); } while (0)
#define LOADV(t) LOADVR(sv, t)
#define STOREKR(R, slot) do { *(LAS u32x4*)(lds + T_K + (slot) + wid * 1024 + lane * 16) = R; } while (0)
#define STOREK(slot) STOREKR(sk, slot)
#define STOREVR(R, slot) do { *(LAS u32x4*)(lds + T_V + (slot) + wid * 1024 + lane * 16) = R; } while (0)
#define STOREV(slot) STOREVR(sv, slot)
#define KLOAD2(j, kp) do { kf[2 * (j)] = *(const LAS bf16x8*)((kp) + (j) * 2048); kf[2 * (j) + 1] = *(const LAS bf16x8*)((kp) + (j) * 2048 + 512); } while (0)
#define CMASKT(P0, P1, t) do { const int jb_ = (t) - (NT - 2); \
        if ((t) == 1) { _Pragma("unroll") for (int r = 0; r < 16; ++r) { P0[r] = -INFINITY; P1[r] = -INFINITY; } } \
        else if (jb_ >= 0) { const int kb_ = 64 * jb_ + 4 * hi; _Pragma("unroll") for (int r = 0; r < 16; ++r) { const int kv_ = kb_ + (r & 3) + 8 * (r >> 2); if (kv_ > qrel) P0[r] = -INFINITY; if (kv_ + 32 > qrel) P1[r] = -INFINITY; } } } while (0)
    LOADK(0); LOADV(0); STOREK(0); STOREV(0); LOADK(1); STOREK(SLOTB); LOADK(2); STOREK(2 * SLOTB);
    __syncthreads();
    f32x16 pA0, pA1, pB0, pB1;
    bool resc = false;
    { const lds_cptr kb = kp0;
#pragma unroll
      for (int d0 = 0; d0 < 2; ++d0) { const bf16x8 b0 = *(const LAS bf16x8*)(kb + d0 * 2048), b1 = *(const LAS bf16x8*)(kb + d0 * 2048 + 512);
        if (d0 == 0) { pA0 = __builtin_amdgcn_mfma_f32_32x32x16_bf16(b0, qr[0], negm, 0, 0, 0); pA1 = __builtin_amdgcn_mfma_f32_32x32x16_bf16(b1, qr[0], negm, 0, 0, 0); }
        else { pA0 = __builtin_amdgcn_mfma_f32_32x32x16_bf16(b0, qr[1], pA0, 0, 0, 0); pA1 = __builtin_amdgcn_mfma_f32_32x32x16_bf16(b1, qr[1], pA1, 0, 0, 0); } }
#pragma unroll
      for (int r = 0; r < 16; ++r) { pA0[r] = -INFINITY; if (crow(r, hi) < 16) pA1[r] = -INFINITY; }
      const float rm = att::rowmax(pA0, pA1);
      mhat += rm;
#pragma unroll
      for (int r = 0; r < 16; ++r) { pA0[r] -= rm; pA1[r] -= rm; }
#pragma unroll
      for (int r = 0; r < 16; ++r) negm[r] = -mhat;
      asm volatile("" : "+v"(negm));
#pragma unroll
      for (int r = 0; r < 16; ++r) { pA0[r] = __builtin_amdgcn_exp2f(pA0[r]); pA1[r] = __builtin_amdgcn_exp2f(pA1[r]); } }
    __syncthreads();
    if (3 < NT) { LOADK(3); STOREK(0); }
    LOADV(1); STOREV(SLOTB);
    int sl_prev = 0, sl_cur = SLOTB, sl_next = 2 * SLOTB;
    bf16x8 kf[4];
    KLOAD2(0, kp0 + sl_cur); KLOAD2(1, kp0 + sl_cur);
    __syncthreads();
    s16x4 vlo[8], vhi[8]; u32x4 pw0, pw1, pw2, pw3;
#define PKW(P, B) cvtpk_s(P[B], P[B + 1])
#define PAF(k) __builtin_bit_cast(bf16x8, pw##k)
#define VFR(i) (bf16x8){vlo[i][0], vlo[i][1], vlo[i][2], vlo[i][3], vhi[i][0], vhi[i][1], vhi[i][2], vhi[i][3]}
#define PIN(x) asm volatile("" : "+v"(x))
#define MX3(a, b, c) __builtin_fmaxf(__builtin_fmaxf((a), (b)), (c))
#define GAPA(MF, A0, A1, A2, A3, W0, W1, PW) do { MF; W0; W1; PIN(PW); SBAR(); } while (0)
#define OSUM(k) o2 = __builtin_amdgcn_mfma_f32_32x32x16_bf16(PAF(k), ones, o2, 0, 0, 0)
#define EX(v) __builtin_amdgcn_exp2f(v)
#define GAPB(MF, X, B) do { MF; X[B] = EX(X[B]); X[B + 1] = EX(X[B + 1]); X[B + 2] = EX(X[B + 2]); X[B + 3] = EX(X[B + 3]); PIN(X); SBAR(); } while (0)
#define VRD(i) do { vlo[i] = vtr(vp_ + (((i) >> 2) * 4096 + ((i) & 3) * 1024)); vhi[i] = vtr(vp_ + (((i) >> 2) * 4096 + ((i) & 3) * 1024 + 512)); } while (0)
#define KRD(G, j) do { if (G) { KLOAD2(j, kp0 + sl_next); SBAR(); } } while (0)
#define NOMF ((void)0)
#define STEP(C0, C1, P0, P1, t, MASKED, LK, LV, SK, SV) do { SBAR(); \
        if ((t) + 3 < NT) LOADKR(LK, (t) + 3); if ((t) + 1 < NT) LOADVR(LV, (t) + 1); \
        const lds_cptr vp_ = vp0 + sl_prev; \
        VRD(0); SBAR(); \
        GAPA(C0 = __builtin_amdgcn_mfma_f32_32x32x16_bf16(kf[0], qr[0], negm, 0, 0, 0), P0[2], P0[3], P0[4], P0[5],     pw0[0] = PKW(P0, 0), pw0[1] = PKW(P0, 2), pw0); \
        VRD(4); SBAR(); GAPA(C1 = __builtin_amdgcn_mfma_f32_32x32x16_bf16(kf[1], qr[0], negm, 0, 0, 0), P0[6], P0[7], P0[8], P0[9],     pw0[2] = PKW(P0, 4), pw0[3] = PKW(P0, 6), pw0); \
        VRD(1); SBAR(); GAPA(C0 = __builtin_amdgcn_mfma_f32_32x32x16_bf16(kf[2], qr[1], C0, 0, 0, 0),   P0[10], P0[11], P0[12], P0[13], pw1[0] = PKW(P0, 8), pw1[1] = PKW(P0, 10), pw1); \
        VRD(5); SBAR(); GAPA(C1 = __builtin_amdgcn_mfma_f32_32x32x16_bf16(kf[3], qr[1], C1, 0, 0, 0),   P0[14], P0[15], P1[0], P1[1],   pw1[2] = PKW(P0, 12), pw1[3] = PKW(P0, 14), pw1); \
        VRD(2); SBAR(); GAPA(OSUM(0), P1[2], P1[3], P1[4], P1[5],     pw2[0] = PKW(P1, 0), pw2[1] = PKW(P1, 2), pw2); \
        VRD(6); SBAR(); GAPA(OSUM(1), P1[6], P1[7], P1[8], P1[9],     pw2[2] = PKW(P1, 4), pw2[3] = PKW(P1, 6), pw2); \
        VRD(3); SBAR(); GAPA(OSUM(2), P1[10], P1[11], P1[12], P1[13], pw3[0] = PKW(P1, 8), pw3[1] = PKW(P1, 10), pw3); \
        VRD(7); SBAR(); GAPA(NOMF, P1[14], P1[15], 0.f, 0.f,       pw3[2] = PKW(P1, 12), pw3[3] = PKW(P1, 14), pw3); \
        OSUM(3); \
        if (MASKED) CMASKT(C0, C1, t); \
        if constexpr (TRACK) { float a = MX3(C0[0], C0[1], C1[0]), b = MX3(C0[2], C0[3], C1[1]); a = MX3(a, C1[2], C1[3]); \
          _Pragma("unroll") for (int r = 4; r < 16; r += 4) { a = MX3(a, C0[r], C0[r + 1]); b = MX3(b, C0[r + 2], C0[r + 3]); a = MX3(a, C1[r], C1[r + 1]); b = MX3(b, C1[r + 2], C1[r + 3]); } \
          float rm = __builtin_fmaxf(a, b); { auto rr = __builtin_amdgcn_permlane32_swap(__float_as_uint(rm), __float_as_uint(rm), false, false); rm = __builtin_fmaxf(__uint_as_float(rr[0]), __uint_as_float(rr[1])); } \
          resc = false; \
          if (__builtin_expect(__any(rm > THRL), 0)) { const float dl = __builtin_fmaxf(rm, 0.f); mhat += dl; \
            _Pragma("unroll") for (int r = 0; r < 16; ++r) { C0[r] -= dl; C1[r] -= dl; } \
            _Pragma("unroll") for (int r = 0; r < 16; ++r) negm[r] = -mhat; asm volatile("" : "+v"(negm)); \
            const float f = __builtin_amdgcn_exp2f(-dl); if (hi == 0) wsf[r32] = f; resc = true; } } \
        SBAR(); \
        GAPB(o[0] = __builtin_amdgcn_mfma_f32_32x32x16_bf16(PAF(0), VFR(0), o[0], 0, 0, 0), C0, 0); \
        GAPB(o[1] = __builtin_amdgcn_mfma_f32_32x32x16_bf16(PAF(0), VFR(4), o[1], 0, 0, 0), C0, 4); \
        KRD((t) + 1 < NT, 0); GAPB(o[0] = __builtin_amdgcn_mfma_f32_32x32x16_bf16(PAF(1), VFR(1), o[0], 0, 0, 0), C0, 8); \
        KRD((t) + 1 < NT, 1); GAPB(o[1] = __builtin_amdgcn_mfma_f32_32x32x16_bf16(PAF(1), VFR(5), o[1], 0, 0, 0), C0, 12); \
        GAPB(o[0] = __builtin_amdgcn_mfma_f32_32x32x16_bf16(PAF(2), VFR(2), o[0], 0, 0, 0), C1, 0); \
        GAPB(o[1] = __builtin_amdgcn_mfma_f32_32x32x16_bf16(PAF(2), VFR(6), o[1], 0, 0, 0), C1, 4); \
        GAPB(o[0] = __builtin_amdgcn_mfma_f32_32x32x16_bf16(PAF(3), VFR(3), o[0], 0, 0, 0), C1, 8); \
        GAPB(o[1] = __builtin_amdgcn_mfma_f32_32x32x16_bf16(PAF(3), VFR(7), o[1], 0, 0, 0), C1, 12); \
        if ((t) >= 2) { if ((t) + 2 < NT) STOREKR(SK, sl_prev); STOREVR(SV, sl_cur); } \
    } while (0)
#define RESC() do { if (resc) { asm volatile("s_waitcnt lgkmcnt(0)" ::: "memory"); \
        _Pragma("unroll") for (int r = 0; r < 16; ++r) { const float fr_ = wsf[crow(r, hi)]; o[0][r] *= fr_; o[1][r] *= fr_; o2[r] *= fr_; } } } while (0)
#define ROT() do { sl_prev = sl_cur; sl_cur = sl_next; sl_next = (sl_next == 2 * SLOTB) ? 0 : sl_next + SLOTB; } while (0)
#define ENDSTEP() do { __syncthreads(); RESC(); ROT(); } while (0)
    int t = 1;
    STEP(pB0, pB1, pA0, pA1, t, true, skA, svA, skB, svB); ENDSTEP(); ++t;
    if (t + 1 < NT) { STEP(pA0, pA1, pB0, pB1, t, true, skB, svB, skA, svA); ENDSTEP(); ++t; }
#pragma unroll 1
    for (; t + 3 < NT; t += 2) {
        STEP(pB0, pB1, pA0, pA1, t, false, skA, svA, skB, svB);     ENDSTEP();
        STEP(pA0, pA1, pB0, pB1, t + 1, false, skB, svB, skA, svA); ENDSTEP();
    }
#pragma unroll 1
    for (; t + 1 < NT; t += 2) {
        STEP(pB0, pB1, pA0, pA1, t, true, skA, svA, skB, svB);      ENDSTEP();
        STEP(pA0, pA1, pB0, pB1, t + 1, true, skB, svB, skA, svA);  ENDSTEP();
    }
    STEP(pB0, pB1, pA0, pA1, NT - 1, true, skA, svA, skB, svB); __syncthreads(); RESC();
    {
      pw0 = (u32x4){PKW(pB0, 0), PKW(pB0, 2), PKW(pB0, 4), PKW(pB0, 6)}; pw1 = (u32x4){PKW(pB0, 8), PKW(pB0, 10), PKW(pB0, 12), PKW(pB0, 14)};
      pw2 = (u32x4){PKW(pB1, 0), PKW(pB1, 2), PKW(pB1, 4), PKW(pB1, 6)}; pw3 = (u32x4){PKW(pB1, 8), PKW(pB1, 10), PKW(pB1, 12), PKW(pB1, 14)};
      OSUM(0); OSUM(1); OSUM(2); OSUM(3);
      SBAR();
      att::pv(o, (int)(unsigned)(uintptr_t)(lds + T_V) + ((lane >> 4) & 1) * 32 + (lane & 3) * 8 + (4 * hi + ((lane & 15) >> 2)) * 64 + sl_cur, PAF(0), PAF(1), PAF(2), PAF(3)); }
    asm volatile("s_nop 7\n\ts_nop 7" : "+v"(o2));
    bool bad = false;
#pragma unroll
    for (int r = 0; r < 16; ++r) { const float l0_ = __shfl(o2[r], 0), l1_ = __shfl(o2[r], 32); const float l_ = hi ? l1_ : l0_; bad |= !(l_ > 0.f && l_ < 1e30f);
        const float rl = __builtin_amdgcn_rcpf(l_); o[0][r] *= rl; o[1][r] *= rl; }
    __syncthreads();
#undef PT
#undef LOADK
#undef LOADV
#undef STOREK
#undef STOREV
#undef LOADKR
#undef LOADVR
#undef STOREKR
#undef STOREVR
#undef KLOAD2
#undef CMASKT
#undef PKW
#undef PAF
#undef VFR
#undef PIN
#undef MX3
#undef GAPA
#undef OSUM
#undef EX
#undef GAPB
#undef VRD
#undef KRD
#undef NOMF
#undef STEP
#undef RESC
#undef ROT
#undef ENDSTEP
    return bad;
}
#undef SBAR
}

namespace hg {
typedef short bf16x8 __attribute__((ext_vector_type(8)));
typedef short s16x4 __attribute__((ext_vector_type(4)));
typedef float f32x16 __attribute__((ext_vector_type(16)));
constexpr int NCK = LSEQ / 64, NITEM = 8 * NCK;
constexpr int RS = 272;
__device__ __forceinline__ bf16x8 trfrag(unsigned addr) {
    s16x4 lo, hi;
    asm volatile("ds_read_b64_tr_b16 %0,%2\n\tds_read_b64_tr_b16 %1,%2 offset:512\n\ts_waitcnt lgkmcnt(0)" : "=&v"(lo), "=&v"(hi) : "v"(addr) : "memory");
    return (bf16x8){lo[0], lo[1], lo[2], lo[3], hi[0], hi[1], hi[2], hi[3]};
}
constexpr int A_SEG = 0, A_KH = 2048, A_VH = A_KH + 16384, A_ST = A_VH + 16384;
constexpr int C_SEG = 0, C_QS = 4096, C_QA = C_QS + 64 * RS, C_KA = C_QA + 64 * RS, C_VH = C_KA + 64 * RS, C_S = C_VH + 16384, C_OUT = C_QS, C_END = C_S + 128 * RS;
static_assert(C_END <= 131072 && 64 * 128 * 4 <= 2 * 64 * RS, "hg3 LDS map");
}
__device__ __forceinline__ void hg1_item(const Frame& F, int item) {
    using namespace hg;
    const int bh = item / NCK, ck = item % NCK, b = bh >> 2, h = bh & 3;
    const size_t m0 = (size_t)b * LSEQ + 64 * ck;
    const int tid = F.tid, seg = tid >> 7, c = tid & 127, wid = F.wave, lane = F.lane, r32 = lane & 31, hi = lane >> 5;
    const float* LF = WSP(float, WS_HLF) + m0 * 512 + 128 * h; const bf16* KK = WSP(bf16, WS_HK) + m0 * 512 + 128 * h; const bf16* VV = WSP(bf16, WS_HV) + m0 * 512 + 128 * h;
    LAS float* segtot = (LAS float*)(F.lds + A_SEG);
#pragma unroll
    for (int i = 0; i < 2; ++i) { const int p = tid + 512 * i, row = p >> 4, j = p & 15;
        *(LAS u32x4*)(F.lds + A_VH + (j >> 2) * 4096 + row * 64 + (j & 3) * 16) = *(const u32x4*)(VV + (size_t)row * 512 + j * 8); }
    float g[16]; bf16 kraw[16];
#pragma unroll
    for (int i = 0; i < 16; ++i) { g[i] = LF[(size_t)(16 * seg + i) * 512 + c]; kraw[i] = KK[(size_t)(16 * seg + i) * 512 + c]; }
    float run = 0.f;
#pragma unroll
    for (int i = 0; i < 16; ++i) { run += g[i]; g[i] = run; }
    segtot[seg * 128 + c] = run;
    __syncthreads();
    float off = 0.f, tot = 0.f;
#pragma unroll
    for (int q = 0; q < 4; ++q) { const float v = segtot[q * 128 + c]; tot += v; if (q < seg) off += v; }
#pragma unroll
    for (int i = 0; i < 16; ++i) { const int s_ = 16 * seg + i; const float e = __expf(tot - (g[i] + off));
        *(LAS bf16*)(F.lds + A_KH + (c >> 5) * 4096 + s_ * 64 + (c & 31) * 2) = (bf16)f2bf(bf2f(kraw[i]) * e); }
    if (seg == 0) st_wt(WSP(float, WS_DEC), WSP(float, WS_DEC) + (size_t)item * 128 + c, __expf(tot));
    __syncthreads();
    const unsigned tb = (unsigned)(uintptr_t)F.lds + ((lane >> 4) & 1) * 32 + (lane & 3) * 8 + (4 * hi + ((lane & 15) >> 2)) * 64;
    const int vblk = wid >> 1;
    bf16x8 af[4];
#pragma unroll
    for (int ks = 0; ks < 4; ++ks) af[ks] = trfrag(tb + A_VH + vblk * 4096 + ks * 1024);
    LAS bf16* stg = (LAS bf16*)(F.lds + A_ST);
#pragma unroll
    for (int cc = 0; cc < 2; ++cc) { const int cblk = (wid & 1) * 2 + cc; f32x16 acc = f32x16{};
#pragma unroll
        for (int ks = 0; ks < 4; ++ks) acc = __builtin_amdgcn_mfma_f32_32x32x16_bf16(af[ks], trfrag(tb + A_KH + cblk * 4096 + ks * 1024), acc, 0, 0, 0);
#pragma unroll
        for (int r = 0; r < 16; ++r) stg[(32 * vblk + att::crow(r, hi)) * 128 + 32 * cblk + r32] = (bf16)f2bf(acc[r]); }
    __syncthreads();
    bf16* UT = WSP(bf16, WS_UT) + (size_t)item * 16384;
#pragma unroll
    for (int i = 0; i < 4; ++i) { const int p = tid + 512 * i; st_wt(WSP(bf16, WS_UT), UT + p * 8, *(const LAS u32x4*)(F.lds + A_ST + p * 16)); }
    asm volatile("s_waitcnt vmcnt(0)" ::: "memory");
    __syncthreads();
}
__device__ __forceinline__ void hg2_item(const Frame& F, int item) {
    using namespace hg;
    const bf16* UT = WSP(bf16, WS_UT); bf16* ST = WSP(bf16, WS_ST); const float* DEC = WSP(float, WS_DEC);
    const int gid = item * 512 + F.tid;
    const int bh = gid >> 14, idx = gid & 16383, c = idx & 127;
    float S = 0.f;
    const size_t base = (size_t)bh * NCK * 16384 + idx; const float* dp = DEC + (size_t)bh * NCK * 128 + c;
#pragma unroll 1
    for (int j0 = 0; j0 < NCK; j0 += 65) {
        bf16 u[65]; float d[65];
#pragma unroll
        for (int j = 0; j < 65; ++j) { u[j] = UT[base + (size_t)(j0 + j) * 16384]; d[j] = dp[(j0 + j) * 128]; }
#pragma unroll
        for (int j = 0; j < 65; ++j) { st_wt(ST, ST + base + (size_t)(j0 + j) * 16384, (unsigned short)f2bf(S)); S = d[j] * S + bf2f(u[j]); }
    }
    asm volatile("s_waitcnt vmcnt(0)" ::: "memory");
    __syncthreads();
}
__device__ __forceinline__ void hand_post(const Frame& F, unsigned* c) { if (F.tid == 0) (void)__hip_atomic_fetch_add(c, 1u, __ATOMIC_RELAXED, __HIP_MEMORY_SCOPE_AGENT); }
__device__ __forceinline__ void hand_wait(const Frame& F, unsigned* c, unsigned target) {
    if (F.tid == 0) { unsigned sp = 0u; unsigned* tmo = WSP(unsigned, WS_CTL) + CW_BAR + XB_TMO;
        while (__hip_atomic_load(c, __ATOMIC_RELAXED, __HIP_MEMORY_SCOPE_AGENT) < target) { __builtin_amdgcn_s_sleep(2);
            if ((++sp & 255u) == 0u) { if (xb_ld(tmo)) break; if (sp > (1u << 22)) { atomicAdd(tmo, 1u); break; } } }
        __builtin_amdgcn_fence(__ATOMIC_ACQUIRE, "agent");
        asm volatile("s_waitcnt vmcnt(0)" ::: "memory"); }
    __syncthreads();
}
__device__ __forceinline__ void hg3_item(const Frame& F, int layer, int item, bool prod = false  ) {
    using namespace hg;
    const int bh = item / NCK, ck = item % NCK, b = bh >> 2, h = bh & 3;
    const size_t m0 = (size_t)b * LSEQ + 64 * ck;
    const int tid = F.tid, seg = tid >> 7, c = tid & 127, wid = F.wave, lane = F.lane, r32 = lane & 31, hi = lane >> 5;
    const float* LF = WSP(float, WS_HLF) + m0 * 512 + 128 * h; const bf16* KK = WSP(bf16, WS_HK) + m0 * 512 + 128 * h; const bf16* VV = WSP(bf16, WS_HV) + m0 * 512 + 128 * h;
    const bf16* QQ = WSP(bf16, WS_HQ) + m0 * 512 + 128 * h; const bf16* SG = WSP(bf16, WS_ST) + (size_t)item * 16384;
    LAS float* segtot = (LAS float*)(F.lds + C_SEG);
#pragma unroll
    for (int i = 0; i < 2; ++i) { const int p = tid + 512 * i, row = p >> 4, j = p & 15;
        *(LAS u32x4*)(F.lds + C_VH + (j >> 2) * 4096 + row * 64 + (j & 3) * 16) = *(const u32x4*)(VV + (size_t)row * 512 + j * 8); }
#pragma unroll
    for (int i = 0; i < 4; ++i) { const int p = tid + 512 * i, v = p >> 4, j = p & 15;
        *(LAS u32x4*)(F.lds + C_S + v * RS + j * 16) = *(const u32x4*)(SG + p * 8); }
    float g[16]; bf16 qraw[16], kraw[16];
#pragma unroll
    for (int i = 0; i < 16; ++i) { const size_t o_ = (size_t)(16 * seg + i) * 512 + c; g[i] = LF[o_]; qraw[i] = QQ[o_]; kraw[i] = KK[o_]; }
    const bf16* gp_ = WSP(bf16, WS_HG) + (m0 + (tid >> 3)) * 512 + 128 * h + (tid & 7) * 16;
    const u32x4 ga = *(const u32x4*)gp_, gb = *(const u32x4*)(gp_ + 8);
    float run = 0.f;
#pragma unroll
    for (int i = 0; i < 16; ++i) { run += g[i]; g[i] = run; }
    segtot[seg * 128 + c] = run;
    __syncthreads();
    const float t0_ = segtot[c], t1_ = segtot[128 + c], t2_ = segtot[256 + c];
    const float off = (seg > 0 ? t0_ : 0.f) + (seg > 1 ? t1_ : 0.f) + (seg > 2 ? t2_ : 0.f), R = t0_ + t1_;
#pragma unroll
    for (int i = 0; i < 16; ++i) { const int t = 16 * seg + i; const float G = g[i] + off;
        const float q = bf2f(qraw[i]), kk = bf2f(kraw[i]);
        *(LAS bf16*)(F.lds + C_QS + t * RS + c * 2) = (bf16)f2bf(q * __expf(G));
        *(LAS bf16*)(F.lds + C_QA + t * RS + c * 2) = (bf16)f2bf(q * __expf(G - R));
        *(LAS bf16*)(F.lds + C_KA + t * RS + c * 2) = (bf16)f2bf(kk * __expf(R - G)); }
    __syncthreads();
    const int tbk = wid >> 2, vb = wid & 3;
    f32x16 o = f32x16{};
    { const LAS unsigned char* qa = F.lds + C_QS + (32 * tbk + r32) * RS + hi * 16; const LAS unsigned char* sa = F.lds + C_S + (32 * vb + r32) * RS + hi * 16;
#pragma unroll
      for (int kk = 0; kk < 8; ++kk) o = __builtin_amdgcn_mfma_f32_32x32x16_bf16(*(const LAS bf16x8*)(qa + kk * 32), *(const LAS bf16x8*)(sa + kk * 32), o, 0, 0, 0); }
    const unsigned tb = (unsigned)(uintptr_t)F.lds + ((lane >> 4) & 1) * 32 + (lane & 3) * 8 + (4 * hi + ((lane & 15) >> 2)) * 64;
#pragma unroll
    for (int sb = 0; sb < 2; ++sb) {
        if (sb <= tbk) {
            f32x16 p = f32x16{};
            const LAS unsigned char* ka = F.lds + C_KA + (32 * sb + r32) * RS + hi * 16; const LAS unsigned char* qq = F.lds + C_QA + (32 * tbk + r32) * RS + hi * 16;
#pragma unroll
            for (int kk = 0; kk < 8; ++kk) p = __builtin_amdgcn_mfma_f32_32x32x16_bf16(*(const LAS bf16x8*)(ka + kk * 32), *(const LAS bf16x8*)(qq + kk * 32), p, 0, 0, 0);
            if (sb == tbk) {
#pragma unroll
                for (int r = 0; r < 16; ++r) if (att::crow(r, hi) > r32) p[r] = 0.f; }
            const u32x4 pw0 = (u32x4){att::cvtpk_s(p[0], p[1]), att::cvtpk_s(p[2], p[3]), att::cvtpk_s(p[4], p[5]), att::cvtpk_s(p[6], p[7])};
            const u32x4 pw1 = (u32x4){att::cvtpk_s(p[8], p[9]), att::cvtpk_s(p[10], p[11]), att::cvtpk_s(p[12], p[13]), att::cvtpk_s(p[14], p[15])};
            o = __builtin_amdgcn_mfma_f32_32x32x16_bf16(__builtin_bit_cast(bf16x8, pw0), trfrag(tb + C_VH + vb * 4096 + (2 * sb) * 1024), o, 0, 0, 0);
            o = __builtin_amdgcn_mfma_f32_32x32x16_bf16(__builtin_bit_cast(bf16x8, pw1), trfrag(tb + C_VH + vb * 4096 + (2 * sb + 1) * 1024), o, 0, 0, 0);
        }
    }
    __syncthreads();
    LAS float* ost = (LAS float*)(F.lds + C_OUT);
#pragma unroll
    for (int r = 0; r < 16; ++r) ost[(32 * tbk + att::crow(r, hi)) * 128 + 32 * vb + r32] = o[r];
    __syncthreads();
    { const int row = tid >> 3, s8 = tid & 7; float x[16];
#pragma unroll
      for (int q = 0; q < 4; ++q) { const f32x4 w = *(const LAS f32x4*)(ost + row * 128 + s8 * 16 + 4 * q); x[4 * q] = w.x; x[4 * q + 1] = w.y; x[4 * q + 2] = w.z; x[4 * q + 3] = w.w; }
      float ss = 0.f;
#pragma unroll
      for (int e = 0; e < 16; ++e) ss += x[e] * x[e];
      ss += __shfl_xor(ss, 1); ss += __shfl_xor(ss, 2); ss += __shfl_xor(ss, 4);
      const float rn = rsqrtf(ss * (1.f / 128.f) + EPS);
      const float* gn = F.in[5] + layer * 128 + s8 * 16;
      const float gt[16] = {bflo(ga.x), bfhi(ga.x), bflo(ga.y), bfhi(ga.y), bflo(ga.z), bfhi(ga.z), bflo(ga.w), bfhi(ga.w), bflo(gb.x), bfhi(gb.x), bflo(gb.y), bfhi(gb.y), bflo(gb.z), bfhi(gb.z), bflo(gb.w), bfhi(gb.w)};
      float y0[8], y1[8];
#pragma unroll
      for (int e = 0; e < 8; ++e) { y0[e] = x[e] * rn * gn[e] * gt[e]; y1[e] = x[8 + e] * rn * gn[8 + e] * gt[8 + e]; }
      bf16* mp = WSP(bf16, WS_MIX) + (m0 + row) * DM + 128 * h + s8 * 16;
      if (prod) { st_wt(WSP(bf16, WS_MIX), mp, pack8(y0)); st_wt(WSP(bf16, WS_MIX), mp + 8, pack8(y1)); asm volatile("s_waitcnt vmcnt(0)" ::: "memory"); }
      else { *(u32x4*)mp = pack8(y0); *(u32x4*)(mp + 8) = pack8(y1); } }
    __syncthreads();
}

__device__ __forceinline__ void attn_queue(const Frame& F, int layer) {
    using namespace att;
    const int lane0 = F.lane;
    unsigned* QC = WSP(unsigned, WS_CTL) + CW_QATT + 64 * layer;
    volatile LAS int* sItem = (volatile LAS int*)(F.lds + L_ITEM);
    const float* lv = F.in[6] + layer * 128;
    const float lam_init = 0.8f - 0.6f * expf(-0.3f * (float)layer);
    float lam; { float a = lane0 < 32 ? lv[lane0] * lv[32 + lane0] : 0.f, c = lane0 < 32 ? lv[64 + lane0] * lv[96 + lane0] : 0.f; a = wave_sum(a); c = wave_sum(c); lam = expf(a) - expf(c) + lam_init; }
    constexpr int NH1 = hg::NITEM, NATT = 768, NH2 = 256, NSERV = 64;
    unsigned* HC = WSP(unsigned, WS_CTL) + CW_HG + 64 * layer; unsigned* QS = QC + 32;
#define QCLAIM(q, dst) do { if (F.tid == 0) *sItem = (int)__hip_atomic_fetch_add(q, 1u, __ATOMIC_RELAXED, __HIP_MEMORY_SCOPE_AGENT); __syncthreads(); dst = *sItem; __syncthreads(); } while (0)
    if (F.blk < NSERV) {
        int s_; QCLAIM(QS, s_);
        unsigned seen1 = 0u, seen2 = 0u;
#pragma unroll 1
        while (s_ < NH1 / 8) {
#pragma unroll 1
            for (int k = 0; k < 8; ++k) { hg1_item(F, 8 * s_ + k); hand_post(F, HC + (8 * s_ + k) / hg::NCK); }
            QCLAIM(QS, s_); }
#pragma unroll 1
        while (s_ < NH1 / 8 + NH2) { const int i2 = s_ - NH1 / 8, bh2 = i2 >> 5;
            if (!((seen1 >> bh2) & 1u)) { hand_wait(F, HC + bh2, (unsigned)hg::NCK); seen1 |= 1u << bh2; }
            hg2_item(F, i2); hand_post(F, HC + 16 + bh2); QCLAIM(QS, s_); }
#pragma unroll 1
        while (s_ < NH1 / 8 + NH2 + NH1 / 4) {
#pragma unroll 1
            for (int k = 0; k < 4; ++k) { const int i3 = 4 * (s_ - NH1 / 8 - NH2) + k, bh3 = i3 / hg::NCK;
                if (!((seen2 >> bh3) & 1u)) { hand_wait(F, HC + 16 + bh3, 32u); seen2 |= 1u << bh3; }
                const bool prod3 = bh3 >= 4 && (i3 - bh3 * hg::NCK) >= hg::NCK - 4;
                hg3_item(F, layer, i3, prod3); if (prod3) hand_post(F, HC + 32); }
            QCLAIM(QS, s_); }
        const int c0 = NH1 / 8 + NH2 + NH1 / 4;
        { const int a0 = layer == 0 ? 9500 : 12000, nA = NW13 - a0, nT = nA + (layer == 0 ? 0 : 3000); LAS float* scr = (LAS float*)(F.lds + F.wave * 16384);
#pragma unroll 1
          while (s_ < c0 + (nT + 15) / 16) {
#pragma unroll 1
              for (int k = 0; k < 2; ++k) { const int idx = 16 * (s_ - c0) + 8 * k + F.wave;
                  if (idx < nA) cvt_w13_item(F, layer, a0 + idx, scr, F.lane); else if (idx < nT) cvt_w2_item(F, layer, idx - nA, scr, F.lane); }
              __syncthreads();
              QCLAIM(QS, s_); }
          const int c1 = c0 + (nT + 15) / 16;
#pragma unroll 1
          while (s_ < c1 + 4) { hand_wait(F, HC + 32, 28u); gemm2_unit(F, layer, G2_PANELS, s_ - c1); __syncthreads(); QCLAIM(QS, s_); } }
    }
    int qit; QCLAIM(QC, qit);
    for (;;) {
        if (qit >= NATT) break;
        const int it = qit;
        Frame Fi = F; asm volatile("" : "+v"(Fi.lane), "+v"(Fi.tid)); asm volatile("" : "+s"(Fi.ws), "+s"(Fi.wave));
        const int wid = Fi.wave, lane = Fi.lane; GAS bf16* MIX = (GAS bf16*)(Fi.ws + WS_MIX);
#define F Fi
        const int lvl = it / 24, r = it % 24, qb = 31 - lvl, bh = r & 7, b = bh >> 2, h = bh & 3;
        const size_t rb = (size_t)b * LSEQ;
        const int ch = lane & 7;
        if (r < 8) {
            const size_t row0 = rb + 128 + 256 * qb; const bool prodA = b == 1 && qb == 31;
            f32x16 o[2];
            attn_map<false>(F.lds, WSG(bf16, WS_FQ) + (row0 + wid * 32 + (lane & 31)) * 256 + 64 * h, WSG(bf16, WS_FK) + rb * 256 + 64 * h, WSG(bf16, WS_FV) + rb * 256 + 64 * h,
                            WSG(bf16, WS_KXF) + (size_t)bh * LSEQ * 8, 4 * qb + 5, wid, lane, o);
            stage_o(F.lds + L_OA, wid, lane, o);
            const LAS bf16* stg = (const LAS bf16*)(F.lds + L_OA) + wid * 2048; const float* gn = F.in[9] + layer * 64 + ch * 8;
#pragma unroll
            for (int i = 0; i < 4; ++i) { const int row = i * 8 + (lane >> 3); const u32x4 w = *(const LAS u32x4*)(stg + row * 64 + ch * 8);
                float x[8] = {bflo(w.x), bfhi(w.x), bflo(w.y), bfhi(w.y), bflo(w.z), bfhi(w.z), bflo(w.w), bfhi(w.w)};
                float ss = 0.f;
#pragma unroll
                for (int e = 0; e < 8; ++e) ss += x[e] * x[e];
                ss += __shfl_xor(ss, 1); ss += __shfl_xor(ss, 2); ss += __shfl_xor(ss, 4);
                const float rn = rsqrtf(ss * (1.f / 64.f) + EPS);
#pragma unroll
                for (int e = 0; e < 8; ++e) x[e] *= rn * gn[e];
                if (prodA) st_wt((const void*)MIX, (const void*)(MIX + (row0 + wid * 32 + row) * DM + 768 + 64 * h + ch * 8), pack8(x)); else *(GAS u32x4*)(MIX + (row0 + wid * 32 + row) * DM + 768 + 64 * h + ch * 8) = pack8(x); }
            if (prodA) { asm volatile("s_waitcnt vmcnt(0)" ::: "memory"); __syncthreads(); hand_post(F, HC + 32); }
        } else {
            const int qd = 2 * qb + (r < 16 ? 1 : 0); const size_t row0 = rb + 128 + 128 * qd; const bool prodB = b == 1 && qd >= 62;
            f32x16 o[2];
#define DIFF_ARGS(W_, LN_, WD_, R0_, RB_, H_) F.lds, (const GAS bf16*)((W_) + WS_DQ) + ((R0_) + ((WD_) & 3) * 32 + ((LN_) & 31)) * 256 + 32 * (2 * (H_) + ((WD_) >> 2)), (const GAS bf16*)((W_) + WS_DK) + (RB_) * 256 + 64 * (H_), \
                (const GAS bf16*)((W_) + WS_DV) + (RB_) * 256 + 64 * (H_), 2 * qd + 4, WD_, LN_, o
            if (__syncthreads_or((int)att2::diff_unit<false>(DIFF_ARGS(F.ws, lane, wid, row0, rb, h)) | MK_FORCE_TRACK)) {
                unsigned char* w2 = F.ws; int ln2 = lane, wd2 = wid, h2 = h; size_t r02 = row0, rb2 = rb;
                asm volatile("" : "+s"(w2), "+s"(wd2), "+s"(h2)); asm volatile("" : "+v"(ln2)); asm volatile("" : "+s"(r02), "+s"(rb2));
                (void)att2::diff_unit<true>(DIFF_ARGS(w2, ln2, wd2, r02, rb2, h2)); }
#undef DIFF_ARGS
            stage_o(F.lds + (wid < 4 ? att2::T_OA : att2::T_OB), wid & 3, lane, o);
            __syncthreads();
            const LAS bf16* sa = (const LAS bf16*)(F.lds + att2::T_OA); const LAS bf16* sb = (const LAS bf16*)(F.lds + att2::T_OB); const float* gn = F.in[7] + layer * 64 + ch * 8;
#pragma unroll
            for (int i = 0; i < 2; ++i) { const int row = wid * 16 + i * 8 + (lane >> 3); const u32x4 wa = *(const LAS u32x4*)(sa + row * 64 + ch * 8), wb = *(const LAS u32x4*)(sb + row * 64 + ch * 8);
                float x[8] = {bflo(wa.x) - lam * bflo(wb.x), bfhi(wa.x) - lam * bfhi(wb.x), bflo(wa.y) - lam * bflo(wb.y), bfhi(wa.y) - lam * bfhi(wb.y),
                              bflo(wa.z) - lam * bflo(wb.z), bfhi(wa.z) - lam * bfhi(wb.z), bflo(wa.w) - lam * bflo(wb.w), bfhi(wa.w) - lam * bfhi(wb.w)};
                float ss = 0.f;
#pragma unroll
                for (int e = 0; e < 8; ++e) ss += x[e] * x[e];
                ss += __shfl_xor(ss, 1); ss += __shfl_xor(ss, 2); ss += __shfl_xor(ss, 4);
                const float rn = rsqrtf(ss * (1.f / 64.f) + EPS) * (1.f - lam_init);
#pragma unroll
                for (int e = 0; e < 8; ++e) x[e] *= rn * gn[e];
                if (prodB) st_wt((const void*)MIX, (const void*)(MIX + (row0 + row) * DM + 512 + 64 * h + ch * 8), pack8(x)); else *(GAS u32x4*)(MIX + (row0 + row) * DM + 512 + 64 * h + ch * 8) = pack8(x); }
            if (prodB) asm volatile("s_waitcnt vmcnt(0)" ::: "memory");
            __syncthreads();
            if (prodB) hand_post(F, HC + 32);
        }
#undef F
        QCLAIM(QC, qit);
    }
#undef QCLAIM
}

__global__ void __launch_bounds__(512, 2) mega(Args args) {
    extern __shared__ __attribute__((aligned(16))) unsigned char lds[];
    Frame F;
    F.lds = (LAS unsigned char*)lds; F.ws = args.ws; F.out = args.out; F.in = args.in;
    F.tid = threadIdx.x; F.lane = F.tid & 63; F.wave = __builtin_amdgcn_readfirstlane(F.tid >> 6); F.G = gridDim.x; F.blk = blockIdx.x;
    volatile LAS unsigned* MISC = (volatile LAS unsigned*)(F.lds + MISC_OFF);
    if (F.tid < 32) MISC[F.tid] = 0u;
    __syncthreads();
    unsigned* ctl = (unsigned*)(args.ws + WS_CTL);
    XcdBarrier bar; bar.bar = ctl + CW_BAR; bar.x = 0; bar.st = nullptr;
    if (MK_ONE_LAUNCH) bar = xcd_barrier_post(ctl + CW_BAR, MISC + 8);
    const int lo = args.ph_lo, hi = args.ph_hi;
#define IN(k) (lo <= (k) && (k) < hi)
#define SEAM(k) do { if (MK_ONE_LAUNCH && IN((k) + 1)) xcd_barrier(bar); } while (0)

    if (IN(0)) { prologue_tables(F); convert_static_weights(F); __syncthreads(); norm_phase<0>(F, 0); SEAM(0); }
#define LAYER_BODY(layer) do { \
        const int pb = 1 + 9 * (layer); \
        if (IN(pb + 0)) { if (F.blk == F.G - 1) fd_scan(F); GEMM1(F, layer); if ((layer) == 0) tail_convert(F, 0, 0, 0, 9500, 910, true); else tail_convert(F, 0, 1, 3000, 12000, 910, true); SEAM(pb + 0); } \
          \
        if (IN(pb + 3)) { attn_naive(F, layer, F.blk, F.G, 2); attn_queue(F, layer); SEAM(pb + 3); } \
        if (IN(pb + 4)) { GEMM2(F, layer); SEAM(pb + 4); }        \
        if (IN(pb + 5)) { norm2_route(F, layer); SEAM(pb + 5); } \
        if (IN(pb + 6)) { MOEUP(F, layer); tail_convert(F, 1, layer, (layer) == 0 ? 0 : 3000, NW2, ((const LAS int*)(F.lds + 131072))[NEXP] * 4); SEAM(pb + 6); } \
        if (IN(pb + 7)) { MOEDOWN(F, layer); if ((layer) == 0) tail_convert(F, 0, 1, 0, 3000, ((const LAS int*)(F.lds + 131072))[NEXP] * 4); SEAM(pb + 7); } \
        if (IN(pb + 8)) { if (layer == 0) norm_phase<1>(F, 1); else norm_phase<2>(F, 0); SEAM(pb + 8); } \
    } while (0)
    LAYER_BODY(0);
    LAYER_BODY(1);
#undef LAYER_BODY
#undef IN
#undef SEAM
}

extern "C" void kernel_launch(void* const* d_in, const int* in_sizes, int n_in, void* d_out, int out_size, void* d_ws, size_t ws_size, hipStream_t stream) {
    static int grid = 0;
    if (grid == 0) {
        if (n_in != 20 || out_size != BATCH * SEQ * DM || ws_size < WS_END) { fprintf(stderr, "kernel_launch: unexpected problem (n_in %d out %d ws %zu)\n", n_in, out_size, ws_size); grid = -1; return; }
        int dev = 0, cus = 0;
        if (hipGetDevice(&dev) != hipSuccess || hipDeviceGetAttribute(&cus, hipDeviceAttributeMultiprocessorCount, dev) != hipSuccess) { grid = -1; return; }
        if (hipFuncSetAttribute((const void*)mega, hipFuncAttributeMaxDynamicSharedMemorySize, LDS_BYTES) != hipSuccess) { fprintf(stderr, "kernel_launch: hipFuncSetAttribute failed\n"); grid = -1; return; }
        int per_cu = 0;
        if (hipOccupancyMaxActiveBlocksPerMultiprocessor(&per_cu, (const void*)mega, 512, LDS_BYTES) != hipSuccess || per_cu < 1) { fprintf(stderr, "kernel_launch: occupancy query says %d\n", per_cu); }
        (void)hipGetLastError();
        grid = cus;
    }
    if (grid < 0) return;
    (void)hipMemsetAsync((char*)d_ws + WS_CTL, 0, CTL_ZERO_BYTES, stream);
    Args a{};
    for (int i = 0; i < 20; ++i) a.in[i] = (const float*)d_in[i];
    a.out = (float*)d_out; a.ws = (unsigned char*)d_ws;
#if MK_ONE_LAUNCH
    a.ph_lo = 0; a.ph_hi = NPH;
    hipLaunchKernelGGL(mega, dim3(grid), dim3(512), LDS_BYTES, stream, a);
#else
    for (int p = 0; p < NPH; ++p) { a.ph_lo = p; a.ph_hi = p + 1; hipLaunchKernelGGL(mega, dim3(grid), dim3(512), LDS_BYTES, stream, a); }
#endif
}
```
